# Optimizing an MI355X kernel written in HIP

```python
import jax
import jax.numpy as jnp
from jax import lax
import numpy as np

D_MODEL = 1024
BATCH = 2
SEQ = 8192
DEPTH = 2

GRID_W = 64
CTX_LEN = 256
HEAD_DIM = 64
N_GROUPS = 4
MIX_WIDTH = D_MODEL
GROUP_WIDTH = MIX_WIDTH // N_GROUPS
GROUP_HEADS = GROUP_WIDTH // HEAD_DIM
Q_BLOCK = 128
ROPE_THETA = 10000.0
NORM_EPS = 1e-6
NEG_INF = -1e30
GQA_KV_HEADS = 2
MLA_Q_RANK = D_MODEL // 4
MLA_KV_RANK = D_MODEL // 8
MLA_NOPE_DIM = 64
MLA_ROPE_DIM = 32
MLA_V_DIM = GROUP_WIDTH // GROUP_HEADS
RWKV_DECAY_LORA = 64
RWKV_ICLR_LORA = 64
RWKV_GATE_LORA = 160
RWKV_GN_EPS = 64e-5
SWA_KV_HEADS = 2
WINDOW = 128
D_FF = 4 * D_MODEL

A_COLS = GROUP_WIDTH + 2 * GQA_KV_HEADS * HEAD_DIM
B_COLS = MLA_Q_RANK + MLA_KV_RANK + MLA_ROPE_DIM
C_COLS = 3 * GROUP_WIDTH + RWKV_DECAY_LORA + RWKV_ICLR_LORA + RWKV_GATE_LORA
D_COLS = GROUP_WIDTH + 2 * SWA_KV_HEADS * HEAD_DIM
IN_COLS = A_COLS + B_COLS + C_COLS + D_COLS
IN_CUTS = (A_COLS, A_COLS + B_COLS, A_COLS + B_COLS + C_COLS)
RWKV_CUTS = (GROUP_WIDTH, 2 * GROUP_WIDTH, 3 * GROUP_WIDTH,
             3 * GROUP_WIDTH + RWKV_DECAY_LORA,
             3 * GROUP_WIDTH + RWKV_DECAY_LORA + RWKV_ICLR_LORA)

kernel_name = 'hybrid_parallel_group_flow_block'


def rms_norm(x, g):
    xf = x.astype(jnp.float32)
    y = xf * lax.rsqrt(jnp.mean(xf * xf, axis=-1, keepdims=True) + NORM_EPS)
    return (y * g.astype(jnp.float32)).astype(x.dtype)


def rope_tables(row, col, rot_dim):
    n = rot_dim // 4
    inv = ROPE_THETA ** (-jnp.arange(n, dtype=jnp.float32) / n)
    ar = row[:, None] * inv
    ac = col[:, None] * inv
    return (jnp.cos(ar), jnp.sin(ar), jnp.cos(ac), jnp.sin(ac))


def _rotate(x, cos, sin):
    shape = (cos.shape[0],) + (1,) * (x.ndim - 3) + (cos.shape[1],)
    cs, sn = cos.reshape(shape), sin.reshape(shape)
    x1, x2 = jnp.split(x, 2, axis=-1)
    return jnp.concatenate([x1 * cs - x2 * sn, x1 * sn + x2 * cs], axis=-1)


def axial_rope(x, rope):
    cos_r, sin_r, cos_c, sin_c = rope
    xf = x.astype(jnp.float32)
    half = x.shape[-1] // 2
    out = jnp.concatenate([_rotate(xf[..., :half], cos_r, sin_r),
                           _rotate(xf[..., half:], cos_c, sin_c)], axis=-1)
    return out.astype(x.dtype)


def softmax_attend(q, k, v, sink):
    s = jnp.einsum('bqgrd,bkgd->bgrqk', q, k).astype(jnp.float32) * (q.shape[-1] ** -0.5)
    if sink is None:
        p = jax.nn.softmax(s, axis=-1)
    else:
        sk = jnp.broadcast_to(sink.astype(jnp.float32)[None, :, :, None, None], s.shape[:-1] + (1,))
        p = jax.nn.softmax(jnp.concatenate([sk, s], axis=-1), axis=-1)[..., 1:]
    return jnp.einsum('bgrqk,bkgd->bqgrd', p.astype(v.dtype), v)


def blocked_attend(q, k, v):
    B, T, G, R, dk = q.shape
    nb = T // Q_BLOCK
    qb = jnp.moveaxis(q.reshape(B, nb, Q_BLOCK, G, R, dk), 1, 0)
    ob = lax.map(lambda qi: softmax_attend(qi, k, v, None), qb)
    return jnp.moveaxis(ob, 0, 1).reshape(B, T, G, R, v.shape[-1])


def banded_window_attend(q, k, v, k_ctx, v_ctx, sink):
    B, T, G, R, d = q.shape
    W = WINDOW
    nb = T // W

    def band(t):
        tp = jnp.pad(t, ((0, 0), (W, W), (0, 0), (0, 0))).reshape(B, nb + 2, W, G, t.shape[-1])
        return jnp.concatenate([tp[:, :-2], tp[:, 1:-1], tp[:, 2:]], axis=2)

    kb, vb = band(k), band(v)
    qb = q.reshape(B, nb, W, G, R, d)
    scale = d ** -0.5
    s_win = jnp.einsum('bnqgrd,bnkgd->bgrnqk', qb, kb).astype(jnp.float32) * scale
    s_ctx = jnp.einsum('bnqgrd,bcgd->bgrnqc', qb, k_ctx).astype(jnp.float32) * scale
    qpos = jnp.arange(T).reshape(nb, W)[:, :, None]
    kpos = (jnp.arange(nb)[:, None] * W - W + jnp.arange(3 * W)[None, :])[:, None, :]
    valid = (jnp.abs(qpos - kpos) <= W) & (kpos >= 0) & (kpos < T)
    s_win = jnp.where(valid, s_win, NEG_INF)
    sk = jnp.broadcast_to(sink.astype(jnp.float32)[None, :, :, None, None, None], s_win.shape[:-1] + (1,))
    p = jax.nn.softmax(jnp.concatenate([sk, s_win, s_ctx], axis=-1), axis=-1)
    p_win = p[..., 1:1 + 3 * W].astype(v.dtype)
    p_ctx = p[..., 1 + 3 * W:].astype(v.dtype)
    o = (jnp.einsum('bgrnqk,bnkgd->bnqgrd', p_win, vb)
         + jnp.einsum('bgrnqc,bcgd->bnqgrd', p_ctx, v_ctx))
    return o.reshape(B, T, G, R, d)


def split_gqa(z, n_kv):
    B, T, _ = z.shape
    q, k, v = jnp.split(z, (GROUP_WIDTH, GROUP_WIDTH + n_kv * HEAD_DIM), axis=-1)
    return (q.reshape(B, T, n_kv, GROUP_HEADS // n_kv, HEAD_DIM),
            k.reshape(B, T, n_kv, HEAD_DIM),
            v.reshape(B, T, n_kv, HEAD_DIM))


def mla_qkv(z, p, rope):
    B, T, _ = z.shape
    cq, ckv, kr = jnp.split(z, (MLA_Q_RANK, MLA_Q_RANK + MLA_KV_RANK), axis=-1)
    q = (rms_norm(cq, p['mla_q_norm']) @ p['mla_w_uq']).reshape(B, T, GROUP_HEADS, MLA_NOPE_DIM + MLA_ROPE_DIM)
    kv = (rms_norm(ckv, p['mla_kv_norm']) @ p['mla_w_ukv']).reshape(B, T, GROUP_HEADS, MLA_NOPE_DIM + MLA_V_DIM)
    q_nope, q_rope = jnp.split(q, (MLA_NOPE_DIM,), axis=-1)
    k_nope, v = jnp.split(kv, (MLA_NOPE_DIM,), axis=-1)
    kr = kr.reshape(B, T, 1, MLA_ROPE_DIM)
    if rope is not None:
        q_rope = axial_rope(q_rope, rope)
        kr = axial_rope(kr, rope)
    q = jnp.concatenate([q_nope, q_rope], axis=-1)[:, :, :, None, :]
    k = jnp.concatenate([k_nope, jnp.broadcast_to(kr, (B, T, GROUP_HEADS, MLA_ROPE_DIM))], axis=-1)
    return q, k, v


def token_shift_centred(z, mu):
    zp = jnp.pad(z, ((0, 0), (1, 1), (0, 0)))
    return z + mu * (0.5 * (zp[:, :-2] + zp[:, 2:]) - z)


def rwkv_prepare(z, p):
    z = token_shift_centred(z, p['rwkv_mu'])
    r, k, v, wl, al, gl = jnp.split(z, RWKV_CUTS, axis=-1)
    B, T, _ = z.shape

    def heads(t):
        return t.reshape(B, T, GROUP_HEADS, HEAD_DIM).astype(jnp.float32)

    wt = jnp.tanh(wl)
    dirs = []
    for d in range(2):
        w_log = -jax.nn.softplus(-(p['rwkv_w0'][d] + wt @ p['rwkv_w2'][d])) - 0.5
        decay = jnp.exp(-jnp.exp(w_log.astype(jnp.float32)))
        a = jax.nn.sigmoid(p['rwkv_a0'][d] + al @ p['rwkv_a2'][d])
        kk = heads(k * p['rwkv_k_k'][d])
        kk = kk / jnp.maximum(jnp.sqrt(jnp.sum(kk * kk, axis=-1, keepdims=True)), 1e-12)
        kd = heads(k * (1.0 + (a - 1.0) * p['rwkv_k_a'][d]))
        dirs.append((heads(decay), kd, -kk, kk * heads(a)))
    return heads(r), heads(v), gl, dirs


def rwkv_scan(S0, r, w, k, v, a, b, reverse):
    def step(S, inp):
        r_t, w_t, k_t, v_t, a_t, b_t = inp
        sa = jnp.einsum('bhij,bhj->bhi', S, a_t)
        S = S * w_t[:, :, None, :] + sa[..., :, None] * b_t[:, :, None, :] + v_t[..., :, None] * k_t[:, :, None, :]
        return S, jnp.einsum('bhij,bhj->bhi', S, r_t)

    xs = tuple(jnp.moveaxis(t, 1, 0) for t in (r, w, k, v, a, b))
    S, ys = lax.scan(step, S0, xs, reverse=reverse)
    return S, jnp.moveaxis(ys, 0, 1)


def rwkv_output(y, r, v, dirs, gl, p, dtype):
    B, T, H, N = y.shape
    mean = jnp.mean(y, axis=-1, keepdims=True)
    var = jnp.mean(jnp.square(y - mean), axis=-1, keepdims=True)
    yn = ((y - mean) * lax.rsqrt(var + RWKV_GN_EPS)).reshape(B, T, H * N)
    yn = yn * p['rwkv_ln_w'].astype(jnp.float32) + p['rwkv_ln_b'].astype(jnp.float32)
    r_k = p['rwkv_r_k'].astype(jnp.float32)
    bonus = ((jnp.sum(r * dirs[0][1] * r_k, axis=-1, keepdims=True)
              + jnp.sum(r * dirs[1][1] * r_k, axis=-1, keepdims=True)) * v).reshape(B, T, H * N)
    g = (jax.nn.sigmoid(gl) @ p['rwkv_g2']).astype(jnp.float32)
    return ((yn + bonus) * g).astype(dtype)


def rwkv_mix(zr, zrc, p, with_ctx_out):
    r_c, v_c, gl_c, dirs_c = rwkv_prepare(zrc, p)
    r_l, v_l, gl_l, dirs_l = rwkv_prepare(zr, p)
    S0 = jnp.zeros((zr.shape[0], GROUP_HEADS, HEAD_DIM, HEAD_DIM), jnp.float32)
    ys_c, ys_l = [], []
    for d, rev in enumerate((False, True)):
        w_c, k_c, a_c, b_c = dirs_c[d]
        S_ctx, y_c = rwkv_scan(S0, r_c, w_c, k_c, v_c, a_c, b_c, rev)
        w_l, k_l, a_l, b_l = dirs_l[d]
        _, y_l = rwkv_scan(S_ctx, r_l, w_l, k_l, v_l, a_l, b_l, rev)
        ys_c.append(y_c)
        ys_l.append(y_l)
    out = rwkv_output(ys_l[0] + ys_l[1], r_l, v_l, dirs_l, gl_l, p, zr.dtype)
    out_c = rwkv_output(ys_c[0] + ys_c[1], r_c, v_c, dirs_c, gl_c, p, zrc.dtype) if with_ctx_out else None
    return out, out_c


def merge_groups(outs):
    return jnp.concatenate([o.reshape(o.shape[0], o.shape[1], -1) for o in outs], axis=-1)


def token_mixer(h, hc, p, rope_hd, rope_mla, with_ctx_out):
    za, zb, zr, zd = jnp.split(h @ p['w_in'], IN_CUTS, axis=-1)
    zac, zbc, zrc, zdc = jnp.split(hc @ p['w_in'], IN_CUTS, axis=-1)
    outs, outs_c = [], []
    q, k, v = split_gqa(za, GQA_KV_HEADS)
    qc, kc, vc = split_gqa(zac, GQA_KV_HEADS)
    q = axial_rope(rms_norm(q, p['gqa_q_norm']), rope_hd)
    k = axial_rope(rms_norm(k, p['gqa_k_norm']), rope_hd)
    qc = rms_norm(qc, p['gqa_q_norm'])
    kc = rms_norm(kc, p['gqa_k_norm'])
    outs.append(blocked_attend(q, jnp.concatenate([k, kc], axis=1), jnp.concatenate([v, vc], axis=1)))
    if with_ctx_out:
        outs_c.append(softmax_attend(qc, kc, vc, None))
    q, k, v = mla_qkv(zb, p, rope_mla)
    qc, kc, vc = mla_qkv(zbc, p, None)
    outs.append(blocked_attend(q, jnp.concatenate([k, kc], axis=1), jnp.concatenate([v, vc], axis=1)))
    if with_ctx_out:
        outs_c.append(softmax_attend(qc, kc, vc, None))
    o, oc = rwkv_mix(zr, zrc, p, with_ctx_out)
    outs.append(o)
    if with_ctx_out:
        outs_c.append(oc)
    q, k, v = split_gqa(zd, SWA_KV_HEADS)
    qc, kc, vc = split_gqa(zdc, SWA_KV_HEADS)
    q = axial_rope(q, rope_hd)
    k = axial_rope(k, rope_hd)
    sink = p['swa_sink'].reshape(SWA_KV_HEADS, GROUP_HEADS // SWA_KV_HEADS)
    outs.append(banded_window_attend(q, k, v, kc, vc, sink))
    if with_ctx_out:
        outs_c.append(softmax_attend(qc, kc, vc, sink))
    y = merge_groups(outs) @ p['w_out']
    yc = merge_groups(outs_c) @ p['w_out'] if with_ctx_out else None
    return y, yc


def sq_relu_mlp(h, w1, w2):
    return jnp.square(jax.nn.relu(h @ w1)) @ w2


def setup_inputs(seed: int = 0) -> dict:
    key = jax.random.key(seed)
    keys = iter(jax.random.split(key, 40))

    def nrm(shape, scale):
        return jax.random.normal(next(keys), shape, jnp.float32) * scale

    def gain(shape):
        return 1.0 + nrm(shape, 0.02)

    def unif(shape, lo, hi):
        return jax.random.uniform(next(keys), shape, jnp.float32, lo, hi)

    L, D, H, N, GW = DEPTH, D_MODEL, GROUP_HEADS, HEAD_DIM, GROUP_WIDTH
    return {
        'x': nrm((BATCH, SEQ, D), 1.0),
        'c': nrm((BATCH, D), 1.0),
        'ctx': nrm((BATCH, CTX_LEN, D), 1.0),
        'c_ctx': nrm((D,), 1.0),
        'w_mod': nrm((L, D, 6 * D), 0.5 * D ** -0.5),
        'b_mod': nrm((L, 6 * D), 0.02),
        'g_pre_mix': gain((L, D)),
        'g_post_mix': gain((L, D)),
        'g_pre_mlp': gain((L, D)),
        'g_post_mlp': gain((L, D)),
        'w_in': nrm((L, D, IN_COLS), D ** -0.5),
        'gqa_q_norm': gain((L, N)),
        'gqa_k_norm': gain((L, N)),
        'mla_q_norm': gain((L, MLA_Q_RANK)),
        'mla_kv_norm': gain((L, MLA_KV_RANK)),
        'mla_w_uq': nrm((L, MLA_Q_RANK, H * (MLA_NOPE_DIM + MLA_ROPE_DIM)), MLA_Q_RANK ** -0.5),
        'mla_w_ukv': nrm((L, MLA_KV_RANK, H * (MLA_NOPE_DIM + MLA_V_DIM)), MLA_KV_RANK ** -0.5),
        'rwkv_mu': unif((L, C_COLS), 0.0, 1.0),
        'rwkv_w0': unif((L, 2, GW), -6.0, -1.0),
        'rwkv_w2': nrm((L, 2, RWKV_DECAY_LORA, GW), 0.1 * RWKV_DECAY_LORA ** -0.5),
        'rwkv_a0': nrm((L, 2, GW), 0.1),
        'rwkv_a2': nrm((L, 2, RWKV_ICLR_LORA, GW), 0.5 * RWKV_ICLR_LORA ** -0.5),
        'rwkv_k_k': 0.85 + nrm((L, 2, GW), 0.05),
        'rwkv_k_a': 1.0 + nrm((L, 2, GW), 0.05),
        'rwkv_r_k': nrm((L, H, N), 0.1),
        'rwkv_g2': nrm((L, RWKV_GATE_LORA, GW), RWKV_GATE_LORA ** -0.5),
        'rwkv_ln_w': gain((L, GW)),
        'rwkv_ln_b': nrm((L, GW), 0.02),
        'swa_sink': nrm((L, H), 0.5),
        'w_out': nrm((L, MIX_WIDTH, D), MIX_WIDTH ** -0.5),
        'w_mlp1': nrm((L, D, D_FF), D ** -0.5),
        'w_mlp2': nrm((L, D_FF, D), D_FF ** -0.5),
    }


def reference(x, c, ctx, c_ctx, w_mod, b_mod, g_pre_mix, g_post_mix, g_pre_mlp, g_post_mlp, w_in,
              gqa_q_norm, gqa_k_norm, mla_q_norm, mla_kv_norm, mla_w_uq, mla_w_ukv,
              rwkv_mu, rwkv_w0, rwkv_w2, rwkv_a0, rwkv_a2, rwkv_k_k, rwkv_k_a, rwkv_r_k, rwkv_g2,
              rwkv_ln_w, rwkv_ln_b, swa_sink, w_out, w_mlp1, w_mlp2):
    T = x.shape[1]
    ROWS = T // GRID_W
    row = jnp.broadcast_to(jnp.arange(ROWS, dtype=jnp.float32)[:, None], (ROWS, GRID_W)).reshape(-1)
    col = jnp.broadcast_to(jnp.arange(GRID_W, dtype=jnp.float32)[None, :], (ROWS, GRID_W)).reshape(-1)
    rope_hd = rope_tables(row, col, HEAD_DIM)
    rope_mla = rope_tables(row, col, MLA_ROPE_DIM)
    silu_c = jax.nn.silu(c)
    silu_cc = jax.nn.silu(c_ctx)[None, :]
    xc = ctx
    for l in range(DEPTH):
        last = l == DEPTH - 1
        m = (silu_c @ w_mod[l] + b_mod[l])[:, None, :]
        mc = (silu_cc @ w_mod[l] + b_mod[l])[:, None, :]
        sh1, sc1, gt1, sh2, sc2, gt2 = jnp.split(m, 6, axis=-1)
        sh1c, sc1c, gt1c, sh2c, sc2c, gt2c = jnp.split(mc, 6, axis=-1)
        p = {
            'w_in': w_in[l], 'w_out': w_out[l],
            'gqa_q_norm': gqa_q_norm[l], 'gqa_k_norm': gqa_k_norm[l],
            'mla_q_norm': mla_q_norm[l], 'mla_kv_norm': mla_kv_norm[l],
            'mla_w_uq': mla_w_uq[l], 'mla_w_ukv': mla_w_ukv[l],
            'rwkv_mu': rwkv_mu[l], 'rwkv_w0': rwkv_w0[l], 'rwkv_w2': rwkv_w2[l],
            'rwkv_a0': rwkv_a0[l], 'rwkv_a2': rwkv_a2[l], 'rwkv_k_k': rwkv_k_k[l],
            'rwkv_k_a': rwkv_k_a[l], 'rwkv_r_k': rwkv_r_k[l], 'rwkv_g2': rwkv_g2[l],
            'rwkv_ln_w': rwkv_ln_w[l], 'rwkv_ln_b': rwkv_ln_b[l], 'swa_sink': swa_sink[l],
        }
        h = rms_norm(x, g_pre_mix[l]) * (1.0 + sc1) + sh1
        hc = rms_norm(xc, g_pre_mix[l]) * (1.0 + sc1c) + sh1c
        y, yc = token_mixer(h, hc, p, rope_hd, rope_mla, not last)
        x = x + gt1 * rms_norm(y, g_post_mix[l])
        h = rms_norm(x, g_pre_mlp[l]) * (1.0 + sc2) + sh2
        x = x + gt2 * rms_norm(sq_relu_mlp(h, w_mlp1[l], w_mlp2[l]), g_post_mlp[l])
        if not last:
            xc = xc + gt1c * rms_norm(yc, g_post_mix[l])
            hc = rms_norm(xc, g_pre_mlp[l]) * (1.0 + sc2c) + sh2c
            xc = xc + gt2c * rms_norm(sq_relu_mlp(hc, w_mlp1[l], w_mlp2[l]), g_post_mlp[l])
    return x
```

```cpp
#include <hip/hip_runtime.h>
#include <hip/hip_cooperative_groups.h>
#include <cstdio>
#include <cstdint>
namespace cg = cooperative_groups;

typedef unsigned short bf16_t;
using bf16x8 = __attribute__((ext_vector_type(8))) short;
using f32x16 = __attribute__((ext_vector_type(16))) float;
#define DI __device__ __forceinline__
#define MFMA32(a, b, c) __builtin_amdgcn_mfma_f32_32x32x16_bf16((a), (b), (c), 0, 0, 0)

constexpr int D_ = 1024, T_ = 8192, NLAT = 16384, NCTX = 512, NT = 16896, CTXL = 256;
constexpr int NWIN = 2816;
constexpr int IN_COLS = 2496, C_COLS = 1056, DFF = 4096;
constexpr int KEYS = 8448;
constexpr float EPS = 1e-6f, LOG2E = 1.4426950408889634f;
constexpr int THREADS = 512;
constexpr int LDS_MAIN = 151552;
constexpr int LDS_BYTES = LDS_MAIN + 64;

constexpr size_t MiB = 1048576;
constexpr size_t OFF_CTL = 0;
constexpr size_t OFF_MODS = 65536;
constexpr size_t OFF_INVN = 262144;
constexpr size_t OFF_XC = 1 * MiB;
constexpr size_t OFF_W = 3 * MiB;
constexpr size_t OFF_WIN = OFF_W;
constexpr size_t OFF_WOUT = OFF_WIN + (size_t)NWIN * 1024 * 2;
constexpr size_t OFF_W1 = OFF_WOUT + (size_t)1024 * 1024 * 2;
constexpr size_t OFF_W2 = OFF_W1 + (size_t)4096 * 1024 * 2;
constexpr size_t OFF_WUQ = OFF_W2 + (size_t)4096 * 1024 * 2;
constexpr size_t OFF_WUKV = OFF_WUQ + 384 * 256 * 2;
constexpr size_t OFF_WW2 = OFF_WUKV + 512 * 128 * 2;
constexpr size_t OFF_WA2 = OFF_WW2 + 2 * 256 * 64 * 2;
constexpr size_t OFF_WG2 = OFF_WA2 + 2 * 256 * 64 * 2;
constexpr size_t OFF_R = 27 * MiB + MiB / 8;
constexpr size_t EIGHTH = MiB / 8;
constexpr size_t OFF_H = OFF_R;
constexpr size_t OFF_BQ = OFF_R;
constexpr size_t OFF_BK = OFF_R + 99 * EIGHTH;
constexpr size_t OFF_VTB = OFF_R + 198 * EIGHTH;
constexpr size_t OFF_ZA = OFF_R + 33 * MiB;
constexpr size_t OFF_ZD = OFF_ZA + 132 * EIGHTH;
constexpr size_t OFF_ZB = OFF_ZD + 132 * EIGHTH;
constexpr size_t OFF_ZC = OFF_ZB + 132 * EIGHTH;
constexpr size_t OFF_OUTS = OFF_ZC;
constexpr size_t OFF_SCANIN = OFF_ZC + 297 * EIGHTH;
constexpr size_t OFF_G = OFF_SCANIN + 462 * EIGHTH;
constexpr size_t OFF_Y = OFF_G + 66 * EIGHTH;
constexpr size_t OFF_TMPW = OFF_Y;
constexpr size_t OFF_TMPA = OFF_TMPW + (size_t)NT * 64 * 2;
constexpr size_t OFF_TMPG = OFF_TMPA + (size_t)NT * 64 * 2;
constexpr size_t OFF_VTA = OFF_Y + 33 * MiB;
constexpr size_t OFF_VTD = OFF_VTA + 33 * EIGHTH;
constexpr size_t OFF_YMIX = OFF_R;
constexpr size_t OFF_H2 = 223 * MiB;
constexpr size_t OFF_U = OFF_R;
constexpr size_t OFF_Y2 = OFF_R + 132 * MiB;
constexpr size_t OFF_SLAB1 = OFF_ZB;
constexpr size_t OFF_SLAB2 = 226 * MiB;
constexpr size_t WS_NEED = 256 * MiB;
static_assert(OFF_VTD + 33 * EIGHTH <= 256 * MiB, "ws");
static_assert(OFF_Y2 + (size_t)NT * 1024 * 4 <= 256 * MiB && OFF_H2 + (size_t)NT * 1024 * 2 <= 256 * MiB, "ws2");
static_assert(OFF_WG2 + 256 * 192 * 2 <= OFF_R, "ws w");

struct Params {
  const float *x, *c, *ctx, *c_ctx, *w_mod, *b_mod, *g_pre_mix, *g_post_mix, *g_pre_mlp, *g_post_mlp, *w_in,
      *gqa_q_norm, *gqa_k_norm, *mla_q_norm, *mla_kv_norm, *mla_w_uq, *mla_w_ukv, *rwkv_mu, *rwkv_w0, *rwkv_w2,
      *rwkv_a0, *rwkv_a2, *rwkv_k_k, *rwkv_k_a, *rwkv_r_k, *rwkv_g2, *rwkv_ln_w, *rwkv_ln_b, *swa_sink, *w_out,
      *w_mlp1, *w_mlp2;
  float* out;
  char* ws;
};

DI int obid() { int b = blockIdx.x; asm volatile("" : "+s"(b)); return b; }
DI int otid() { int t = threadIdx.x; asm volatile("" : "+v"(t)); return t; }
DI float bf2f(bf16_t b) { return __uint_as_float(((unsigned)b) << 16); }
typedef __bf16 bf2v_t __attribute__((ext_vector_type(2)));
typedef float f2v_t __attribute__((ext_vector_type(2)));
DI unsigned pack2(float a, float b) { f2v_t f = {a, b}; bf2v_t r = __builtin_convertvector(f, bf2v_t); return __builtin_bit_cast(unsigned, r); }
DI bf16_t f2bf(float x) { return (bf16_t)(pack2(x, 0.f) & 0xffffu); }
DI void st4bf(bf16_t* p, float a, float b, float c, float d) { uint2 v; v.x = pack2(a, b); v.y = pack2(c, d); *(uint2*)p = v; }
DI float wave_sum_slow(float v) {
#pragma unroll
  for (int o = 32; o > 0; o >>= 1) v += __shfl_xor(v, o);
  return v;
}
DI float fexp2(float x) { return __builtin_amdgcn_exp2f(x); }
DI float fexp(float x) { return __builtin_amdgcn_exp2f(x * LOG2E); }
DI float frcp(float x) { return __builtin_amdgcn_rcpf(x); }
DI float sigmoidf_(float x) { return frcp(1.f + fexp(-x)); }
DI float frsqrt(float x) { return __builtin_amdgcn_rsqf(x); }
DI int key_of_row(int m) { return m < NLAT ? (m & (T_ - 1)) : T_ + ((m - NLAT) & (CTXL - 1)); }
DI int batch_of_row(int m) { return m < NLAT ? (m >> 13) : ((m - NLAT) >> 8); }
DI int mods_slot(int m) { return m < NLAT ? (m >> 13) : 2; }
template <int CTRL> DI float dpp_mov(float v) {
  return __builtin_bit_cast(float, __builtin_amdgcn_update_dpp(0, __builtin_bit_cast(int, v), CTRL, 0xf, 0xf, false));
}
DI float allreduce16(float v) {
  v += dpp_mov<0x128>(v);
  v += dpp_mov<0x124>(v);
  v += dpp_mov<0x122>(v);
  v += dpp_mov<0x121>(v);
  return v;
}
DI float wave_sum(float v) {
  v = allreduce16(v);
  { const auto sw = __builtin_amdgcn_permlane32_swap(__float_as_uint(v), __float_as_uint(v), false, false); v = __uint_as_float(sw[0]) + __uint_as_float(sw[1]); }
  v += __shfl_xor(v, 16);
  return v;
}

DI void phase_mods(const Params& p, char* smem) {
  float* s_silu = (float*)smem;
  float* s_red = s_silu + 3 * 1024;
  const int tid = otid(), lane = tid & 63, wave = tid >> 6;
  for (int i = tid; i < 3 * 1024; i += THREADS) {
    int sI = i >> 10, k = i & 1023;
    float v = (sI < 2) ? p.c[sI * 1024 + k] : p.c_ctx[k];
    s_silu[i] = v * sigmoidf_(v);
  }
  __syncthreads();
  float* mods = (float*)(p.ws + OFF_MODS);
  for (int item = obid(); item < 192; item += gridDim.x) {
    const int l = item / 96, n0 = (item % 96) * 64;
    float a0 = 0.f, a1 = 0.f, a2 = 0.f;
    const float* w = p.w_mod + (size_t)l * 1024 * 6144 + (size_t)(wave * 128) * 6144 + n0 + lane;
#pragma unroll 16
    for (int kk = 0; kk < 128; ++kk) {
      const int k = wave * 128 + kk;
      const float wv = w[(size_t)kk * 6144];
      a0 += s_silu[k] * wv; a1 += s_silu[1024 + k] * wv; a2 += s_silu[2048 + k] * wv;
    }
    s_red[(wave * 3 + 0) * 64 + lane] = a0; s_red[(wave * 3 + 1) * 64 + lane] = a1; s_red[(wave * 3 + 2) * 64 + lane] = a2;
    __syncthreads();
    if (tid < 192) {
      const int sI = tid >> 6, j = tid & 63;
      float acc = p.b_mod[l * 6144 + n0 + j];
#pragma unroll
      for (int w8 = 0; w8 < 8; ++w8) acc += s_red[(w8 * 3 + sI) * 64 + j];
      mods[(size_t)(l * 3 + sI) * 6144 + n0 + j] = acc;
    }
    __syncthreads();
  }
}

struct RowMapId { DI int operator()(int n) const { return n; } };
struct RowMapWin { DI int operator()(int n) const { return n < 512 ? n : (n < 928 ? n : (n < 1984 ? n + 96 : n + 320)); } };
template <class RM>
DI void conv_T(const float* __restrict__ src, int K, int N, bf16_t* __restrict__ dst, int ldd, int Kpad, RM rm, int& rot, char* smem) {
  float* tile = (float*)smem;
  const int tid = otid(), G = gridDim.x;
  const int kt_n = Kpad >> 6, nt_n = N >> 6, total = kt_n * nt_n;
  int first = (int)((obid() + G - (rot % G)) % G);
  const int lk = tid >> 4, ln4 = (tid & 15) * 4;
  const int sn = tid >> 3, sk8 = (tid & 7) * 8;
  for (int t = first; t < total; t += G) {
    const int k0 = (t / nt_n) << 6, n0 = (t % nt_n) << 6;
    float4 v0 = make_float4(0.f, 0.f, 0.f, 0.f), v1 = make_float4(0.f, 0.f, 0.f, 0.f);
    if (k0 + lk < K) v0 = *(const float4*)(src + (size_t)(k0 + lk) * N + n0 + ln4);
    if (k0 + lk + 32 < K) v1 = *(const float4*)(src + (size_t)(k0 + lk + 32) * N + n0 + ln4);
    *(float4*)(tile + lk * 68 + ln4) = v0;
    *(float4*)(tile + (lk + 32) * 68 + ln4) = v1;
    __syncthreads();
    float f[8];
#pragma unroll
    for (int e = 0; e < 8; ++e) f[e] = tile[(sk8 + e) * 68 + sn];
    *(uint4*)(dst + (size_t)rm(n0 + sn) * ldd + k0 + sk8) = make_uint4(pack2(f[0], f[1]), pack2(f[2], f[3]), pack2(f[4], f[5]), pack2(f[6], f[7]));
    __syncthreads();
  }
  rot += total;
}
DI void phase_convert(const Params& p, int l, char* smem) {
  char* ws = p.ws;
  int rot = 0;
  conv_T(p.w_in + (size_t)l * 1024 * IN_COLS, 1024, IN_COLS, (bf16_t*)(ws + OFF_WIN), 1024, 1024, RowMapWin(), rot, smem);
  conv_T(p.w_out + (size_t)l * 1024 * 1024, 1024, 1024, (bf16_t*)(ws + OFF_WOUT), 1024, 1024, RowMapId(), rot, smem);
  conv_T(p.w_mlp1 + (size_t)l * 1024 * 4096, 1024, 4096, (bf16_t*)(ws + OFF_W1), 1024, 1024, RowMapId(), rot, smem);
  conv_T(p.w_mlp2 + (size_t)l * 4096 * 1024, 4096, 1024, (bf16_t*)(ws + OFF_W2), 4096, 4096, RowMapId(), rot, smem);
  conv_T(p.mla_w_uq + (size_t)l * 256 * 384, 256, 384, (bf16_t*)(ws + OFF_WUQ), 256, 256, RowMapId(), rot, smem);
  conv_T(p.mla_w_ukv + (size_t)l * 128 * 512, 128, 512, (bf16_t*)(ws + OFF_WUKV), 128, 128, RowMapId(), rot, smem);
  for (int d = 0; d < 2; ++d) {
    conv_T(p.rwkv_w2 + (size_t)(l * 2 + d) * 64 * 256, 64, 256, (bf16_t*)(ws + OFF_WW2) + d * 256 * 64, 64, 64, RowMapId(), rot, smem);
    conv_T(p.rwkv_a2 + (size_t)(l * 2 + d) * 64 * 256, 64, 256, (bf16_t*)(ws + OFF_WA2) + d * 256 * 64, 64, 64, RowMapId(), rot, smem);
  }
  conv_T(p.rwkv_g2 + (size_t)l * 160 * 256, 160, 256, (bf16_t*)(ws + OFF_WG2), 192, 192, RowMapId(), rot, smem);
}

DI void phase_rows(const Params& p, int nrows, const bf16_t* __restrict__ y, const float* xl_src, const float* xc_src,
                   float* xl_dst, float* xc_dst, const float* mods_y, int gt_off, const float* __restrict__ gpost, bool do_h,
                   const float* mods_h, int sh_off, int sc_off, const float* __restrict__ gpre, bf16_t* hdst, const float* yslab = nullptr, int nslab = 0) {
  const int tid_ = otid(); const int lane = tid_ & 63, wave = tid_ >> 6;
  float4 gpo[4], gpr[4], gtv[4], scv[4], shv[4];
#pragma unroll
  for (int i = 0; i < 4; ++i) {
    const int c = i * 256 + lane * 4;
    gpo[i] = y ? *(const float4*)(gpost + c) : make_float4(0.f, 0.f, 0.f, 0.f);
    gpr[i] = do_h ? *(const float4*)(gpre + c) : make_float4(0.f, 0.f, 0.f, 0.f);
    gtv[i] = scv[i] = shv[i] = make_float4(0.f, 0.f, 0.f, 0.f);
  }
  int cur_slot = -1;
  for (int row = obid() * 8 + wave; row < nrows; row += gridDim.x * 8) {
    const int slot = mods_slot(row);
    const float* xs = row < NLAT ? xl_src + (size_t)row * 1024 : xc_src + (size_t)(row - NLAT) * 1024;
    float4 xv[4];
#pragma unroll
    for (int i = 0; i < 4; ++i) xv[i] = *(const float4*)(xs + i * 256 + lane * 4);
    if (slot != cur_slot) {
      cur_slot = slot;
#pragma unroll
      for (int i = 0; i < 4; ++i) {
        const int c = i * 256 + lane * 4;
        if (y) gtv[i] = *(const float4*)(mods_y + (size_t)slot * 6144 + gt_off + c);
        if (do_h) { scv[i] = *(const float4*)(mods_h + (size_t)slot * 6144 + sc_off + c); shv[i] = *(const float4*)(mods_h + (size_t)slot * 6144 + sh_off + c); }
      }
    }
    if (y) {
      float4 yv[4];
      float ss = 0.f;
#pragma unroll
      for (int i = 0; i < 4; ++i) {
        if (nslab > 0 && row >= NLAT) {
          float4 a = make_float4(0.f, 0.f, 0.f, 0.f);
          for (int sidx = 0; sidx < nslab; ++sidx) {
            const float4 t4 = *(const float4*)(yslab + ((size_t)sidx * NCTX + (row - NLAT)) * 1024 + i * 256 + lane * 4);
            a.x += t4.x; a.y += t4.y; a.z += t4.z; a.w += t4.w;
          }
          yv[i] = a;
        } else
        { const uint2 u_ = *(const uint2*)(y + (size_t)row * 1024 + i * 256 + lane * 4);
          yv[i] = make_float4(__uint_as_float(u_.x << 16), __uint_as_float(u_.x & 0xffff0000u), __uint_as_float(u_.y << 16), __uint_as_float(u_.y & 0xffff0000u)); }
        ss += yv[i].x * yv[i].x + yv[i].y * yv[i].y + yv[i].z * yv[i].z + yv[i].w * yv[i].w;
      }
      ss = wave_sum(ss);
      const float rs = frsqrt(ss * (1.f / 1024.f) + EPS);
      float* xd = row < NLAT ? xl_dst + (size_t)row * 1024 : xc_dst + (size_t)(row - NLAT) * 1024;
#pragma unroll
      for (int i = 0; i < 4; ++i) {
        const int c = i * 256 + lane * 4;
        const float4 g = gpo[i], t = gtv[i];
        xv[i].x += t.x * (yv[i].x * rs * g.x); xv[i].y += t.y * (yv[i].y * rs * g.y);
        xv[i].z += t.z * (yv[i].z * rs * g.z); xv[i].w += t.w * (yv[i].w * rs * g.w);
        *(float4*)(xd + c) = xv[i];
      }
    }
    if (do_h) {
      float ss = 0.f;
#pragma unroll
      for (int i = 0; i < 4; ++i) ss += xv[i].x * xv[i].x + xv[i].y * xv[i].y + xv[i].z * xv[i].z + xv[i].w * xv[i].w;
      ss = wave_sum(ss);
      const float rs = frsqrt(ss * (1.f / 1024.f) + EPS);
#pragma unroll
      for (int i = 0; i < 4; ++i) {
        const int c = i * 256 + lane * 4;
        const float4 g = gpr[i], a = scv[i], b = shv[i];
        st4bf(hdst + (size_t)row * 1024 + c, xv[i].x * rs * g.x * (1.f + a.x) + b.x, xv[i].y * rs * g.y * (1.f + a.y) + b.y,
              xv[i].z * rs * g.z * (1.f + a.z) + b.z, xv[i].w * rs * g.w * (1.f + a.w) + b.w);
      }
    }
  }
}

namespace pg8 {
#define PG8_LAS __attribute__((address_space(3)))
typedef unsigned short bf16_t;
typedef short bf16x8 __attribute__((ext_vector_type(8)));
typedef float f32x4 __attribute__((ext_vector_type(4)));
typedef unsigned u32x4 __attribute__((ext_vector_type(4)));
constexpr int BM = 256, BK = 64, HALF = 128, HTB = HALF * BK * 2  , STAGE_BYTES = 8 * HTB, NXCD = 8, WGM = 8;

__host__ __device__ __forceinline__ int lds_byte(int r, int c) { const int st = (r >> 4) * 2 + (c >> 5), rr = r & 15, cc = c & 31, ob = rr * 64 + cc * 2; return st * 1024 + (ob ^ (((ob >> 9) & 1) << 5)); }
__host__ __device__ __forceinline__ void stage_rc(int b, int& R, int& C) { const int st = b / 1024, sb = b % 1024, swz = sb ^ (((sb >> 9) & 1) << 5); R = (st >> 1) * 16 + swz / 64; C = (st & 1) * 32 + (swz % 64) / 2; }
__host__ __device__ __forceinline__ int perm32(int rho) { const int n = rho >> 4, i = rho & 15; return 8 * (i >> 2) + 4 * n + (i & 3); }

struct Unit { int pm, pn; };
struct Gemm { const bf16_t* A; const bf16_t* Bt; int M, N, K, ld; };

struct StaticOrder {
    int nM, nN, nwg, G, c;
    __host__ __device__ void init(int M, int N, int G_, int c_) { nM = M / BM; nN = N / BM; nwg = nM * nN; G = G_; c = c_; }
    __host__ __device__ bool next(int i, Unit& u) const {
        const long L = (long)i * G + c; if (L >= nwg) return false;
        int wgid = (int)L; { const int q = nwg / NXCD, r = nwg % NXCD, xcd = wgid % NXCD, off = wgid / NXCD; wgid = (xcd < r ? xcd * (q + 1) : r * (q + 1) + (xcd - r) * q) + off; }
        const int nig = WGM * nN, gid = wgid / nig, fm = gid * WGM, gsz = (nM - fm) < WGM ? (nM - fm) : WGM;
        u.pm = fm + ((wgid % nig) % gsz); u.pn = (wgid % nig) / gsz; return true;
    }
    __device__ __forceinline__ void a_ready(const Unit&) const {}
    __device__ __forceinline__ void done(const Unit&) const {}
};

struct PEpiBf16 {
    static constexpr bool PERM = true, AFTER_DRAIN = false;
    bf16_t* O; int ldc; bool sqrelu;
    __device__ __forceinline__ void operator()(const f32x4 (&acc)[2][2][4][2], const Unit& u, int wr, int wc, int fr, int fq) const {
        const int row0 = u.pm * BM + wr * 64 + fr, col0 = u.pn * BM + wc * 32 + 8 * fq;
#pragma unroll
        for (int ai = 0; ai < 2; ++ai)
#pragma unroll
            for (int m = 0; m < 4; ++m) { bf16_t* rowp = O + (size_t)(row0 + ai * HALF + m * 16) * ldc + col0;
#pragma unroll
                for (int bj = 0; bj < 2; ++bj) { f32x4 v0 = acc[ai][bj][m][0], v1 = acc[ai][bj][m][1];
                    if (sqrelu) { v0 = __builtin_elementwise_max(v0, (f32x4){0.f, 0.f, 0.f, 0.f}); v1 = __builtin_elementwise_max(v1, (f32x4){0.f, 0.f, 0.f, 0.f}); v0 = v0 * v0; v1 = v1 * v1; }
                    u32x4 w; w.x = ::pack2(v0[0], v0[1]); w.y = ::pack2(v0[2], v0[3]); w.z = ::pack2(v1[0], v1[1]); w.w = ::pack2(v1[2], v1[3]);
                    *(u32x4*)(rowp + bj * HALF) = w; } }
    }
};
struct PieceOrder {
    int pm, pn; bool have;
    __device__ __forceinline__ bool next(int i, Unit& u) const { if (i != 0 || !have) return false; u.pm = pm; u.pn = pn; return true; }
    __device__ __forceinline__ void a_ready(const Unit&) const {}
    __device__ __forceinline__ void done(const Unit&) const {}
};
struct WinCOrder {
    int G, c;
    __device__ __forceinline__ bool next(int i, Unit& u) const {
        const long L = (long)i * G + c; if (L >= 342) return false;
        if (L < 330) { u.pm = (int)(L / 5); u.pn = 4 + (int)(L % 5); }
        else { const int j = (int)L - 330, k6 = j % 6; u.pm = 64 + j / 6; u.pn = k6 < 4 ? k6 : k6 + 5; }
        return true; }
    __device__ __forceinline__ void a_ready(const Unit&) const {}
    __device__ __forceinline__ void done(const Unit&) const {}
};
struct PEpiF32 {
    static constexpr bool PERM = true, AFTER_DRAIN = false;
    float* O; int ldc;
    __device__ __forceinline__ void operator()(const f32x4 (&acc)[2][2][4][2], const Unit& u, int wr, int wc, int fr, int fq) const {
        const int row0 = u.pm * BM + wr * 64 + fr, col0 = u.pn * BM + wc * 32 + 8 * fq;
#pragma unroll
        for (int ai = 0; ai < 2; ++ai)
#pragma unroll
            for (int m = 0; m < 4; ++m) { float* rowp = O + (size_t)(row0 + ai * HALF + m * 16) * ldc + col0;
#pragma unroll
                for (int bj = 0; bj < 2; ++bj) { *(f32x4*)(rowp + bj * HALF) = acc[ai][bj][m][0]; *(f32x4*)(rowp + bj * HALF + 4) = acc[ai][bj][m][1]; } }
    }
};
struct PEpiWin {
    static constexpr bool PERM = true, AFTER_DRAIN = false;
    bf16_t *za, *zb, *zc, *zd, *vta, *vtd;
    __device__ __forceinline__ void operator()(const f32x4 (&acc)[2][2][4][2], const Unit& u, int wr, int wc, int fr, int fq) const {
        const int row0 = u.pm * BM + wr * 64 + fr;
#pragma unroll
        for (int bj = 0; bj < 2; ++bj) {
            const int pc = u.pn * BM + bj * HALF + wc * 32 + 8 * fq;
            bf16_t* dst; int col, ld; bf16_t* vt = nullptr; bool ok = true;
            if (pc < 512) { col = pc; dst = za; ld = 512; if (col >= 384) vt = vta; }
            else if (pc < 1024) { col = pc - 512; dst = zb; ld = 512; }
            else if (pc < 2304) { col = pc - 1024; dst = zc; ld = 1152; ok = col < 1152; }
            else { col = pc - 2304; dst = zd; ld = 512; if (col >= 384) vt = vtd; }
#pragma unroll
            for (int ai = 0; ai < 2; ++ai)
#pragma unroll
                for (int m = 0; m < 4; ++m) {
                    const int r = row0 + ai * HALF + m * 16;
                    const f32x4 v0 = acc[ai][bj][m][0], v1 = acc[ai][bj][m][1];
                    if (vt) {
                        bf16_t* base = vt + ((size_t)::batch_of_row(r) * 128 + (col - 384)) * KEYS + ::key_of_row(r);
                        base[0] = ::f2bf(v0[0]); base[(size_t)KEYS] = ::f2bf(v0[1]); base[(size_t)2 * KEYS] = ::f2bf(v0[2]); base[(size_t)3 * KEYS] = ::f2bf(v0[3]);
                        base[(size_t)4 * KEYS] = ::f2bf(v1[0]); base[(size_t)5 * KEYS] = ::f2bf(v1[1]); base[(size_t)6 * KEYS] = ::f2bf(v1[2]); base[(size_t)7 * KEYS] = ::f2bf(v1[3]);
                    } else if (ok) {
                        u32x4 w; w.x = ::pack2(v0[0], v0[1]); w.y = ::pack2(v0[2], v0[3]); w.z = ::pack2(v1[0], v1[1]); w.w = ::pack2(v1[2], v1[3]);
                        *(u32x4*)(dst + (size_t)r * ld + col) = w;
                    }
                }
        }
    }
};

template <class Epi, class Sched, bool ALIGN_EPI = false, bool SP2 = false>
__device__ __forceinline__ void gemm_phase(PG8_LAS unsigned char* lds, const Gemm g, const Sched& S, const Epi& E) {
    const int tid = otid(), wid = __builtin_amdgcn_readfirstlane(tid >> 6), lane = tid & 63, wr = wid >> 2, wc = wid & 3, fr = lane & 15, fq = lane >> 4;
    const int K = g.ld, nt = g.K / BK;
    unsigned voffA[2], voffB[2];
#pragma unroll
    for (int i = 0; i < 2; ++i) { int R, C; stage_rc(tid * 16 + i * 8192, R, C); const int Rb = Epi::PERM ? ((R & ~31) + perm32(R & 31)) : R;
        voffA[i] = (unsigned)(R * K + C) * 2u; voffB[i] = (unsigned)(Rb * K + C) * 2u; }
    const size_t kstep = (size_t)(BK * 2);
    const size_t hstep = (size_t)HALF * K * 2;
    const size_t tstep = 2 * hstep;
    const unsigned ldsw = (unsigned)wid * 1024u;
    const int aoff = lds_byte(wr * 64 + fr, fq * 8), boff = lds_byte(wc * 32 + fr, fq * 8);
#define PG8_SA(b, h) (((b) * 2 + (h)) * HTB)
#define PG8_SB(b, h) ((4 + (b) * 2 + (h)) * HTB)
#define PG8_STAGE(bufoff, gbase, voff) do { _Pragma("unroll") for (int _i = 0; _i < 2; ++_i) \
        __builtin_amdgcn_global_load_lds((const unsigned*)((const char*)(gbase) + (voff)[_i]), (PG8_LAS unsigned*)(lds + (bufoff) + ldsw + _i * 8192), 16, 0, 0); } while (0)
#define PG8_LDA(dst, b, h) do { _Pragma("unroll") for (int m = 0; m < 4; ++m) _Pragma("unroll") for (int k = 0; k < 2; ++k) dst[m][k] = *(const PG8_LAS bf16x8*)(lds + PG8_SA(b, h) + aoff + m * 2048 + k * 1024); } while (0)
#define PG8_LDB(dst, b, h) do { _Pragma("unroll") for (int n = 0; n < 2; ++n) _Pragma("unroll") for (int k = 0; k < 2; ++k) dst[n][k] = *(const PG8_LAS bf16x8*)(lds + PG8_SB(b, h) + boff + n * 2048 + k * 1024); } while (0)
#define PG8_MMA(ai, bj, At, Bt) do { __builtin_amdgcn_s_setprio(1); _Pragma("unroll") for (int m = 0; m < 4; ++m) _Pragma("unroll") for (int n = 0; n < 2; ++n) _Pragma("unroll") for (int k = 0; k < 2; ++k) \
        acc[ai][bj][m][n] = __builtin_amdgcn_mfma_f32_16x16x32_bf16(Bt[n][k], At[m][k], acc[ai][bj][m][n], 0, 0, 0); __builtin_amdgcn_s_setprio(0); } while (0)
#define PG8_WAIT_V(n) asm volatile("s_waitcnt vmcnt(" #n ")" ::: "memory")
#define PG8_WAIT_L(n) asm volatile("s_waitcnt lgkmcnt(" #n ")" ::: "memory")
#define PG8_BAR __builtin_amdgcn_s_barrier()
#define PG8_SCHED __builtin_amdgcn_sched_barrier(0)
    Unit cur, nxt; int ui = 0;
    if (!S.next(0, cur)) return;
    f32x4 acc[2][2][4][2];
#pragma unroll
    for (int a = 0; a < 2; ++a)
#pragma unroll
        for (int b = 0; b < 2; ++b)
#pragma unroll
            for (int m = 0; m < 4; ++m)
#pragma unroll
                for (int n = 0; n < 2; ++n) acc[a][b][m][n] = (f32x4){0.f, 0.f, 0.f, 0.f};
    bf16x8 At[4][2], B0[2][2], B1[2][2];
    const char* cA = (const char*)g.A + (size_t)cur.pm * tstep; const char* cB = (const char*)g.Bt + (size_t)cur.pn * tstep;
    S.a_ready(cur);
    if constexpr (SP2) {
        PG8_STAGE(PG8_SB(0, 0), cB, voffB); PG8_STAGE(PG8_SB(0, 1), cB + hstep, voffB); PG8_STAGE(PG8_SA(0, 0), cA, voffA); PG8_STAGE(PG8_SA(0, 1), cA + hstep, voffA);
        if (wr == 1) PG8_BAR;
        PG8_WAIT_V(2); PG8_BAR;
        PG8_STAGE(PG8_SB(1, 0), cB + kstep, voffB); PG8_STAGE(PG8_SA(1, 0), cA + kstep, voffA); PG8_STAGE(PG8_SB(1, 1), cB + hstep + kstep, voffB);
        PG8_WAIT_V(6); PG8_BAR;
    } else {
        PG8_STAGE(PG8_SB(0, 0), cB, voffB); PG8_STAGE(PG8_SA(0, 0), cA, voffA); PG8_STAGE(PG8_SB(0, 1), cB + hstep, voffB); PG8_STAGE(PG8_SA(0, 1), cA + hstep, voffA);
        if (wr == 1) PG8_BAR;
        PG8_WAIT_V(4); PG8_BAR;
        PG8_STAGE(PG8_SB(1, 0), cB + kstep, voffB); PG8_STAGE(PG8_SA(1, 0), cA + kstep, voffA); PG8_STAGE(PG8_SB(1, 1), cB + hstep + kstep, voffB);
        PG8_WAIT_V(6); PG8_BAR;
    }
    for (;;) {
        const bool has_next = S.next(ui + 1, nxt);
        const char* nA = has_next ? (const char*)g.A + (size_t)nxt.pm * tstep : cA; const char* nB = has_next ? (const char*)g.Bt + (size_t)nxt.pn * tstep : cB;
        for (int t = 0; t < nt; t += 2) {
            const bool last = (t == nt - 2);
            const char* a1 = cA + (size_t)(t + 1) * kstep;
            const char* a2 = last ? nA : cA + (size_t)(t + 2) * kstep; const char* b2 = last ? nB : cB + (size_t)(t + 2) * kstep;
            const char* a3 = a2 + kstep; const char* b3 = b2 + kstep;
            if (last && has_next) S.a_ready(nxt);
            if constexpr (SP2) {
            PG8_LDB(B0, 0, 0); PG8_LDB(B1, 0, 1); PG8_SCHED; PG8_LDA(At, 0, 0); PG8_STAGE(PG8_SA(1, 1), a1 + hstep, voffA);
            PG8_WAIT_V(8); PG8_WAIT_L(0); PG8_BAR; PG8_MMA(0, 0, At, B0); PG8_MMA(0, 1, At, B1); PG8_BAR; PG8_SCHED;
            PG8_LDA(At, 0, 1); PG8_STAGE(PG8_SB(0, 0), b2, voffB); PG8_STAGE(PG8_SB(0, 1), b2 + hstep, voffB); PG8_STAGE(PG8_SA(0, 0), a2, voffA);
            PG8_WAIT_V(8); PG8_WAIT_L(0); PG8_BAR; PG8_MMA(1, 0, At, B0); PG8_MMA(1, 1, At, B1); PG8_BAR; PG8_SCHED;
            PG8_LDB(B0, 1, 0); PG8_LDB(B1, 1, 1); PG8_SCHED; PG8_LDA(At, 1, 0); PG8_STAGE(PG8_SA(0, 1), a2 + hstep, voffA);
            PG8_WAIT_V(8); PG8_WAIT_L(0); PG8_BAR; PG8_MMA(0, 0, At, B0); PG8_MMA(0, 1, At, B1); PG8_BAR; PG8_SCHED;
            PG8_LDA(At, 1, 1); PG8_STAGE(PG8_SB(1, 0), b3, voffB); PG8_STAGE(PG8_SB(1, 1), b3 + hstep, voffB); PG8_STAGE(PG8_SA(1, 0), a3, voffA);
            PG8_WAIT_V(8); PG8_WAIT_L(0); PG8_BAR; PG8_MMA(1, 0, At, B0); PG8_MMA(1, 1, At, B1); PG8_BAR; PG8_SCHED;
            } else {
            PG8_LDB(B0, 0, 0); PG8_SCHED; PG8_LDA(At, 0, 0); PG8_STAGE(PG8_SA(1, 1), a1 + hstep, voffA);
            PG8_WAIT_L(8); PG8_BAR; PG8_WAIT_L(0); PG8_MMA(0, 0, At, B0); PG8_BAR; PG8_SCHED;
            PG8_LDB(B1, 0, 1); PG8_STAGE(PG8_SB(0, 0), b2, voffB);
            PG8_BAR; PG8_WAIT_L(0); PG8_MMA(0, 1, At, B1); PG8_BAR;
            PG8_LDA(At, 0, 1); PG8_STAGE(PG8_SA(0, 0), a2, voffA);
            PG8_BAR; PG8_WAIT_L(0); PG8_MMA(1, 0, At, B0); PG8_BAR; PG8_SCHED;
            PG8_STAGE(PG8_SB(0, 1), b2 + hstep, voffB);
            PG8_WAIT_V(6); PG8_BAR; PG8_MMA(1, 1, At, B1); PG8_BAR;
            PG8_LDB(B0, 1, 0); PG8_SCHED; PG8_LDA(At, 1, 0); PG8_STAGE(PG8_SA(0, 1), a2 + hstep, voffA);
            PG8_WAIT_L(8); PG8_BAR; PG8_WAIT_L(0); PG8_MMA(0, 0, At, B0); PG8_BAR; PG8_SCHED;
            PG8_LDB(B1, 1, 1); PG8_STAGE(PG8_SB(1, 0), b3, voffB);
            PG8_BAR; PG8_WAIT_L(0); PG8_MMA(0, 1, At, B1); PG8_BAR;
            PG8_LDA(At, 1, 1); PG8_STAGE(PG8_SA(1, 0), a3, voffA);
            PG8_BAR; PG8_WAIT_L(0); PG8_MMA(1, 0, At, B0); PG8_BAR; PG8_SCHED;
            PG8_STAGE(PG8_SB(1, 1), b3 + hstep, voffB);
            PG8_WAIT_V(6); PG8_BAR; PG8_MMA(1, 1, At, B1); PG8_BAR;
            }
        }
        if constexpr (ALIGN_EPI) { if (wr == 0) PG8_BAR; }
        if constexpr (!Epi::AFTER_DRAIN) { E(acc, cur, wr, wc, fr, fq); S.done(cur); }
        if (!has_next) break;
#pragma unroll
        for (int a = 0; a < 2; ++a)
#pragma unroll
            for (int b = 0; b < 2; ++b)
#pragma unroll
                for (int m = 0; m < 4; ++m)
#pragma unroll
                    for (int n = 0; n < 2; ++n) acc[a][b][m][n] = (f32x4){0.f, 0.f, 0.f, 0.f};
        cur = nxt; cA = nA; cB = nB; ++ui;
        if constexpr (ALIGN_EPI) { if (wr == 1) PG8_BAR; }
    }
    PG8_WAIT_V(0);
    if constexpr (!ALIGN_EPI) { if (wr == 0) PG8_BAR; }
    PG8_BAR;
    if constexpr (Epi::AFTER_DRAIN) { E.fused(acc, cur, wr, wc, fr, fq, lds, wid, lane); S.done(cur); }
#undef PG8_SA
#undef PG8_SB
#undef PG8_STAGE
#undef PG8_LDA
#undef PG8_LDB
#undef PG8_MMA
#undef PG8_WAIT_V
#undef PG8_WAIT_L
#undef PG8_BAR
#undef PG8_SCHED
}
}
template <class Epi>
DI void gemm_small_tile(const bf16_t* __restrict__ A, int lda, const bf16_t* __restrict__ W, int ldw, int mt, int nt, int K, char* smem, Epi epi) {
  bf16_t* As = (bf16_t*)smem;
  bf16_t* Bs = As + 2 * 256 * 72;
  const int tid = otid(), lane = tid & 63, wave = tid >> 6;
  const int wm = wave >> 1, wn = wave & 1, l = lane & 31, h = lane >> 5;
  const int nk = K >> 6;
  {
    const int m0 = mt * 256, n0 = nt * 128;
    f32x16 acc[2][2];
#pragma unroll
    for (int i = 0; i < 2; ++i)
#pragma unroll
      for (int j = 0; j < 2; ++j)
#pragma unroll
        for (int q = 0; q < 16; ++q) acc[i][j][q] = 0.f;
    uint4 sA0, sA1, sA2, sA3, sA4, sA5, sB0, sB1, sB2, sB3, sB4, sB5;
    const bf16_t* ap[4];
    const bf16_t* bp[2];
    int aoff[4], boff[2];
#pragma unroll
    for (int i = 0; i < 4; ++i) {
      int c = tid + THREADS * i, row = c >> 3, kc = c & 7;
      ap[i] = A + (size_t)(m0 + row) * lda + kc * 8;
      aoff[i] = row * 72 + kc * 8;
    }
#pragma unroll
    for (int i = 0; i < 2; ++i) {
      int c = tid + THREADS * i, row = c >> 3, kc = c & 7;
      bp[i] = W + (size_t)(n0 + row) * ldw + kc * 8;
      boff[i] = row * 72 + kc * 8;
    }
    const bf16_t* Ab = As + (wm * 64 + l) * 72 + 8 * h;
    const bf16_t* Bb = Bs + (wn * 64 + l) * 72 + 8 * h;
#define G_LOAD(P, KT) { const int k1_ = (KT) << 6; P##0 = *(const uint4*)(ap[0] + k1_); P##1 = *(const uint4*)(ap[1] + k1_); P##2 = *(const uint4*)(ap[2] + k1_); \
                        P##3 = *(const uint4*)(ap[3] + k1_); P##4 = *(const uint4*)(bp[0] + k1_); P##5 = *(const uint4*)(bp[1] + k1_); }
#define G_STORE(P, BUF) { *(uint4*)(As + (BUF) * 256 * 72 + aoff[0]) = P##0; *(uint4*)(As + (BUF) * 256 * 72 + aoff[1]) = P##1; *(uint4*)(As + (BUF) * 256 * 72 + aoff[2]) = P##2; \
                          *(uint4*)(As + (BUF) * 256 * 72 + aoff[3]) = P##3; *(uint4*)(Bs + (BUF) * 128 * 72 + boff[0]) = P##4; *(uint4*)(Bs + (BUF) * 128 * 72 + boff[1]) = P##5; }
#define G_COMPUTE(BUF) { _Pragma("unroll") for (int ks = 0; ks < 4; ++ks) { bf16x8 af[2], bfr[2]; \
        af[0] = *(const bf16x8*)(Ab + (BUF) * 256 * 72 + ks * 16); af[1] = *(const bf16x8*)(Ab + (BUF) * 256 * 72 + 32 * 72 + ks * 16); \
        bfr[0] = *(const bf16x8*)(Bb + (BUF) * 128 * 72 + ks * 16); bfr[1] = *(const bf16x8*)(Bb + (BUF) * 128 * 72 + 32 * 72 + ks * 16); \
        _Pragma("unroll") for (int i = 0; i < 2; ++i) _Pragma("unroll") for (int j = 0; j < 2; ++j) acc[i][j] = MFMA32(bfr[j], af[i], acc[i][j]); } }
    G_LOAD(sA, 0);
    sB0 = sA0; sB1 = sA1; sB2 = sA2; sB3 = sA3; sB4 = sA4; sB5 = sA5;
    if (nk > 1) G_LOAD(sB, 1);
    for (int kt = 0; kt < nk; kt += 2) {
      G_STORE(sA, 0);
      __syncthreads();
      if (kt + 2 < nk) G_LOAD(sA, kt + 2);
      G_COMPUTE(0);
      if (kt + 1 < nk) {
        G_STORE(sB, 1);
        __syncthreads();
        if (kt + 3 < nk) G_LOAD(sB, kt + 3);
        G_COMPUTE(1);
      }
    }
    __syncthreads();
#pragma unroll
    for (int i = 0; i < 2; ++i)
#pragma unroll
      for (int j = 0; j < 2; ++j) epi(m0 + wm * 64 + 32 * i + l, n0 + wn * 64 + 32 * j, h, acc[i][j]);
  }
#undef G_LOAD
#undef G_STORE
#undef G_COMPUTE
}
template <class Epi>
DI void gemm_small(const bf16_t* __restrict__ A, int lda, const bf16_t* __restrict__ W, int ldw, int mtiles, int ntiles, int K,
                   int& rot, char* smem, Epi epi) {
  const int G = gridDim.x, total = mtiles * ntiles;
  int first = (int)((obid() + G - (rot % G)) % G);
#pragma unroll 1
  for (int tile = first; tile < total; tile += G) {
    const int mt = tile / ntiles, nt = tile - mt * ntiles;
    gemm_small_tile(A, lda, W, ldw, mt, nt, K, smem, epi);
  }
  rot += total;
}

struct EpiUq {
  bf16_t* bq;
  DI void operator()(int m, int nbase, int h, const f32x16& a) const {
    const float qs = 0.10206207261596577f * LOG2E;
    const bool rope = ((nbase % 96) == 64) && (m < NLAT);
    float o[16];
    if (rope) {
      const int t = m & (T_ - 1);
#pragma unroll
      for (int g = 0; g < 4; ++g) {
        const float pos = (g >> 1) ? (float)(t & 63) : (float)(t >> 6);
#pragma unroll
        for (int c = 0; c < 4; ++c) {
          const int fi = 4 * h + c;
          const float inv = fexp2(-(float)fi * (13.287712379549449f / 8.f));
          const float rev = pos * inv * 0.15915494309189535f;
          const float sn = __builtin_amdgcn_sinf(rev), cs = __builtin_amdgcn_cosf(rev);
          const float own = a[4 * g + c], par = a[4 * (g ^ 1) + c];
          o[4 * g + c] = (g & 1) ? (par * sn + own * cs) : (own * cs - par * sn);
        }
      }
    } else {
#pragma unroll
      for (int q = 0; q < 16; ++q) o[q] = a[q];
    }
    bf16_t* dst = bq + (size_t)m * 384 + nbase + 4 * h;
#pragma unroll
    for (int g = 0; g < 4; ++g) st4bf(dst + 8 * g, o[4 * g] * qs, o[4 * g + 1] * qs, o[4 * g + 2] * qs, o[4 * g + 3] * qs);
  }
};
struct EpiUkv {
  bf16_t *bk, *vtb;
  DI void operator()(int m, int nbase, int h, const f32x16& a) const {
    const int head = nbase >> 7, dd = nbase & 127;
    if (dd < 64) {
      bf16_t* dst = bk + (size_t)m * 384 + head * 96 + dd + 4 * h;
#pragma unroll
      for (int g = 0; g < 4; ++g) st4bf(dst + 8 * g, a[4 * g], a[4 * g + 1], a[4 * g + 2], a[4 * g + 3]);
    } else {
      const int b = batch_of_row(m), key = key_of_row(m);
      bf16_t* base = vtb + ((size_t)b * 256 + head * 64 + (dd - 64)) * KEYS + key;
#pragma unroll
      for (int g = 0; g < 4; ++g)
#pragma unroll
        for (int c = 0; c < 4; ++c) base[(size_t)(8 * g + 4 * h + c) * KEYS] = f2bf(a[4 * g + c]);
    }
  }
};
struct EpiUqkv {
  int type; bf16_t *bq, *bk, *vtb;
  DI void operator()(int m, int nbase, int h, const f32x16& a) const {
    if (type == 0) EpiUq{bq}(m, nbase, h, a); else EpiUkv{bk, vtb}(m, nbase, h, a);
  }
};
struct EpiWlora {
  bf16_t* dst; const float* w0;
  DI void operator()(int m, int nbase, int h, const f32x16& a) const {
    float o[16];
#pragma unroll
    for (int g = 0; g < 4; ++g)
#pragma unroll
      for (int c = 0; c < 4; ++c) {
        const float u = w0[nbase + 8 * g + 4 * h + c] + a[4 * g + c];
        const float ew = 0.6065306597126334f * sigmoidf_(u);
        o[4 * g + c] = 1.f - fexp(-ew);
      }
    bf16_t* d = dst + (size_t)m * 1792 + nbase + 4 * h;
#pragma unroll
    for (int g = 0; g < 4; ++g) st4bf(d + 8 * g, o[4 * g], o[4 * g + 1], o[4 * g + 2], o[4 * g + 3]);
  }
};
struct EpiAlora {
  bf16_t* dst; const float* a0;
  DI void operator()(int m, int nbase, int h, const f32x16& a) const {
    float o[16];
#pragma unroll
    for (int g = 0; g < 4; ++g)
#pragma unroll
      for (int c = 0; c < 4; ++c) o[4 * g + c] = sigmoidf_(a0[nbase + 8 * g + 4 * h + c] + a[4 * g + c]);
    bf16_t* d = dst + (size_t)m * 1792 + nbase + 4 * h;
#pragma unroll
    for (int g = 0; g < 4; ++g) st4bf(d + 8 * g, o[4 * g], o[4 * g + 1], o[4 * g + 2], o[4 * g + 3]);
  }
};
struct EpiBf16 {
  bf16_t* dst; int ld; bool sqrelu;
  DI void operator()(int m, int nbase, int h, const f32x16& a) const {
    bf16_t* d = dst + (size_t)m * ld + nbase + 4 * h;
#pragma unroll
    for (int g = 0; g < 4; ++g) {
      float v0 = a[4 * g], v1 = a[4 * g + 1], v2 = a[4 * g + 2], v3 = a[4 * g + 3];
      if (sqrelu) { v0 = fmaxf(v0, 0.f); v1 = fmaxf(v1, 0.f); v2 = fmaxf(v2, 0.f); v3 = fmaxf(v3, 0.f); v0 *= v0; v1 *= v1; v2 *= v2; v3 *= v3; }
      st4bf(d + 8 * g, v0, v1, v2, v3);
    }
  }
};

DI void unpack8(const uint4 u, float* f) {
  f[0] = __uint_as_float(u.x << 16); f[1] = __uint_as_float(u.x & 0xffff0000u); f[2] = __uint_as_float(u.y << 16); f[3] = __uint_as_float(u.y & 0xffff0000u);
  f[4] = __uint_as_float(u.z << 16); f[5] = __uint_as_float(u.z & 0xffff0000u); f[6] = __uint_as_float(u.w << 16); f[7] = __uint_as_float(u.w & 0xffff0000u);
}
DI uint4 pack8(const float* f) { return make_uint4(pack2(f[0], f[1]), pack2(f[2], f[3]), pack2(f[4], f[5]), pack2(f[6], f[7])); }
DI float allreduce8(float v) {
  v += dpp_mov<0xB1>(v);
  v += dpp_mov<0x4E>(v);
  v += dpp_mov<0x141>(v);
  return v;
}
DI uint4 dpp_u4_xor2(uint4 u) {
  uint4 r;
  r.x = (unsigned)__builtin_amdgcn_update_dpp(0, (int)u.x, 0x4E, 0xf, 0xf, false); r.y = (unsigned)__builtin_amdgcn_update_dpp(0, (int)u.y, 0x4E, 0xf, 0xf, false);
  r.z = (unsigned)__builtin_amdgcn_update_dpp(0, (int)u.z, 0x4E, 0xf, 0xf, false); r.w = (unsigned)__builtin_amdgcn_update_dpp(0, (int)u.w, 0x4E, 0xf, 0xf, false);
  return r;
}
DI uint4 dpp_u4_xor1(uint4 u) {
  uint4 r;
  r.x = (unsigned)__builtin_amdgcn_update_dpp(0, (int)u.x, 0xB1, 0xf, 0xf, false); r.y = (unsigned)__builtin_amdgcn_update_dpp(0, (int)u.y, 0xB1, 0xf, 0xf, false);
  r.z = (unsigned)__builtin_amdgcn_update_dpp(0, (int)u.z, 0xB1, 0xf, 0xf, false); r.w = (unsigned)__builtin_amdgcn_update_dpp(0, (int)u.w, 0xB1, 0xf, 0xf, false);
  return r;
}
template <bool DO_ABD, bool DO_C>
DI void prep_rows(const Params& p, int l, int first, int end, int step) {
  char* ws = p.ws;
  const int tid_ = otid(); const int lane = tid_ & 63, wave = tid_ >> 6;
  bf16_t* ZA = (bf16_t*)(ws + OFF_ZA); bf16_t* ZD = (bf16_t*)(ws + OFF_ZD); bf16_t* ZB = (bf16_t*)(ws + OFF_ZB);
  const bf16_t* ZC = (const bf16_t*)(ws + OFF_ZC);
  bf16_t* BK = (bf16_t*)(ws + OFF_BK); bf16_t* SC = (bf16_t*)(ws + OFF_SCANIN);
  bf16_t* TW = (bf16_t*)(ws + OFF_TMPW); bf16_t* TA = (bf16_t*)(ws + OFF_TMPA); bf16_t* TG = (bf16_t*)(ws + OFF_TMPG);
  float* INVN = (float*)(ws + OFF_INVN);
  const float* mu = p.rwkv_mu + l * C_COLS;
  const float* kk0 = p.rwkv_k_k + (l * 2 + 0) * 256; const float* kk1 = p.rwkv_k_k + (l * 2 + 1) * 256;
  const int j = lane & 7;
  float gA[8], gAp[8];
  {
    const float* gsrc = (lane < 32 ? p.gqa_q_norm : p.gqa_k_norm) + l * 64;
#pragma unroll
    for (int e = 0; e < 8; ++e) { gA[e] = gsrc[8 * j + e]; gAp[e] = gsrc[(8 * j + e) ^ 16]; }
  }
  float inv64[8], inv32[8];
#pragma unroll
  for (int e = 0; e < 8; ++e) {
    inv64[e] = fexp2(-(float)(8 * (j & 1) + e) * (13.287712379549449f / 16.f)) * 0.15915494309189535f;
    inv32[e] = fexp2(-(float)e * (13.287712379549449f / 8.f)) * 0.15915494309189535f;
  }
  float gB[8];
#pragma unroll
  for (int e = 0; e < 8; ++e) gB[e] = lane < 32 ? p.mla_q_norm[l * 256 + 8 * lane + e] : (lane < 48 ? p.mla_kv_norm[l * 128 + 8 * (lane - 32) + e] : 0.f);
  float muc[3][8], kkc0[8], kkc1[8];
#pragma unroll
  for (int i = 0; i < 3; ++i)
#pragma unroll
    for (int e = 0; e < 8; ++e) { const int c = lane + 64 * i; muc[i][e] = (c < 132) ? mu[8 * c + e] : 0.f; }
#pragma unroll
  for (int e = 0; e < 8; ++e) { const int kc = (8 * lane - 256) & 255; kkc0[e] = kk0[kc + e]; kkc1[e] = kk1[kc + e]; }
  const bool x2_64 = (j >> 1) & 1, col64 = (j >> 2) & 1;
  const int jj = lane & 3; const bool x2_32 = jj & 1, col32 = (jj >> 1) & 1;
  for (int row = first + wave; row < end; row += step) {
    const bool lat = row < NLAT;
    const int t = row & (T_ - 1);
    const float prow = (float)(t >> 6), pcol = (float)(t & 63);
    uint4 ua = make_uint4(0, 0, 0, 0), ud = ua, ub = ua;
    if constexpr (DO_ABD) {
      ua = *(const uint4*)(ZA + (size_t)row * 512 + 8 * lane);
      ud = *(const uint4*)(ZD + (size_t)row * 512 + 8 * lane);
      ub = *(const uint4*)(ZB + (size_t)row * 512 + 8 * lane);
    }
    const int pos = lat ? t : ((row - NLAT) & (CTXL - 1));
    const int lastp = lat ? (T_ - 1) : (CTXL - 1);
    const bool hp = pos > 0, hn = pos < lastp;
    const bf16_t* zc = ZC + (size_t)row * 1152 + 8 * lane;
    uint4 c0[3], cp[3], cn[3];
#pragma unroll
    for (int i = 0; i < 3; ++i) {
      const bool ok = DO_C && ((i < 2) || (lane < 4));
      c0[i] = ok ? *(const uint4*)(zc + 512 * i) : make_uint4(0, 0, 0, 0);
      cp[i] = (ok && hp) ? *(const uint4*)(zc + 512 * i - 1152) : make_uint4(0, 0, 0, 0);
      cn[i] = (ok && hn) ? *(const uint4*)(zc + 512 * i + 1152) : make_uint4(0, 0, 0, 0);
    }
    if constexpr (DO_ABD) {
    float sn64[8], cs64[8], sn32[8], cs32[8];
    {
      const float p64 = col64 ? pcol : prow, p32 = col32 ? pcol : prow;
#pragma unroll
      for (int e = 0; e < 8; ++e) {
        const float r64 = lat ? p64 * inv64[e] : 0.f, r32 = lat ? p32 * inv32[e] : 0.f;
        sn64[e] = __builtin_amdgcn_sinf(r64); cs64[e] = __builtin_amdgcn_cosf(r64);
        sn32[e] = __builtin_amdgcn_sinf(r32); cs32[e] = __builtin_amdgcn_cosf(r32);
      }
    }
    {
      float x[8], xp[8];
      unpack8(ua, x); unpack8(dpp_u4_xor2(ua), xp);
      float ss = 0.f;
#pragma unroll
      for (int e = 0; e < 8; ++e) ss += x[e] * x[e];
      ss = allreduce8(ss);
      const float rs = frsqrt(ss * (1.f / 64.f) + EPS);
      const float sc = lane < 32 ? 0.125f * LOG2E : 1.f;
      float o[8];
#pragma unroll
      for (int e = 0; e < 8; ++e) {
        const float own = x[e] * rs * gA[e], par = xp[e] * rs * gAp[e];
        o[e] = (x2_64 ? (par * sn64[e] + own * cs64[e]) : (own * cs64[e] - par * sn64[e])) * sc;
      }
      if (lane < 48) *(uint4*)(ZA + (size_t)row * 512 + 8 * lane) = pack8(o);
    }
    {
      float x[8], xp[8];
      unpack8(ud, x); unpack8(dpp_u4_xor2(ud), xp);
      const float sc = lane < 32 ? 0.125f * LOG2E : 1.f;
      float o[8];
#pragma unroll
      for (int e = 0; e < 8; ++e) o[e] = (x2_64 ? (xp[e] * sn64[e] + x[e] * cs64[e]) : (x[e] * cs64[e] - xp[e] * sn64[e])) * sc;
      if (lane < 48) *(uint4*)(ZD + (size_t)row * 512 + 8 * lane) = pack8(o);
    }
    {
      float x[8], xp[8];
      unpack8(ub, x); unpack8(dpp_u4_xor1(ub), xp);
      float ss = 0.f;
#pragma unroll
      for (int e = 0; e < 8; ++e) ss += x[e] * x[e];
      const float s16 = allreduce16(ss);
      const float s32 = s16 + __shfl_xor(s16, 16);
      const float rs = lane < 32 ? frsqrt(s32 * (1.f / 256.f) + EPS) : frsqrt(s16 * (1.f / 128.f) + EPS);
      float o[8];
#pragma unroll
      for (int e = 0; e < 8; ++e) o[e] = x[e] * rs * gB[e];
      if (lane < 48) *(uint4*)(ZB + (size_t)row * 512 + 8 * lane) = pack8(o);
      float kr[8];
#pragma unroll
      for (int e = 0; e < 8; ++e) kr[e] = x2_32 ? (xp[e] * sn32[e] + x[e] * cs32[e]) : (x[e] * cs32[e] - xp[e] * sn32[e]);
      if (lane >= 48 && lane < 52) {
        const uint4 kb = pack8(kr);
        bf16_t* bk = BK + (size_t)row * 384 + 64 + 8 * jj;
        *(uint4*)(bk) = kb; *(uint4*)(bk + 96) = kb; *(uint4*)(bk + 192) = kb; *(uint4*)(bk + 288) = kb;
      }
    }
    }
    if constexpr (DO_C) {
#pragma unroll
    for (int i = 0; i < 3; ++i) {
      const int c = lane + 64 * i;
      if (c < 132) {
        float z[8], zp[8], zn[8], zs[8];
        unpack8(c0[i], z); unpack8(cp[i], zp); unpack8(cn[i], zn);
#pragma unroll
        for (int e = 0; e < 8; ++e) zs[e] = z[e] + muc[i][e] * (0.5f * (zp[e] + zn[e]) - z[e]);
        if (c < 96) {
          const uint4 pk = pack8(zs);
          *(uint4*)(SC + (size_t)row * 1792 + 8 * c) = pk;
          if (i == 0) {
            float kq[8]; unpack8(pk, kq);
            float s0 = 0.f, s1 = 0.f;
#pragma unroll
            for (int e = 0; e < 8; ++e) { const float a0 = kq[e] * kkc0[e], a1 = kq[e] * kkc1[e]; s0 += a0 * a0; s1 += a1 * a1; }
            s0 = allreduce8(s0); s1 = allreduce8(s1);
            if (lane >= 32 && j == 0) {
              const int hd = (lane - 32) >> 3;
              INVN[(size_t)row * 8 + hd] = fminf(frsqrt(s0), 1e12f);
              INVN[(size_t)row * 8 + 4 + hd] = fminf(frsqrt(s1), 1e12f);
            }
          }
        } else if (c < 104) {
          float o[8];
#pragma unroll
          for (int e = 0; e < 8; ++e) { const float ex = fexp(2.f * zs[e]); o[e] = 1.f - 2.f * frcp(ex + 1.f); }
          *(uint4*)(TW + (size_t)row * 64 + 8 * (c - 96)) = pack8(o);
        } else if (c < 112) {
          *(uint4*)(TA + (size_t)row * 64 + 8 * (c - 104)) = pack8(zs);
        } else {
          float o[8];
#pragma unroll
          for (int e = 0; e < 8; ++e) o[e] = sigmoidf_(zs[e]);
          *(uint4*)(TG + (size_t)row * 192 + 8 * (c - 112)) = pack8(o);
        }
      } else if (c < 136) {
        *(uint4*)(TG + (size_t)row * 192 + 8 * (c - 112)) = make_uint4(0, 0, 0, 0);
      }
    }
    }
  }
}

template <int DK>
DI void attn_item(const bf16_t* __restrict__ Q, int ldq, const bf16_t* __restrict__ Kg, int ldk, const bf16_t* __restrict__ Vt,
                  int qrow0, int b, int lat_t0, int lat_t1, bool window, int qpos0, bool use_sink, float sink_l2,
                  bf16_t* out, int ldo, char* smem) {
  constexpr int KS = DK + 8, NKS = DK / 16, CPR = DK / 8;
  bf16_t* Ks = (bf16_t*)smem;
  bf16_t* Vs = Ks + 2 * 64 * KS;
  const int tid = otid(), lane = tid & 63, wave = tid >> 6, l = lane & 31, h = lane >> 5;
  const int pl = (l & ~12) | ((l & 4) << 1) | ((l & 8) >> 1);
  const int nlat = lat_t1 - lat_t0, ntile = nlat + 4;
  bf16x8 qf[NKS];
  {
    const bf16_t* qp = Q + (size_t)(qrow0 + wave * 32 + l) * ldq + 8 * h;
#pragma unroll
    for (int ks = 0; ks < NKS; ++ks) qf[ks] = *(const bf16x8*)(qp + ks * 16);
  }
  f32x16 o0, o1;
#pragma unroll
  for (int q = 0; q < 16; ++q) { o0[q] = 0.f; o1[q] = 0.f; }
  if (wave >= 4) __builtin_amdgcn_s_setprio(1);
  float m_run = use_sink ? sink_l2 : -64.f;
  f32x16 o2;
#pragma unroll
  for (int q = 0; q < 16; ++q) o2[q] = 0.f;
  o2[0] = (use_sink && h == 0) ? 1.f : 0.f;
  bf16x8 vones;
#pragma unroll
  for (int e = 0; e < 8; ++e) vones[e] = (l == 0) ? (short)0x3F80 : (short)0;
  const int qp_ = qpos0 + wave * 32 + l;

  uint4 rk0, rk1 = make_uint4(0, 0, 0, 0), rv;
  const int krow_a = tid / CPR, kc_a = tid % CPR;
  const int krow_b = (tid + 512) / CPR, kc_b = (tid + 512) % CPR;
  const int vrow = tid >> 3, vkc = tid & 7;
  auto tile_src = [&](int i, int& krow_base, int& vcol) {
    if (i < nlat) { const int kt = lat_t0 + i; krow_base = b * T_ + kt * 64; vcol = kt * 64; }
    else { const int c = i - nlat; krow_base = NLAT + b * CTXL + c * 64; vcol = T_ + c * 64; }
  };
  {
    int kb, vc; tile_src(0, kb, vc);
    rk0 = *(const uint4*)(Kg + (size_t)(kb + krow_a) * ldk + kc_a * 8);
    if (DK == 96 && tid < 256) rk1 = *(const uint4*)(Kg + (size_t)(kb + krow_b) * ldk + kc_b * 8);
    rv = *(const uint4*)(Vt + (size_t)vrow * KEYS + vc + vkc * 8);
    *(uint4*)(Ks + krow_a * KS + kc_a * 8) = rk0;
    if (DK == 96 && tid < 256) *(uint4*)(Ks + krow_b * KS + kc_b * 8) = rk1;
    *(uint4*)(Vs + vrow * 72 + vkc * 8) = rv;
  }
  __syncthreads();
  for (int it = 0; it < ntile; ++it) {
    const int buf = it & 1;
    if (it + 1 < ntile) {
      int kb, vc; tile_src(it + 1, kb, vc);
      rk0 = *(const uint4*)(Kg + (size_t)(kb + krow_a) * ldk + kc_a * 8);
      if (DK == 96 && tid < 256) rk1 = *(const uint4*)(Kg + (size_t)(kb + krow_b) * ldk + kc_b * 8);
      rv = *(const uint4*)(Vt + (size_t)vrow * KEYS + vc + vkc * 8);
    }
    const bf16_t* Kb = Ks + buf * 64 * KS + pl * KS + 8 * h;
    const bf16_t* Vb = Vs + buf * 64 * 72 + l * 72 + 8 * h;
    f32x16 s0, s1;
    {
      const float nm = -m_run;
#pragma unroll
      for (int q = 0; q < 16; ++q) { s0[q] = nm; s1[q] = nm; }
    }
#pragma unroll
    for (int ks = 0; ks < NKS; ++ks) {
      const bf16x8 k0 = *(const bf16x8*)(Kb + ks * 16);
      const bf16x8 k1 = *(const bf16x8*)(Kb + 32 * KS + ks * 16);
      s0 = MFMA32(k0, qf[ks], s0);
      s1 = MFMA32(k1, qf[ks], s1);
    }
    if (window && it < nlat) {
      const int kbase = (lat_t0 + it) * 64 + 8 * h - qp_;
#pragma unroll
      for (int q = 0; q < 16; ++q) {
        const int d0 = kbase + 16 * (q >> 3) + (q & 7);
        const int d1 = d0 + 32;
        if (d0 > 128 || d0 < -128) s0[q] = -1e30f;
        if (d1 > 128 || d1 < -128) s1[q] = -1e30f;
      }
    }
    int di = 0;
#pragma unroll
    for (int q = 0; q < 16; q += 2) {
      const int a0 = __float_as_int(s0[q]), a1 = __float_as_int(s1[q]), a2 = __float_as_int(s0[q + 1]), a3 = __float_as_int(s1[q + 1]);
      di = max(max(di, a0), max(a1, max(a2, a3)));
    }
    float d = __int_as_float(di);
    { const auto sw = __builtin_amdgcn_permlane32_swap(__float_as_uint(d), __float_as_uint(d), false, false); d = fmaxf(__uint_as_float(sw[0]), __uint_as_float(sw[1])); }
    if (__any(d > 8.f)) {
      const float alpha = fexp2(-d);
      m_run += d;
      o2[0] *= alpha;
#pragma unroll
      for (int q = 0; q < 16; ++q) { s0[q] -= d; s1[q] -= d; o0[q] *= alpha; o1[q] *= alpha; }
    }
#pragma unroll
    for (int q = 0; q < 16; ++q) { s0[q] = fexp2(s0[q]); s1[q] = fexp2(s1[q]); }
    bf16x8 pf[4];
#pragma unroll
    for (int s4 = 0; s4 < 4; ++s4) {
      unsigned u[4];
#pragma unroll
      for (int j = 0; j < 4; ++j) {
        const float e0 = (s4 < 2) ? s0[8 * (s4 & 1) + 2 * j] : s1[8 * (s4 & 1) + 2 * j];
        const float e1 = (s4 < 2) ? s0[8 * (s4 & 1) + 2 * j + 1] : s1[8 * (s4 & 1) + 2 * j + 1];
        u[j] = pack2(e0, e1);
      }
      pf[s4] = __builtin_bit_cast(bf16x8, make_uint4(u[0], u[1], u[2], u[3]));
    }
#pragma unroll
    for (int s4 = 0; s4 < 4; ++s4) {
      const bf16x8 v0 = *(const bf16x8*)(Vb + s4 * 16);
      const bf16x8 v1 = *(const bf16x8*)(Vb + 32 * 72 + s4 * 16);
      o0 = MFMA32(v0, pf[s4], o0);
      o1 = MFMA32(v1, pf[s4], o1);
      o2 = MFMA32(vones, pf[s4], o2);
    }
    if (it + 1 < ntile) {
      const int nb = buf ^ 1;
      *(uint4*)(Ks + nb * 64 * KS + krow_a * KS + kc_a * 8) = rk0;
      if (DK == 96 && tid < 256) *(uint4*)(Ks + nb * 64 * KS + krow_b * KS + kc_b * 8) = rk1;
      *(uint4*)(Vs + nb * 64 * 72 + vrow * 72 + vkc * 8) = rv;
    }
    __syncthreads();
  }
  __builtin_amdgcn_s_setprio(0);
  float lt;
  { const float l_run = o2[0]; const auto sw = __builtin_amdgcn_permlane32_swap(__float_as_uint(l_run), __float_as_uint(l_run), false, false); lt = __uint_as_float(sw[0]) + __uint_as_float(sw[1]); }
  const float inv = frcp(lt);
  bf16_t* op = out + (size_t)(qrow0 + wave * 32 + l) * ldo + 4 * h;
#pragma unroll
  for (int g = 0; g < 4; ++g) {
    st4bf(op + 8 * g, o0[4 * g] * inv, o0[4 * g + 1] * inv, o0[4 * g + 2] * inv, o0[4 * g + 3] * inv);
    st4bf(op + 32 + 8 * g, o1[4 * g] * inv, o1[4 * g + 1] * inv, o1[4 * g + 2] * inv, o1[4 * g + 3] * inv);
  }
}

DI void run_attn_item(const Params& p, int l, int kind, int b, int hq, int qt, bool isctx, char* smem) {
  char* ws = p.ws;
  const bf16_t* ZA = (const bf16_t*)(ws + OFF_ZA); const bf16_t* ZD = (const bf16_t*)(ws + OFF_ZD);
  const bf16_t* BQ = (const bf16_t*)(ws + OFF_BQ); const bf16_t* BK = (const bf16_t*)(ws + OFF_BK);
  const bf16_t* VTA = (const bf16_t*)(ws + OFF_VTA); const bf16_t* VTB = (const bf16_t*)(ws + OFF_VTB); const bf16_t* VTD = (const bf16_t*)(ws + OFF_VTD);
  bf16_t* OUTS = (bf16_t*)(ws + OFF_OUTS);
  const int qrow0 = isctx ? NLAT + b * CTXL : b * T_ + qt * 256;
  int t0 = 0, t1 = isctx ? 0 : 128;
  if (kind == 0) {
    attn_item<96>(BQ + hq * 96, 384, BK + hq * 96, 384, VTB + ((size_t)b * 256 + hq * 64) * KEYS, qrow0, b, t0, t1, false, 0, false, 0.f,
                  OUTS + 256 + hq * 64, 1024, smem);
  } else if (kind == 1) {
    attn_item<64>(ZA + hq * 64, 512, ZA + 256 + (hq >> 1) * 64, 512, VTA + ((size_t)b * 128 + (hq >> 1) * 64) * KEYS, qrow0, b, t0, t1, false, 0,
                  false, 0.f, OUTS + hq * 64, 1024, smem);
  } else {
    if (!isctx) { t0 = 4 * qt - 2; if (t0 < 0) t0 = 0; t1 = 4 * qt + 6; if (t1 > 128) t1 = 128; }
    attn_item<64>(ZD + hq * 64, 512, ZD + 256 + (hq >> 1) * 64, 512, VTD + ((size_t)b * 128 + (hq >> 1) * 64) * KEYS, qrow0, b, t0, t1, !isctx,
                  qt * 256, true, p.swa_sink[l * 4 + hq] * LOG2E, OUTS + 768 + hq * 64, 1024, smem);
  }
}

constexpr int SCH = 32;
constexpr int SST = 336;
DI int scan_row(int b, int dir, int s) {
  if (s < CTXL) return NLAT + b * CTXL + (dir ? CTXL - 1 - s : s);
  const int s2 = s - CTXL;
  return b * T_ + (dir ? T_ - 1 - s2 : s2);
}
DI void scan_block(const Params& p, int l, int sb, char* smem) {
  float* opbuf = (float*)smem;
  float* ybuf = opbuf + 2 * SCH * SST;
  const int tid = otid(), lane = tid & 63, wave = tid >> 6;
  const int chain = sb >> 2, rg = sb & 3, b = chain >> 3, hh = (chain >> 1) & 3, dir = chain & 1;
  const bf16_t* SC = (const bf16_t*)(p.ws + OFF_SCANIN);
  float* Y = (float*)(p.ws + OFF_Y) + (size_t)dir * NT * 256;
  const int nchunk = (CTXL + T_) / SCH;
  const float* INVN = (const float*)(p.ws + OFF_INVN);
  const int ht = tid - 256, fg = ht & 15;
  float kkc[4], kac[4];
#pragma unroll
  for (int e = 0; e < 4; ++e) {
    kkc[e] = p.rwkv_k_k[(l * 2 + dir) * 256 + hh * 64 + ((4 * fg + e) & 63)];
    kac[e] = p.rwkv_k_a[(l * 2 + dir) * 256 + hh * 64 + ((4 * fg + e) & 63)];
  }
  struct HStage { uint2 r0, k0, v0, w0, a0, r1, k1, v1, w1, a1; float n0, n1; };
  auto issue = [&](HStage& h, int ci) {
    {
      const int row = scan_row(b, dir, ci * SCH + (ht >> 4));
      const bf16_t* src = SC + (size_t)row * 1792 + hh * 64 + 4 * fg;
      h.r0 = *(const uint2*)(src); h.k0 = *(const uint2*)(src + 256); h.v0 = *(const uint2*)(src + 512);
      h.w0 = *(const uint2*)(src + (3 + dir) * 256); h.a0 = *(const uint2*)(src + (5 + dir) * 256);
      h.n0 = INVN[(size_t)row * 8 + dir * 4 + hh];
    }
    {
      const int row = scan_row(b, dir, ci * SCH + (ht >> 4) + 16);
      const bf16_t* src = SC + (size_t)row * 1792 + hh * 64 + 4 * fg;
      h.r1 = *(const uint2*)(src); h.k1 = *(const uint2*)(src + 256); h.v1 = *(const uint2*)(src + 512);
      h.w1 = *(const uint2*)(src + (3 + dir) * 256); h.a1 = *(const uint2*)(src + (5 + dir) * 256);
      h.n1 = INVN[(size_t)row * 8 + dir * 4 + hh];
    }
  };
  auto commit1 = [&](uint2 lr, uint2 lk, uint2 lv, uint2 lw, uint2 la, float inn, int ls, int bi) {
    float* st = opbuf + ((size_t)bi * SCH + ls) * SST + 4 * fg;
    float r4[4], k4[4], v4[4], w4[4], a4[4];
    r4[0] = __uint_as_float(lr.x << 16); r4[1] = __uint_as_float(lr.x & 0xffff0000u); r4[2] = __uint_as_float(lr.y << 16); r4[3] = __uint_as_float(lr.y & 0xffff0000u);
    k4[0] = __uint_as_float(lk.x << 16); k4[1] = __uint_as_float(lk.x & 0xffff0000u); k4[2] = __uint_as_float(lk.y << 16); k4[3] = __uint_as_float(lk.y & 0xffff0000u);
    v4[0] = __uint_as_float(lv.x << 16); v4[1] = __uint_as_float(lv.x & 0xffff0000u); v4[2] = __uint_as_float(lv.y << 16); v4[3] = __uint_as_float(lv.y & 0xffff0000u);
    w4[0] = __uint_as_float(lw.x << 16); w4[1] = __uint_as_float(lw.x & 0xffff0000u); w4[2] = __uint_as_float(lw.y << 16); w4[3] = __uint_as_float(lw.y & 0xffff0000u);
    a4[0] = __uint_as_float(la.x << 16); a4[1] = __uint_as_float(la.x & 0xffff0000u); a4[2] = __uint_as_float(la.y << 16); a4[3] = __uint_as_float(la.y & 0xffff0000u);
    float kk[4];
#pragma unroll
    for (int e = 0; e < 4; ++e) kk[e] = k4[e] * kkc[e] * inn;
    *(float4*)(st) = make_float4(1.f - w4[0], 1.f - w4[1], 1.f - w4[2], 1.f - w4[3]);
    *(float4*)(st + 64) = make_float4(-kk[0], -kk[1], -kk[2], -kk[3]);
    *(float4*)(st + 128) = make_float4(kk[0] * a4[0], kk[1] * a4[1], kk[2] * a4[2], kk[3] * a4[3]);
    *(float4*)(st + 192) = make_float4(k4[0] * (1.f + (a4[0] - 1.f) * kac[0]), k4[1] * (1.f + (a4[1] - 1.f) * kac[1]),
                                       k4[2] * (1.f + (a4[2] - 1.f) * kac[2]), k4[3] * (1.f + (a4[3] - 1.f) * kac[3]));
    *(float4*)(st + 256) = make_float4(r4[0], r4[1], r4[2], r4[3]);
    if ((fg >> 2) == rg) *(float4*)(opbuf + ((size_t)bi * SCH + ls) * SST + 320 + 4 * (fg & 3)) = make_float4(v4[0], v4[1], v4[2], v4[3]);
  };
  auto commit = [&](const HStage& h, int bi) {
    commit1(h.r0, h.k0, h.v0, h.w0, h.a0, h.n0, (ht >> 4), bi);
    commit1(h.r1, h.k1, h.v1, h.w1, h.a1, h.n1, (ht >> 4) + 16, bi);
  };
  auto flush = [&](int ci) {
    const float* yb = ybuf + (size_t)(ci & 1) * SCH * 256;
#pragma unroll
    for (int i = 0; i < 2; ++i) {
      const int o = ht + 256 * i, ls = o >> 4, r16 = o & 15;
      const float* src = yb + ls * 256 + r16 * 16;
      const float4 a = *(const float4*)(src), b4 = *(const float4*)(src + 4), c = *(const float4*)(src + 8), d = *(const float4*)(src + 12);
      const float y = ((a.x + a.y) + (a.z + a.w)) + ((b4.x + b4.y) + (b4.z + b4.w)) + ((c.x + c.y) + (c.z + c.w)) + ((d.x + d.y) + (d.z + d.w));
      Y[(size_t)scan_row(b, dir, ci * SCH + ls) * 256 + hh * 64 + rg * 16 + r16] = y;
    }
  };
  typedef float f2_t __attribute__((ext_vector_type(2)));
  f2_t Sa = {0.f, 0.f}, Sb = {0.f, 0.f};
  const int rowl = wave * 4 + (lane >> 4), c4 = lane & 15;
  auto process = [&](int bi) {
    const float* cb = opbuf + (size_t)bi * SCH * SST + 4 * c4;
    const float* vb = opbuf + (size_t)bi * SCH * SST + 320 + rowl;
    float* yb = ybuf + (size_t)bi * SCH * 256 + wave * 64 + lane;
    f2_t W0[3], W1[3], A0[3], A1[3], B0[3], B1[3], K0[3], K1[3], R0[3], R1[3]; float V_[3];
#define SC_LD2(DST0, DST1, PTR) { const float4 t_ = *(const float4*)(PTR); DST0 = (f2_t){t_.x, t_.y}; DST1 = (f2_t){t_.z, t_.w}; }
#define SC_LOAD(ST, SL) { const float* q_ = cb + (ST) * SST; SC_LD2(W0[SL], W1[SL], q_); SC_LD2(A0[SL], A1[SL], q_ + 64); SC_LD2(B0[SL], B1[SL], q_ + 128); \
                          SC_LD2(K0[SL], K1[SL], q_ + 192); SC_LD2(R0[SL], R1[SL], q_ + 256); V_[SL] = vb[(ST) * SST]; }
    SC_LOAD(0, 0);
    SC_LOAD(1, 1);
#pragma unroll
    for (int ls = 0; ls < SCH; ++ls) {
      if (ls + 2 < SCH) SC_LOAD(ls + 2, (ls + 2) % 3);
      const int sl = ls % 3;
      const f2_t vv = {V_[sl], V_[sl]};
      f2_t pp = __builtin_elementwise_fma(Sb, A1[sl], Sa * A0[sl]);
      float pa = pp.x + pp.y;
      const f2_t ta = __builtin_elementwise_fma(Sa, W0[sl], vv * K0[sl]);
      const f2_t tb = __builtin_elementwise_fma(Sb, W1[sl], vv * K1[sl]);
      pa = allreduce16(pa);
      const f2_t pv = {pa, pa};
      Sa = __builtin_elementwise_fma(pv, B0[sl], ta);
      Sb = __builtin_elementwise_fma(pv, B1[sl], tb);
      const f2_t yy = __builtin_elementwise_fma(Sb, R1[sl], Sa * R0[sl]);
      yb[ls * 256] = yy.x + yy.y;
    }
#undef SC_LOAD
#undef SC_LD2
  };
  HStage h0, h1;
  const bool helper = wave >= 4;
  if (helper) { issue(h0, 0); commit(h0, 0); issue(h1, 1); issue(h0, 2); }
  __syncthreads();
#define SCAN_BAR() do { asm volatile("s_waitcnt lgkmcnt(0)" ::: "memory"); __builtin_amdgcn_s_barrier(); asm volatile("" ::: "memory"); } while (0)
#pragma unroll 1
  for (int ci = 0; ci <= nchunk; ci += 2) {
    if (helper) {
      if (ci + 1 < nchunk) { commit(h1, 1); if (ci + 3 < nchunk) issue(h1, ci + 3); }
      if (ci >= 1) flush(ci - 1);
    } else if (ci < nchunk) process(0);
    SCAN_BAR();
    if (helper) {
      if (ci + 2 < nchunk) { commit(h0, 0); if (ci + 4 < nchunk) issue(h0, ci + 4); }
      if (ci < nchunk) flush(ci);
    } else if (ci + 1 < nchunk) process(1);
    SCAN_BAR();
  }
#undef SCAN_BAR
  __syncthreads();
}

DI void phase_rwkv_out(const Params& p, int l, int nrows) {
  char* ws = p.ws;
  const int tid_ = otid(); const int lane = tid_ & 63, wave = tid_ >> 6;
  const float* Y0 = (const float*)(ws + OFF_Y); const float* Y1 = Y0 + (size_t)NT * 256;
  const bf16_t* SC = (const bf16_t*)(ws + OFF_SCANIN); const bf16_t* Gb = (const bf16_t*)(ws + OFF_G);
  bf16_t* OUTS = (bf16_t*)(ws + OFF_OUTS);
  const int c0 = 4 * lane;
  const float4 lw = *(const float4*)(p.rwkv_ln_w + l * 256 + c0), lb = *(const float4*)(p.rwkv_ln_b + l * 256 + c0);
  const float4 ka0 = *(const float4*)(p.rwkv_k_a + (l * 2 + 0) * 256 + c0), ka1 = *(const float4*)(p.rwkv_k_a + (l * 2 + 1) * 256 + c0);
  const float4 rk = *(const float4*)(p.rwkv_r_k + l * 256 + c0);
  const float lwv[4] = {lw.x, lw.y, lw.z, lw.w}, lbv[4] = {lb.x, lb.y, lb.z, lb.w};
  const float k0v[4] = {ka0.x, ka0.y, ka0.z, ka0.w}, k1v[4] = {ka1.x, ka1.y, ka1.z, ka1.w}, rkv[4] = {rk.x, rk.y, rk.z, rk.w};
  for (int row = obid() * 8 + wave; row < nrows; row += gridDim.x * 8) {
    const float4 ya = *(const float4*)(Y0 + (size_t)row * 256 + c0), yb = *(const float4*)(Y1 + (size_t)row * 256 + c0);
    const bf16_t* sc = SC + (size_t)row * 1792 + c0;
    const uint2 ur = *(const uint2*)(sc), uk = *(const uint2*)(sc + 256), uv = *(const uint2*)(sc + 512), ua0 = *(const uint2*)(sc + 5 * 256), ua1 = *(const uint2*)(sc + 6 * 256);
    const uint2 ug = *(const uint2*)(Gb + (size_t)row * 256 + c0);
    const float y[4] = {ya.x + yb.x, ya.y + yb.y, ya.z + yb.z, ya.w + yb.w};
    const float mean = allreduce16((y[0] + y[1]) + (y[2] + y[3])) * (1.f / 64.f);
    float d[4], var = 0.f;
#pragma unroll
    for (int e = 0; e < 4; ++e) { d[e] = y[e] - mean; var += d[e] * d[e]; }
    var = allreduce16(var) * (1.f / 64.f);
    const float rstd = frsqrt(var + 64e-5f);
#define U2F(U, E) (((E) & 1) ? __uint_as_float((((E) >> 1) ? (U).y : (U).x) & 0xffff0000u) : __uint_as_float((((E) >> 1) ? (U).y : (U).x) << 16))
    float bs = 0.f, r4[4], k4[4], v4[4], g4[4];
#pragma unroll
    for (int e = 0; e < 4; ++e) {
      r4[e] = U2F(ur, e); k4[e] = U2F(uk, e); v4[e] = U2F(uv, e); g4[e] = U2F(ug, e);
      const float a0 = U2F(ua0, e), a1 = U2F(ua1, e);
      const float kd0 = k4[e] * (1.f + (a0 - 1.f) * k0v[e]), kd1 = k4[e] * (1.f + (a1 - 1.f) * k1v[e]);
      bs += r4[e] * (kd0 + kd1) * rkv[e];
    }
#undef U2F
    bs = allreduce16(bs);
    float o[4];
#pragma unroll
    for (int e = 0; e < 4; ++e) o[e] = ((d[e] * rstd * lwv[e] + lbv[e]) + bs * v4[e]) * g4[e];
    st4bf(OUTS + (size_t)row * 1024 + 512 + c0, o[0], o[1], o[2], o[3]);
  }
}

#define XB_TMO      128
#define XB_XCNT(j)  (256  + 64 * (j))
#define XB_XSUB(j)  (1280 + 64 * (j))
#define XB_XGEN(j)  (2304 + 64 * (j))
#define XB_TOP      3328
#define XB_TOPGEN   3392
#define XCD_BAR_WORDS 3456
#define XB_SPIN_CAP (1u << 22)
#define LAS __attribute__((address_space(3)))
DI unsigned xb_ld(unsigned* p) { return __hip_atomic_load(p, __ATOMIC_RELAXED, __HIP_MEMORY_SCOPE_AGENT); }
DI unsigned xb_add(unsigned* p, unsigned v) { return __hip_atomic_fetch_add(p, v, __ATOMIC_RELAXED, __HIP_MEMORY_SCOPE_AGENT); }
DI unsigned xb_xcc_id() { return (unsigned)__builtin_amdgcn_s_getreg((3 << 11) | 20) & 0xFu; }
#define XB_SPIN(cond, bar) do { unsigned _sp = 0; while (cond) { __builtin_amdgcn_s_sleep(1); \
    if ((++_sp & 255u) == 0u) { if (xb_ld(&(bar)[XB_TMO])) break; if (_sp > XB_SPIN_CAP) { atomicAdd(&(bar)[XB_TMO], 1u); break; } } } } while (0)
struct XcdBarrier { unsigned* bar; unsigned x; volatile LAS unsigned* st; };
DI XcdBarrier xcd_barrier_post(unsigned* bar, volatile LAS unsigned* st) {
  XcdBarrier b; b.bar = bar; b.x = xb_xcc_id(); b.st = st;
  if (threadIdx.x == 0) (void)xb_add(&bar[XB_XCNT(b.x)], 1u);
  return b;
}
DI void xcd_barrier_complete(unsigned* bar, unsigned x, unsigned& nloc, unsigned& nx) {
  const unsigned G = gridDim.x * gridDim.y * gridDim.z;
  unsigned sum, cnt, mine, sp = 0u;
  for (;;) {
    sum = 0u; cnt = 0u; mine = 0u;
#pragma unroll
    for (unsigned j = 0; j < 16; ++j) { const unsigned c = xb_ld(&bar[XB_XCNT(j)]); sum += c; cnt += (c > 0u) ? 1u : 0u; mine = (j == x) ? c : mine; }
    if (sum == G) break;
    __builtin_amdgcn_s_sleep(1);
    if ((++sp & 255u) == 0u) { if (xb_ld(&bar[XB_TMO])) break; if (sp > XB_SPIN_CAP) { atomicAdd(&bar[XB_TMO], 1u); break; } }
  }
  nloc = mine > 0u ? mine : 1u; nx = cnt > 0u ? cnt : 1u;
}
DI void xcd_barrier(const XcdBarrier& b) {
  asm volatile("s_waitcnt vmcnt(0)" ::: "memory");
  __syncthreads();
  if (otid() == 0) {
    unsigned* bar = b.bar;
    __builtin_amdgcn_s_waitcnt(0);
    unsigned nloc = b.st[0], nx = b.st[1];
    if (nloc == 0u) { xcd_barrier_complete(bar, b.x, nloc, nx); b.st[0] = nloc; b.st[1] = nx; }
    const unsigned old = xb_add(&bar[XB_XSUB(b.x)], 1u);
    const unsigned gen = old / nloc;
    if (old + 1u == (gen + 1u) * nloc) {
      __builtin_amdgcn_fence(__ATOMIC_RELEASE, "agent");
      asm volatile("s_waitcnt vmcnt(0)" ::: "memory");
      const unsigned og = xb_add(&bar[XB_TOP], 1u);
      const unsigned tg = og / nx;
      if (og + 1u == (tg + 1u) * nx) xb_add(&bar[XB_TOPGEN], 1u);
      else XB_SPIN(xb_ld(&bar[XB_TOPGEN]) == tg, bar);
      __builtin_amdgcn_fence(__ATOMIC_ACQUIRE, "agent");
      xb_add(&bar[XB_XGEN(b.x)], 1u);
      asm volatile("s_waitcnt vmcnt(0)" ::: "memory");
    } else {
      XB_SPIN(xb_ld(&bar[XB_XGEN(b.x)]) == gen, bar);
      __builtin_amdgcn_fence(__ATOMIC_ACQUIRE, "agent");
      asm volatile("s_waitcnt vmcnt(0)" ::: "memory");
    }
  }
  __syncthreads();
}

typedef const uint64_t __attribute__((address_space(4))) cu64_t;
DI Params load_params(cu64_t*& ka) {
  asm volatile("" : "+s"(ka));
  Params p;
  const float** d = (const float**)&p;
#pragma unroll
  for (int i = 0; i < 32; ++i) d[i] = (const float*)(const float __attribute__((address_space(1)))*)ka[i];
  p.out = (float*)(float __attribute__((address_space(1)))*)ka[32];
  p.ws = (char*)(char __attribute__((address_space(1)))*)ka[33];
  return p;
}
#define LP() const Params p = load_params(ka)
__global__ void __launch_bounds__(THREADS) fwd_megakernel(Params p_unused) {
  extern __shared__ __attribute__((aligned(16))) char smem[];
  cg::grid_group grid = cg::this_grid();
  cu64_t* ka = (cu64_t*)__builtin_amdgcn_kernarg_segment_ptr();
  int* s_item = (int*)(smem + LDS_MAIN);
  if (threadIdx.x < 16) ((volatile LAS unsigned*)(smem + LDS_MAIN))[threadIdx.x] = 0u;
  __syncthreads();
  XcdBarrier xbar;
  { LP(); xbar = xcd_barrier_post((unsigned*)(p.ws + OFF_CTL), (volatile LAS unsigned*)(smem + LDS_MAIN + 16)); }
#define PH_BEGIN { LP(); char* ws = p.ws; (void)ws; float* mods = (float*)(ws + OFF_MODS); (void)mods; float* XC = (float*)(ws + OFF_XC); (void)XC; bf16_t* H = (bf16_t*)(ws + OFF_H); (void)H; int rot = 0; (void)rot;
#define XBAR() { LP(); xbar.bar = (unsigned*)(p.ws + OFF_CTL); xbar.x = xb_xcc_id(); xcd_barrier(xbar); }
#define PH_END } XBAR();
#define PH_END_CG } if (gridDim.x == 0x7fffffffu) grid.sync(); XBAR();

  PH_BEGIN
    phase_mods(p, smem);
    phase_convert(p, 0, smem);
  PH_END_CG
  PH_BEGIN
    phase_rows(p, NT, nullptr, p.x, p.ctx, nullptr, nullptr, nullptr, 0, nullptr, true, mods, 0, 1024, p.g_pre_mix, H);
  PH_END

  volatile int* s_layer = (volatile int*)(smem + LDS_MAIN + 48);
#pragma unroll 1
  for (;;) {
    const int l = __builtin_amdgcn_readfirstlane(*s_layer);
    if (l >= 2) break;
    const bool last = (l == 1);
    const int nrows = last ? NLAT : NT;
    PH_BEGIN
      pg8::PEpiWin e{(bf16_t*)(ws + OFF_ZA), (bf16_t*)(ws + OFF_ZB), (bf16_t*)(ws + OFF_ZC), (bf16_t*)(ws + OFF_ZD), (bf16_t*)(ws + OFF_VTA), (bf16_t*)(ws + OFF_VTD)};
      pg8::Gemm g{H, (const bf16_t*)(ws + OFF_WIN), NT, NWIN, 1024, 1024}; pg8::WinCOrder S{(int)gridDim.x, obid()};
      pg8::gemm_phase<pg8::PEpiWin, pg8::WinCOrder, true, true>((PG8_LAS unsigned char*)smem, g, S, e);
    PH_END
    PH_BEGIN
      prep_rows<false, true>(p, l, obid() * 8, NT, (int)gridDim.x * 8);
    PH_END
    PH_BEGIN
      gemm_small((const bf16_t*)(ws + OFF_TMPW), 64, (const bf16_t*)(ws + OFF_WW2), 64, NT / 256, 4, 64, rot, smem,
                 EpiWlora{(bf16_t*)(ws + OFF_SCANIN) + 3 * 256, p.rwkv_w0 + l * 512});
      gemm_small((const bf16_t*)(ws + OFF_TMPA), 64, (const bf16_t*)(ws + OFF_WA2), 64, NT / 256, 4, 64, rot, smem,
                 EpiAlora{(bf16_t*)(ws + OFF_SCANIN) + 5 * 256, p.rwkv_a0 + l * 512});
      gemm_small((const bf16_t*)(ws + OFF_TMPG), 192, (const bf16_t*)(ws + OFF_WG2), 192, NT / 256, 2, 192, rot, smem, EpiBf16{(bf16_t*)(ws + OFF_G), 256, false});
    PH_END
    PH_BEGIN
      for (int sb = obid(); sb < 64; sb += gridDim.x) scan_block(p, l, sb, smem);
      const int NWQ = 384, NPREP = 264, NPROJ = 462, NJOB = NWQ + NPREP + NPROJ;
      const int nitems = NJOB + (last ? 768 : 792);
      unsigned* counters = (unsigned*)(ws + OFF_CTL + 32768);
      bool win_ok = false;
      bool prep_ok = false;
      bool proj_ok = false;
#pragma unroll 1
      for (;;) {
        if (otid() == 0) {
          const int it = (int)atomicAdd(&counters[l * 64], 1u);
          if (it >= NWQ && it < nitems && !win_ok) {
            unsigned sp = 0;
            while (xb_ld(&counters[l * 64 + 48]) < (unsigned)NWQ) { __builtin_amdgcn_s_sleep(2); if (++sp > (1u << 24)) break; }
            __builtin_amdgcn_fence(__ATOMIC_ACQUIRE, "agent");
            asm volatile("s_waitcnt vmcnt(0)" ::: "memory");
            win_ok = true;
          }
          if (it >= NWQ + NPREP && it < nitems && !prep_ok) {
            unsigned sp = 0;
            while (xb_ld(&counters[l * 64 + 32]) < (unsigned)NPREP) { __builtin_amdgcn_s_sleep(2); if (++sp > (1u << 24)) break; }
            __builtin_amdgcn_fence(__ATOMIC_ACQUIRE, "agent");
            asm volatile("s_waitcnt vmcnt(0)" ::: "memory");
            prep_ok = true;
          }
          const int q0 = it - NJOB;
          const bool is_mla = (q0 >= 256 && q0 < 512) || (q0 >= 768 && q0 < 776);
          if (is_mla && it < nitems && !proj_ok) {
            unsigned sp = 0;
            while (xb_ld(&counters[l * 64 + 16]) < (unsigned)NPROJ) { __builtin_amdgcn_s_sleep(2); if (++sp > (1u << 24)) break; }
            __builtin_amdgcn_fence(__ATOMIC_ACQUIRE, "agent");
            asm volatile("s_waitcnt vmcnt(0)" ::: "memory");
            proj_ok = true;
          }
          *s_item = it;
        }
        __syncthreads();
        const int item = *s_item;
        __syncthreads();
        if (item >= nitems) break;
        if (item < NWQ) {
          const int mt = item / 6, k6 = item - 6 * mt;
          pg8::PEpiWin e{(bf16_t*)(ws + OFF_ZA), (bf16_t*)(ws + OFF_ZB), (bf16_t*)(ws + OFF_ZC), (bf16_t*)(ws + OFF_ZD), (bf16_t*)(ws + OFF_VTA), (bf16_t*)(ws + OFF_VTD)};
          pg8::Gemm g{H, (const bf16_t*)(ws + OFF_WIN), NT, NWIN, 1024, 1024};
          pg8::PieceOrder S{mt, k6 < 4 ? k6 : k6 + 5, true};
          pg8::gemm_phase<pg8::PEpiWin, pg8::PieceOrder, false, true>((PG8_LAS unsigned char*)smem, g, S, e);
          asm volatile("s_waitcnt vmcnt(0)" ::: "memory");
          __syncthreads();
          if (otid() == 0) {
            __builtin_amdgcn_fence(__ATOMIC_RELEASE, "agent");
            asm volatile("s_waitcnt vmcnt(0)" ::: "memory");
            (void)xb_add(&counters[l * 64 + 48], 1u);
          }
        } else if (item < NWQ + NPREP) {
          const int pjb = item - NWQ;
          prep_rows<true, false>(p, l, pjb * 64, pjb * 64 + 64, 8);
          asm volatile("s_waitcnt vmcnt(0)" ::: "memory");
          __syncthreads();
          if (otid() == 0) {
            __builtin_amdgcn_fence(__ATOMIC_RELEASE, "agent");
            asm volatile("s_waitcnt vmcnt(0)" ::: "memory");
            (void)xb_add(&counters[l * 64 + 32], 1u);
          }
        } else if (item < NJOB) {
          const bf16_t* ZB = (const bf16_t*)(ws + OFF_ZB);
          const int pj = item - NWQ - NPREP;
          const bool isq = pj < 198;
          const int j = isq ? pj : pj - 198;
          const int mt = isq ? j / 3 : j >> 2, nt = isq ? j - 3 * mt : j & 3;
          gemm_small_tile(isq ? ZB : ZB + 256, 512, (const bf16_t*)(ws + (isq ? OFF_WUQ : OFF_WUKV)), isq ? 256 : 128, mt, nt, isq ? 256 : 128, smem,
                          EpiUqkv{isq ? 0 : 1, (bf16_t*)(ws + OFF_BQ), (bf16_t*)(ws + OFF_BK), (bf16_t*)(ws + OFF_VTB)});
          asm volatile("s_waitcnt vmcnt(0)" ::: "memory");
          __syncthreads();
          if (otid() == 0) {
            __builtin_amdgcn_fence(__ATOMIC_RELEASE, "agent");
            asm volatile("s_waitcnt vmcnt(0)" ::: "memory");
            (void)xb_add(&counters[l * 64 + 16], 1u);
          }
        } else {
          const int q = item - NJOB;
          int kind, b, hq, qt; bool isctx = false;
          if (q < 768) { const int k3 = q >> 8; kind = (k3 == 0) ? 1 : (k3 == 1 ? 0 : 2); const int j = q & 255; b = j >> 7; hq = (j >> 5) & 3; qt = j & 31; }
          else { const int j = q - 768; kind = j >> 3; b = (j >> 2) & 1; hq = j & 3; qt = 0; isctx = true; }
          run_attn_item(p, l, kind, b, hq, qt, isctx, smem);
        }
      }
    PH_END
    PH_BEGIN
      phase_rwkv_out(p, l, nrows);
    PH_END
    PH_BEGIN
      {
        pg8::PEpiBf16 e{(bf16_t*)(ws + OFF_YMIX), 1024, false};
        pg8::Gemm g{(const bf16_t*)(ws + OFF_OUTS), (const bf16_t*)(ws + OFF_WOUT), NLAT, 1024, 1024, 1024}; pg8::StaticOrder S; S.init(NLAT, 1024, (int)gridDim.x, obid());
        pg8::gemm_phase<pg8::PEpiBf16, pg8::StaticOrder, true, true>((PG8_LAS unsigned char*)smem, g, S, e);
      }
      if (!last) {
        const int idx = obid(), u = idx >> 2, ks = idx & 3;
        pg8::PieceOrder S{64 + (u >> 2), u & 3, idx < 32};
        pg8::PEpiF32 e{(float*)(ws + OFF_SLAB1) + (size_t)ks * NCTX * 1024 - (size_t)NLAT * 1024, 1024};
        pg8::Gemm g{(const bf16_t*)(ws + OFF_OUTS) + ks * 256, (const bf16_t*)(ws + OFF_WOUT) + ks * 256, NT, 1024, 256, 1024};
        pg8::gemm_phase<pg8::PEpiF32, pg8::PieceOrder, false, true>((PG8_LAS unsigned char*)smem, g, S, e);
      }
    PH_END
    PH_BEGIN
      const float* modl = mods + (size_t)l * 3 * 6144;
      phase_rows(p, nrows, (const bf16_t*)(ws + OFF_YMIX), l == 0 ? p.x : p.out, l == 0 ? p.ctx : XC, p.out, XC, modl, 2048, p.g_post_mix + l * 1024, true,
                 modl, 3072, 4096, p.g_pre_mlp + l * 1024, (bf16_t*)(ws + OFF_H2), (const float*)(ws + OFF_SLAB1), last ? 0 : 4);
    PH_END
    PH_BEGIN
      pg8::PEpiBf16 e{(bf16_t*)(ws + OFF_U), 4096, true};
      pg8::Gemm g{(const bf16_t*)(ws + OFF_H2), (const bf16_t*)(ws + OFF_W1), nrows, 4096, 1024, 1024}; pg8::StaticOrder S; S.init(nrows, 4096, (int)gridDim.x, obid());
      pg8::gemm_phase<pg8::PEpiBf16, pg8::StaticOrder, true, true>((PG8_LAS unsigned char*)smem, g, S, e);
    PH_END
    PH_BEGIN
      {
        pg8::PEpiBf16 e{(bf16_t*)(ws + OFF_Y2), 1024, false};
        pg8::Gemm g{(const bf16_t*)(ws + OFF_U), (const bf16_t*)(ws + OFF_W2), NLAT, 1024, 4096, 4096}; pg8::StaticOrder S; S.init(NLAT, 1024, (int)gridDim.x, obid());
        pg8::gemm_phase<pg8::PEpiBf16, pg8::StaticOrder, true, true>((PG8_LAS unsigned char*)smem, g, S, e);
      }
      if (!last) {
        const int idx = obid(), u = idx >> 3, ks = idx & 7;
        pg8::PieceOrder S{64 + (u >> 2), u & 3, idx < 64};
        pg8::PEpiF32 e{(float*)(ws + OFF_SLAB2) + (size_t)ks * NCTX * 1024 - (size_t)NLAT * 1024, 1024};
        pg8::Gemm g{(const bf16_t*)(ws + OFF_U) + ks * 512, (const bf16_t*)(ws + OFF_W2) + ks * 512, NT, 1024, 512, 4096};
        pg8::gemm_phase<pg8::PEpiF32, pg8::PieceOrder, false, true>((PG8_LAS unsigned char*)smem, g, S, e);
      }
    PH_END
    PH_BEGIN
      if (!last) phase_convert(p, l + 1, smem);
      const float* modl = mods + (size_t)l * 3 * 6144;
      phase_rows(p, nrows, (const bf16_t*)(ws + OFF_Y2), p.out, XC, p.out, XC, modl, 5120, p.g_post_mlp + l * 1024, !last,
                 mods + (size_t)(l + 1) * 3 * 6144, 0, 1024, p.g_pre_mix + (last ? 0 : (l + 1) * 1024), H, (const float*)(ws + OFF_SLAB2), last ? 0 : 8);
    }
    if (last) break;
    XBAR();
    if (otid() == 0) *s_layer = l + 1;
    __syncthreads();
  }
}

extern "C" void kernel_launch(void* const* d_in, const int* in_sizes, int n_in, void* d_out, int out_size, void* d_ws, size_t ws_size,
                              hipStream_t stream) {
  static int grid_blocks = 0;
  if (grid_blocks == 0) {
    if (n_in != 32 || ws_size < WS_NEED) { fprintf(stderr, "kernel_launch: unexpected n_in %d / ws_size %zu\n", n_in, ws_size); grid_blocks = -1; return; }
    int dev = 0, cus = 0, per_cu = 0;
    hipGetDevice(&dev);
    hipDeviceGetAttribute(&cus, hipDeviceAttributeMultiprocessorCount, dev);
    hipFuncSetAttribute((const void*)fwd_megakernel, hipFuncAttributeMaxDynamicSharedMemorySize, LDS_BYTES);
    hipOccupancyMaxActiveBlocksPerMultiprocessor(&per_cu, (const void*)fwd_megakernel, THREADS, LDS_BYTES);
    if (per_cu < 1) { fprintf(stderr, "kernel_launch: occupancy query says %d blocks per CU\n", per_cu); grid_blocks = -1; return; }
    grid_blocks = cus;
  }
  if (grid_blocks < 0) return;
  hipMemsetAsync((char*)d_ws + OFF_CTL, 0, 65536, stream);
  Params p{};
  const float** pp = (const float**)&p;
  for (int i = 0; i < 32; ++i) pp[i] = (const float*)d_in[i];
  p.out = (float*)d_out;
  p.ws = (char*)d_ws;
  void* args[] = {&p};
  hipError_t e = hipLaunchCooperativeKernel((const void*)fwd_megakernel, dim3(grid_blocks), dim3(THREADS), args, LDS_BYTES, stream);
  if (e != hipSuccess) fprintf(stderr, "cooperative launch failed: %s (grid %d)\n", hipGetErrorString(e), grid_blocks);
}
```

```cpp
#include <hip/hip_runtime.h>
#include <hip/hip_cooperative_groups.h>
#include <cstdio>
#include <cstdint>
namespace cg = cooperative_groups;

typedef unsigned short bf16_t;
using bf16x8 = __attribute__((ext_vector_type(8))) short;
using f32x16 = __attribute__((ext_vector_type(16))) float;
#define DI __device__ __forceinline__
#define MFMA32(a, b, c) __builtin_amdgcn_mfma_f32_32x32x16_bf16((a), (b), (c), 0, 0, 0)

constexpr int D_ = 1024, T_ = 8192, NLAT = 16384, NCTX = 512, NT = 16896, CTXL = 256;
constexpr int NWIN = 2816;
constexpr int IN_COLS = 2496, C_COLS = 1056, DFF = 4096;
constexpr int KEYS = 8448;
constexpr float EPS = 1e-6f, LOG2E = 1.4426950408889634f;
constexpr int THREADS = 512;
constexpr int LDS_MAIN = 151552;
constexpr int LDS_BYTES = LDS_MAIN + 64;

constexpr size_t MiB = 1048576;
constexpr size_t OFF_CTL = 0;
constexpr size_t OFF_MODS = 65536;
constexpr size_t OFF_INVN = 262144;
constexpr size_t OFF_XC = 1 * MiB;
constexpr size_t OFF_W = 3 * MiB;
constexpr size_t OFF_WIN = OFF_W;
constexpr size_t OFF_WOUT = OFF_WIN + (size_t)NWIN * 1024 * 2;
constexpr size_t OFF_W1 = OFF_WOUT + (size_t)1024 * 1024 * 2;
constexpr size_t OFF_W2 = OFF_W1 + (size_t)4096 * 1024 * 2;
constexpr size_t OFF_WUQ = OFF_W2 + (size_t)4096 * 1024 * 2;
constexpr size_t OFF_WUKV = OFF_WUQ + 384 * 256 * 2;
constexpr size_t OFF_WW2 = OFF_WUKV + 512 * 128 * 2;
constexpr size_t OFF_WA2 = OFF_WW2 + 2 * 256 * 64 * 2;
constexpr size_t OFF_WG2 = OFF_WA2 + 2 * 256 * 64 * 2;
constexpr size_t OFF_R = 27 * MiB + MiB / 8;
constexpr size_t EIGHTH = MiB / 8;
constexpr size_t OFF_H = OFF_R;
constexpr size_t OFF_BQ = OFF_R;
constexpr size_t OFF_BK = OFF_R + 99 * EIGHTH;
constexpr size_t OFF_VTB = OFF_R + 198 * EIGHTH;
constexpr size_t OFF_ZA = OFF_R + 33 * MiB;
constexpr size_t OFF_ZD = OFF_ZA + 132 * EIGHTH;
constexpr size_t OFF_ZB = OFF_ZD + 132 * EIGHTH;
constexpr size_t OFF_ZC = OFF_ZB + 132 * EIGHTH;
constexpr size_t OFF_OUTS = OFF_ZC;
constexpr size_t OFF_SCANIN = OFF_ZC + 297 * EIGHTH;
constexpr size_t OFF_G = OFF_SCANIN + 462 * EIGHTH;
constexpr size_t OFF_Y = OFF_G + 66 * EIGHTH;
constexpr size_t OFF_TMPW = OFF_Y;
constexpr size_t OFF_TMPA = OFF_TMPW + (size_t)NT * 64 * 2;
constexpr size_t OFF_TMPG = OFF_TMPA + (size_t)NT * 64 * 2;
constexpr size_t OFF_VTA = OFF_Y + 33 * MiB;
constexpr size_t OFF_VTD = OFF_VTA + 33 * EIGHTH;
constexpr size_t OFF_YMIX = OFF_R;
constexpr size_t OFF_H2 = 223 * MiB;
constexpr size_t OFF_U = OFF_R;
constexpr size_t OFF_Y2 = OFF_R + 132 * MiB;
constexpr size_t OFF_SLAB1 = OFF_ZB;
constexpr size_t OFF_SLAB2 = 226 * MiB;
constexpr size_t WS_NEED = 256 * MiB;
static_assert(OFF_VTD + 33 * EIGHTH <= 256 * MiB, "ws");
static_assert(OFF_Y2 + (size_t)NT * 1024 * 4 <= 256 * MiB && OFF_H2 + (size_t)NT * 1024 * 2 <= 256 * MiB, "ws2");
static_assert(OFF_WG2 + 256 * 192 * 2 <= OFF_R, "ws w");

struct Params {
  const float *x, *c, *ctx, *c_ctx, *w_mod, *b_mod, *g_pre_mix, *g_post_mix, *g_pre_mlp, *g_post_mlp, *w_in,
      *gqa_q_norm, *gqa_k_norm, *mla_q_norm, *mla_kv_norm, *mla_w_uq, *mla_w_ukv, *rwkv_mu, *rwkv_w0, *rwkv_w2,
      *rwkv_a0, *rwkv_a2, *rwkv_k_k, *rwkv_k_a, *rwkv_r_k, *rwkv_g2, *rwkv_ln_w, *rwkv_ln_b, *swa_sink, *w_out,
      *w_mlp1, *w_mlp2;
  float* out;
  char* ws;
};

DI int obid() { int b = blockIdx.x; asm volatile("" : "+s"(b)); return b; }
DI int otid() { int t = threadIdx.x; asm volatile("" : "+v"(t)); return t; }
DI float bf2f(bf16_t b) { return __uint_as_float(((unsigned)b) << 16); }
typedef __bf16 bf2v_t __attribute__((ext_vector_type(2)));
typedef float f2v_t __attribute__((ext_vector_type(2)));
DI unsigned pack2(float a, float b) { f2v_t f = {a, b}; bf2v_t r = __builtin_convertvector(f, bf2v_t); return __builtin_bit_cast(unsigned, r); }
DI bf16_t f2bf(float x) { return (bf16_t)(pack2(x, 0.f) & 0xffffu); }
DI void st4bf(bf16_t* p, float a, float b, float c, float d) { uint2 v; v.x = pack2(a, b); v.y = pack2(c, d); *(uint2*)p = v; }
DI float wave_sum_slow(float v) {
#pragma unroll
  for (int o = 32; o > 0; o >>= 1) v += __shfl_xor(v, o);
  return v;
}
DI float fexp2(float x) { return __builtin_amdgcn_exp2f(x); }
DI float fexp(float x) { return __builtin_amdgcn_exp2f(x * LOG2E); }
DI float frcp(float x) { return __builtin_amdgcn_rcpf(x); }
DI float sigmoidf_(float x) { return frcp(1.f + fexp(-x)); }
DI float frsqrt(float x) { return __builtin_amdgcn_rsqf(x); }
DI int key_of_row(int m) { return m < NLAT ? (m & (T_ - 1)) : T_ + ((m - NLAT) & (CTXL - 1)); }
DI int batch_of_row(int m) { return m < NLAT ? (m >> 13) : ((m - NLAT) >> 8); }
DI int mods_slot(int m) { return m < NLAT ? (m >> 13) : 2; }
template <int CTRL> DI float dpp_mov(float v) {
  return __builtin_bit_cast(float, __builtin_amdgcn_update_dpp(0, __builtin_bit_cast(int, v), CTRL, 0xf, 0xf, false));
}
DI float allreduce16(float v) {
  v += dpp_mov<0x128>(v);
  v += dpp_mov<0x124>(v);
  v += dpp_mov<0x122>(v);
  v += dpp_mov<0x121>(v);
  return v;
}
DI float wave_sum(float v) {
  v = allreduce16(v);
  { const auto sw = __builtin_amdgcn_permlane32_swap(__float_as_uint(v), __float_as_uint(v), false, false); v = __uint_as_float(sw[0]) + __uint_as_float(sw[1]); }
  v += __shfl_xor(v, 16);
  return v;
}

DI void phase_mods(const Params& p, char* smem) {
  float* s_silu = (float*)smem;
  float* s_red = s_silu + 3 * 1024;
  const int tid = otid(), lane = tid & 63, wave = tid >> 6;
  for (int i = tid; i < 3 * 1024; i += THREADS) {
    int sI = i >> 10, k = i & 1023;
    float v = (sI < 2) ? p.c[sI * 1024 + k] : p.c_ctx[k];
    s_silu[i] = v * sigmoidf_(v);
  }
  __syncthreads();
  float* mods = (float*)(p.ws + OFF_MODS);
  for (int item = obid(); item < 192; item += gridDim.x) {
    const int l = item / 96, n0 = (item % 96) * 64;
    float a0 = 0.f, a1 = 0.f, a2 = 0.f;
    const float* w = p.w_mod + (size_t)l * 1024 * 6144 + (size_t)(wave * 128) * 6144 + n0 + lane;
#pragma unroll 16
    for (int kk = 0; kk < 128; ++kk) {
      const int k = wave * 128 + kk;
      const float wv = w[(size_t)kk * 6144];
      a0 += s_silu[k] * wv; a1 += s_silu[1024 + k] * wv; a2 += s_silu[2048 + k] * wv;
    }
    s_red[(wave * 3 + 0) * 64 + lane] = a0; s_red[(wave * 3 + 1) * 64 + lane] = a1; s_red[(wave * 3 + 2) * 64 + lane] = a2;
    __syncthreads();
    if (tid < 192) {
      const int sI = tid >> 6, j = tid & 63;
      float acc = p.b_mod[l * 6144 + n0 + j];
#pragma unroll
      for (int w8 = 0; w8 < 8; ++w8) acc += s_red[(w8 * 3 + sI) * 64 + j];
      mods[(size_t)(l * 3 + sI) * 6144 + n0 + j] = acc;
    }
    __syncthreads();
  }
}

struct RowMapId { DI int operator()(int n) const { return n; } };
struct RowMapWin { DI int operator()(int n) const { return n < 512 ? n : (n < 928 ? n : (n < 1984 ? n + 96 : n + 320)); } };
template <class RM>
DI void conv_T(const float* __restrict__ src, int K, int N, bf16_t* __restrict__ dst, int ldd, int Kpad, RM rm, int& rot, char* smem) {
  float* tile = (float*)smem;
  const int tid = otid(), G = gridDim.x;
  const int kt_n = Kpad >> 6, nt_n = N >> 6, total = kt_n * nt_n;
  int first = (int)((obid() + G - (rot % G)) % G);
  const int lk = tid >> 4, ln4 = (tid & 15) * 4;
  const int sn = tid >> 3, sk8 = (tid & 7) * 8;
  for (int t = first; t < total; t += G) {
    const int k0 = (t / nt_n) << 6, n0 = (t % nt_n) << 6;
    float4 v0 = make_float4(0.f, 0.f, 0.f, 0.f), v1 = make_float4(0.f, 0.f, 0.f, 0.f);
    if (k0 + lk < K) v0 = *(const float4*)(src + (size_t)(k0 + lk) * N + n0 + ln4);
    if (k0 + lk + 32 < K) v1 = *(const float4*)(src + (size_t)(k0 + lk + 32) * N + n0 + ln4);
    *(float4*)(tile + lk * 68 + ln4) = v0;
    *(float4*)(tile + (lk + 32) * 68 + ln4) = v1;
    __syncthreads();
    float f[8];
#pragma unroll
    for (int e = 0; e < 8; ++e) f[e] = tile[(sk8 + e) * 68 + sn];
    *(uint4*)(dst + (size_t)rm(n0 + sn) * ldd + k0 + sk8) = make_uint4(pack2(f[0], f[1]), pack2(f[2], f[3]), pack2(f[4], f[5]), pack2(f[6], f[7]));
    __syncthreads();
  }
  rot += total;
}
DI void phase_convert(const Params& p, int l, char* smem) {
  char* ws = p.ws;
  int rot = 0;
  conv_T(p.w_in + (size_t)l * 1024 * IN_COLS, 1024, IN_COLS, (bf16_t*)(ws + OFF_WIN), 1024, 1024, RowMapWin(), rot, smem);
  conv_T(p.w_out + (size_t)l * 1024 * 1024, 1024, 1024, (bf16_t*)(ws + OFF_WOUT), 1024, 1024, RowMapId(), rot, smem);
  conv_T(p.w_mlp1 + (size_t)l * 1024 * 4096, 1024, 4096, (bf16_t*)(ws + OFF_W1), 1024, 1024, RowMapId(), rot, smem);
  conv_T(p.w_mlp2 + (size_t)l * 4096 * 1024, 4096, 1024, (bf16_t*)(ws + OFF_W2), 4096, 4096, RowMapId(), rot, smem);
  conv_T(p.mla_w_uq + (size_t)l * 256 * 384, 256, 384, (bf16_t*)(ws + OFF_WUQ), 256, 256, RowMapId(), rot, smem);
  conv_T(p.mla_w_ukv + (size_t)l * 128 * 512, 128, 512, (bf16_t*)(ws + OFF_WUKV), 128, 128, RowMapId(), rot, smem);
  for (int d = 0; d < 2; ++d) {
    conv_T(p.rwkv_w2 + (size_t)(l * 2 + d) * 64 * 256, 64, 256, (bf16_t*)(ws + OFF_WW2) + d * 256 * 64, 64, 64, RowMapId(), rot, smem);
    conv_T(p.rwkv_a2 + (size_t)(l * 2 + d) * 64 * 256, 64, 256, (bf16_t*)(ws + OFF_WA2) + d * 256 * 64, 64, 64, RowMapId(), rot, smem);
  }
  conv_T(p.rwkv_g2 + (size_t)l * 160 * 256, 160, 256, (bf16_t*)(ws + OFF_WG2), 192, 192, RowMapId(), rot, smem);
}

DI void phase_rows(const Params& p, int nrows, const bf16_t* __restrict__ y, const float* xl_src, const float* xc_src,
                   float* xl_dst, float* xc_dst, const float* mods_y, int gt_off, const float* __restrict__ gpost, bool do_h,
                   const float* mods_h, int sh_off, int sc_off, const float* __restrict__ gpre, bf16_t* hdst, const float* yslab = nullptr, int nslab = 0) {
  const int tid_ = otid(); const int lane = tid_ & 63, wave = tid_ >> 6;
  float4 gpo[4], gpr[4], gtv[4], scv[4], shv[4];
#pragma unroll
  for (int i = 0; i < 4; ++i) {
    const int c = i * 256 + lane * 4;
    gpo[i] = y ? *(const float4*)(gpost + c) : make_float4(0.f, 0.f, 0.f, 0.f);
    gpr[i] = do_h ? *(const float4*)(gpre + c) : make_float4(0.f, 0.f, 0.f, 0.f);
    gtv[i] = scv[i] = shv[i] = make_float4(0.f, 0.f, 0.f, 0.f);
  }
  int cur_slot = -1;
  for (int row = obid() * 8 + wave; row < nrows; row += gridDim.x * 8) {
    const int slot = mods_slot(row);
    const float* xs = row < NLAT ? xl_src + (size_t)row * 1024 : xc_src + (size_t)(row - NLAT) * 1024;
    float4 xv[4];
#pragma unroll
    for (int i = 0; i < 4; ++i) xv[i] = *(const float4*)(xs + i * 256 + lane * 4);
    if (slot != cur_slot) {
      cur_slot = slot;
#pragma unroll
      for (int i = 0; i < 4; ++i) {
        const int c = i * 256 + lane * 4;
        if (y) gtv[i] = *(const float4*)(mods_y + (size_t)slot * 6144 + gt_off + c);
        if (do_h) { scv[i] = *(const float4*)(mods_h + (size_t)slot * 6144 + sc_off + c); shv[i] = *(const float4*)(mods_h + (size_t)slot * 6144 + sh_off + c); }
      }
    }
    if (y) {
      float4 yv[4];
      float ss = 0.f;
#pragma unroll
      for (int i = 0; i < 4; ++i) {
        if (nslab > 0 && row >= NLAT) {
          float4 a = make_float4(0.f, 0.f, 0.f, 0.f);
          for (int sidx = 0; sidx < nslab; ++sidx) {
            const float4 t4 = *(const float4*)(yslab + ((size_t)sidx * NCTX + (row - NLAT)) * 1024 + i * 256 + lane * 4);
            a.x += t4.x; a.y += t4.y; a.z += t4.z; a.w += t4.w;
          }
          yv[i] = a;
        } else
        { const uint2 u_ = *(const uint2*)(y + (size_t)row * 1024 + i * 256 + lane * 4);
          yv[i] = make_float4(__uint_as_float(u_.x << 16), __uint_as_float(u_.x & 0xffff0000u), __uint_as_float(u_.y << 16), __uint_as_float(u_.y & 0xffff0000u)); }
        ss += yv[i].x * yv[i].x + yv[i].y * yv[i].y + yv[i].z * yv[i].z + yv[i].w * yv[i].w;
      }
      ss = wave_sum(ss);
      const float rs = frsqrt(ss * (1.f / 1024.f) + EPS);
      float* xd = row < NLAT ? xl_dst + (size_t)row * 1024 : xc_dst + (size_t)(row - NLAT) * 1024;
#pragma unroll
      for (int i = 0; i < 4; ++i) {
        const int c = i * 256 + lane * 4;
        const float4 g = gpo[i], t = gtv[i];
        xv[i].x += t.x * (yv[i].x * rs * g.x); xv[i].y += t.y * (yv[i].y * rs * g.y);
        xv[i].z += t.z * (yv[i].z * rs * g.z); xv[i].w += t.w * (yv[i].w * rs * g.w);
        *(float4*)(xd + c) = xv[i];
      }
    }
    if (do_h) {
      float ss = 0.f;
#pragma unroll
      for (int i = 0; i < 4; ++i) ss += xv[i].x * xv[i].x + xv[i].y * xv[i].y + xv[i].z * xv[i].z + xv[i].w * xv[i].w;
      ss = wave_sum(ss);
      const float rs = frsqrt(ss * (1.f / 1024.f) + EPS);
#pragma unroll
      for (int i = 0; i < 4; ++i) {
        const int c = i * 256 + lane * 4;
        const float4 g = gpr[i], a = scv[i], b = shv[i];
        st4bf(hdst + (size_t)row * 1024 + c, xv[i].x * rs * g.x * (1.f + a.x) + b.x, xv[i].y * rs * g.y * (1.f + a.y) + b.y,
              xv[i].z * rs * g.z * (1.f + a.z) + b.z, xv[i].w * rs * g.w * (1.f + a.w) + b.w);
      }
    }
  }
}

namespace pg8 {
#define PG8_LAS __attribute__((address_space(3)))
typedef unsigned short bf16_t;
typedef short bf16x8 __attribute__((ext_vector_type(8)));
typedef float f32x4 __attribute__((ext_vector_type(4)));
typedef unsigned u32x4 __attribute__((ext_vector_type(4)));
constexpr int BM = 256, BK = 64, HALF = 128, HTB = HALF * BK * 2  , STAGE_BYTES = 8 * HTB, NXCD = 8, WGM = 8;

__host__ __device__ __forceinline__ int lds_byte(int r, int c) { const int st = (r >> 4) * 2 + (c >> 5), rr = r & 15, cc = c & 31, ob = rr * 64 + cc * 2; return st * 1024 + (ob ^ (((ob >> 9) & 1) << 5)); }
__host__ __device__ __forceinline__ void stage_rc(int b, int& R, int& C) { const int st = b / 1024, sb = b % 1024, swz = sb ^ (((sb >> 9) & 1) << 5); R = (st >> 1) * 16 + swz / 64; C = (st & 1) * 32 + (swz % 64) / 2; }
__host__ __device__ __forceinline__ int perm32(int rho) { const int n = rho >> 4, i = rho & 15; return 8 * (i >> 2) + 4 * n + (i & 3); }

struct Unit { int pm, pn; };
struct Gemm { const bf16_t* A; const bf16_t* Bt; int M, N, K, ld; };

struct StaticOrder {
    int nM, nN, nwg, G, c;
    __host__ __device__ void init(int M, int N, int G_, int c_) { nM = M / BM; nN = N / BM; nwg = nM * nN; G = G_; c = c_; }
    __host__ __device__ bool next(int i, Unit& u) const {
        const long L = (long)i * G + c; if (L >= nwg) return false;
        int wgid = (int)L; { const int q = nwg / NXCD, r = nwg % NXCD, xcd = wgid % NXCD, off = wgid / NXCD; wgid = (xcd < r ? xcd * (q + 1) : r * (q + 1) + (xcd - r) * q) + off; }
        const int nig = WGM * nN, gid = wgid / nig, fm = gid * WGM, gsz = (nM - fm) < WGM ? (nM - fm) : WGM;
        u.pm = fm + ((wgid % nig) % gsz); u.pn = (wgid % nig) / gsz; return true;
    }
    __device__ __forceinline__ void a_ready(const Unit&) const {}
    __device__ __forceinline__ void done(const Unit&) const {}
};

struct PEpiBf16 {
    static constexpr bool PERM = true, AFTER_DRAIN = false;
    bf16_t* O; int ldc; bool sqrelu;
    __device__ __forceinline__ void operator()(const f32x4 (&acc)[2][2][4][2], const Unit& u, int wr, int wc, int fr, int fq) const {
        const int row0 = u.pm * BM + wr * 64 + fr, col0 = u.pn * BM + wc * 32 + 8 * fq;
#pragma unroll
        for (int ai = 0; ai < 2; ++ai)
#pragma unroll
            for (int m = 0; m < 4; ++m) { bf16_t* rowp = O + (size_t)(row0 + ai * HALF + m * 16) * ldc + col0;
#pragma unroll
                for (int bj = 0; bj < 2; ++bj) { f32x4 v0 = acc[ai][bj][m][0], v1 = acc[ai][bj][m][1];
                    if (sqrelu) { v0 = __builtin_elementwise_max(v0, (f32x4){0.f, 0.f, 0.f, 0.f}); v1 = __builtin_elementwise_max(v1, (f32x4){0.f, 0.f, 0.f, 0.f}); v0 = v0 * v0; v1 = v1 * v1; }
                    u32x4 w; w.x = ::pack2(v0[0], v0[1]); w.y = ::pack2(v0[2], v0[3]); w.z = ::pack2(v1[0], v1[1]); w.w = ::pack2(v1[2], v1[3]);
                    *(u32x4*)(rowp + bj * HALF) = w; } }
    }
};
struct PieceOrder {
    int pm, pn; bool have;
    __device__ __forceinline__ bool next(int i, Unit& u) const { if (i != 0 || !have) return false; u.pm = pm; u.pn = pn; return true; }
    __device__ __forceinline__ void a_ready(const Unit&) const {}
    __device__ __forceinline__ void done(const Unit&) const {}
};
struct WinCOrder {
    int G, c;
    __device__ __forceinline__ bool next(int i, Unit& u) const {
        const long L = (long)i * G + c; if (L >= 342) return false;
        if (L < 330) { u.pm = (int)(L / 5); u.pn = 4 + (int)(L % 5); }
        else { const int j = (int)L - 330, k6 = j % 6; u.pm = 64 + j / 6; u.pn = k6 < 4 ? k6 : k6 + 5; }
        return true; }
    __device__ __forceinline__ void a_ready(const Unit&) const {}
    __device__ __forceinline__ void done(const Unit&) const {}
};
struct PEpiF32 {
    static constexpr bool PERM = true, AFTER_DRAIN = false;
    float* O; int ldc;
    __device__ __forceinline__ void operator()(const f32x4 (&acc)[2][2][4][2], const Unit& u, int wr, int wc, int fr, int fq) const {
        const int row0 = u.pm * BM + wr * 64 + fr, col0 = u.pn * BM + wc * 32 + 8 * fq;
#pragma unroll
        for (int ai = 0; ai < 2; ++ai)
#pragma unroll
            for (int m = 0; m < 4; ++m) { float* rowp = O + (size_t)(row0 + ai * HALF + m * 16) * ldc + col0;
#pragma unroll
                for (int bj = 0; bj < 2; ++bj) { *(f32x4*)(rowp + bj * HALF) = acc[ai][bj][m][0]; *(f32x4*)(rowp + bj * HALF + 4) = acc[ai][bj][m][1]; } }
    }
};
struct PEpiWin {
    static constexpr bool PERM = true, AFTER_DRAIN = false;
    bf16_t *za, *zb, *zc, *zd, *vta, *vtd;
    __device__ __forceinline__ void operator()(const f32x4 (&acc)[2][2][4][2], const Unit& u, int wr, int wc, int fr, int fq) const {
        const int row0 = u.pm * BM + wr * 64 + fr;
#pragma unroll
        for (int bj = 0; bj < 2; ++bj) {
            const int pc = u.pn * BM + bj * HALF + wc * 32 + 8 * fq;
            bf16_t* dst; int col, ld; bf16_t* vt = nullptr; bool ok = true;
            if (pc < 512) { col = pc; dst = za; ld = 512; if (col >= 384) vt = vta; }
            else if (pc < 1024) { col = pc - 512; dst = zb; ld = 512; }
            else if (pc < 2304) { col = pc - 1024; dst = zc; ld = 1152; ok = col < 1152; }
            else { col = pc - 2304; dst = zd; ld = 512; if (col >= 384) vt = vtd; }
#pragma unroll
            for (int ai = 0; ai < 2; ++ai)
#pragma unroll
                for (int m = 0; m < 4; ++m) {
                    const int r = row0 + ai * HALF + m * 16;
                    const f32x4 v0 = acc[ai][bj][m][0], v1 = acc[ai][bj][m][1];
                    if (vt) {
                        bf16_t* base = vt + ((size_t)::batch_of_row(r) * 128 + (col - 384)) * KEYS + ::key_of_row(r);
                        base[0] = ::f2bf(v0[0]); base[(size_t)KEYS] = ::f2bf(v0[1]); base[(size_t)2 * KEYS] = ::f2bf(v0[2]); base[(size_t)3 * KEYS] = ::f2bf(v0[3]);
                        base[(size_t)4 * KEYS] = ::f2bf(v1[0]); base[(size_t)5 * KEYS] = ::f2bf(v1[1]); base[(size_t)6 * KEYS] = ::f2bf(v1[2]); base[(size_t)7 * KEYS] = ::f2bf(v1[3]);
                    } else if (ok) {
                        u32x4 w; w.x = ::pack2(v0[0], v0[1]); w.y = ::pack2(v0[2], v0[3]); w.z = ::pack2(v1[0], v1[1]); w.w = ::pack2(v1[2], v1[3]);
                        *(u32x4*)(dst + (size_t)r * ld + col) = w;
                    }
                }
        }
    }
};

template <class Epi, class Sched, bool ALIGN_EPI = false, bool SP2 = false>
__device__ __forceinline__ void gemm_phase(PG8_LAS unsigned char* lds, const Gemm g, const Sched& S, const Epi& E) {
    const int tid = otid(), wid = __builtin_amdgcn_readfirstlane(tid >> 6), lane = tid & 63, wr = wid >> 2, wc = wid & 3, fr = lane & 15, fq = lane >> 4;
    const int K = g.ld, nt = g.K / BK;
    unsigned voffA[2], voffB[2];
#pragma unroll
    for (int i = 0; i < 2; ++i) { int R, C; stage_rc(tid * 16 + i * 8192, R, C); const int Rb = Epi::PERM ? ((R & ~31) + perm32(R & 31)) : R;
        voffA[i] = (unsigned)(R * K + C) * 2u; voffB[i] = (unsigned)(Rb * K + C) * 2u; }
    const size_t kstep = (size_t)(BK * 2);
    const size_t hstep = (size_t)HALF * K * 2;
    const size_t tstep = 2 * hstep;
    const unsigned ldsw = (unsigned)wid * 1024u;
    const int aoff = lds_byte(wr * 64 + fr, fq * 8), boff = lds_byte(wc * 32 + fr, fq * 8);
#define PG8_SA(b, h) (((b) * 2 + (h)) * HTB)
#define PG8_SB(b, h) ((4 + (b) * 2 + (h)) * HTB)
#define PG8_STAGE(bufoff, gbase, voff) do { _Pragma("unroll") for (int _i = 0; _i < 2; ++_i) \
        __builtin_amdgcn_global_load_lds((const unsigned*)((const char*)(gbase) + (voff)[_i]), (PG8_LAS unsigned*)(lds + (bufoff) + ldsw + _i * 8192), 16, 0, 0); } while (0)
#define PG8_LDA(dst, b, h) do { _Pragma("unroll") for (int m = 0; m < 4; ++m) _Pragma("unroll") for (int k = 0; k < 2; ++k) dst[m][k] = *(const PG8_LAS bf16x8*)(lds + PG8_SA(b, h) + aoff + m * 2048 + k * 1024); } while (0)
#define PG8_LDB(dst, b, h) do { _Pragma("unroll") for (int n = 0; n < 2; ++n) _Pragma("unroll") for (int k = 0; k < 2; ++k) dst[n][k] = *(const PG8_LAS bf16x8*)(lds + PG8_SB(b, h) + boff + n * 2048 + k * 1024); } while (0)
#define PG8_MMA(ai, bj, At, Bt) do { __builtin_amdgcn_s_setprio(1); _Pragma("unroll") for (int m = 0; m < 4; ++m) _Pragma("unroll") for (int n = 0; n < 2; ++n) _Pragma("unroll") for (int k = 0; k < 2; ++k) \
        acc[ai][bj][m][n] = __builtin_amdgcn_mfma_f32_16x16x32_bf16(Bt[n][k], At[m][k], acc[ai][bj][m][n], 0, 0, 0); __builtin_amdgcn_s_setprio(0); } while (0)
#define PG8_WAIT_V(n) asm volatile("s_waitcnt vmcnt(" #n ")" ::: "memory")
#define PG8_WAIT_L(n) asm volatile("s_waitcnt lgkmcnt(" #n ")" ::: "memory")
#define PG8_BAR __builtin_amdgcn_s_barrier()
#define PG8_SCHED __builtin_amdgcn_sched_barrier(0)
    Unit cur, nxt; int ui = 0;
    if (!S.next(0, cur)) return;
    f32x4 acc[2][2][4][2];
#pragma unroll
    for (int a = 0; a < 2; ++a)
#pragma unroll
        for (int b = 0; b < 2; ++b)
#pragma unroll
            for (int m = 0; m < 4; ++m)
#pragma unroll
                for (int n = 0; n < 2; ++n) acc[a][b][m][n] = (f32x4){0.f, 0.f, 0.f, 0.f};
    bf16x8 At[4][2], B0[2][2], B1[2][2];
    const char* cA = (const char*)g.A + (size_t)cur.pm * tstep; const char* cB = (const char*)g.Bt + (size_t)cur.pn * tstep;
    S.a_ready(cur);
    if constexpr (SP2) {
        PG8_STAGE(PG8_SB(0, 0), cB, voffB); PG8_STAGE(PG8_SB(0, 1), cB + hstep, voffB); PG8_STAGE(PG8_SA(0, 0), cA, voffA); PG8_STAGE(PG8_SA(0, 1), cA + hstep, voffA);
        if (wr == 1) PG8_BAR;
        PG8_WAIT_V(2); PG8_BAR;
        PG8_STAGE(PG8_SB(1, 0), cB + kstep, voffB); PG8_STAGE(PG8_SA(1, 0), cA + kstep, voffA); PG8_STAGE(PG8_SB(1, 1), cB + hstep + kstep, voffB);
        PG8_WAIT_V(6); PG8_BAR;
    } else {
        PG8_STAGE(PG8_SB(0, 0), cB, voffB); PG8_STAGE(PG8_SA(0, 0), cA, voffA); PG8_STAGE(PG8_SB(0, 1), cB + hstep, voffB); PG8_STAGE(PG8_SA(0, 1), cA + hstep, voffA);
        if (wr == 1) PG8_BAR;
        PG8_WAIT_V(4); PG8_BAR;
        PG8_STAGE(PG8_SB(1, 0), cB + kstep, voffB); PG8_STAGE(PG8_SA(1, 0), cA + kstep, voffA); PG8_STAGE(PG8_SB(1, 1), cB + hstep + kstep, voffB);
        PG8_WAIT_V(6); PG8_BAR;
    }
    for (;;) {
        const bool has_next = S.next(ui + 1, nxt);
        const char* nA = has_next ? (const char*)g.A + (size_t)nxt.pm * tstep : cA; const char* nB = has_next ? (const char*)g.Bt + (size_t)nxt.pn * tstep : cB;
        for (int t = 0; t < nt; t += 2) {
            const bool last = (t == nt - 2);
            const char* a1 = cA + (size_t)(t + 1) * kstep;
            const char* a2 = last ? nA : cA + (size_t)(t + 2) * kstep; const char* b2 = last ? nB : cB + (size_t)(t + 2) * kstep;
            const char* a3 = a2 + kstep; const char* b3 = b2 + kstep;
            if (last && has_next) S.a_ready(nxt);
            if constexpr (SP2) {
            PG8_LDB(B0, 0, 0); PG8_LDB(B1, 0, 1); PG8_SCHED; PG8_LDA(At, 0, 0); PG8_STAGE(PG8_SA(1, 1), a1 + hstep, voffA);
            PG8_WAIT_V(8); PG8_WAIT_L(0); PG8_BAR; PG8_MMA(0, 0, At, B0); PG8_MMA(0, 1, At, B1); PG8_BAR; PG8_SCHED;
            PG8_LDA(At, 0, 1); PG8_STAGE(PG8_SB(0, 0), b2, voffB); PG8_STAGE(PG8_SB(0, 1), b2 + hstep, voffB); PG8_STAGE(PG8_SA(0, 0), a2, voffA);
            PG8_WAIT_V(8); PG8_WAIT_L(0); PG8_BAR; PG8_MMA(1, 0, At, B0); PG8_MMA(1, 1, At, B1); PG8_BAR; PG8_SCHED;
            PG8_LDB(B0, 1, 0); PG8_LDB(B1, 1, 1); PG8_SCHED; PG8_LDA(At, 1, 0); PG8_STAGE(PG8_SA(0, 1), a2 + hstep, voffA);
            PG8_WAIT_V(8); PG8_WAIT_L(0); PG8_BAR; PG8_MMA(0, 0, At, B0); PG8_MMA(0, 1, At, B1); PG8_BAR; PG8_SCHED;
            PG8_LDA(At, 1, 1); PG8_STAGE(PG8_SB(1, 0), b3, voffB); PG8_STAGE(PG8_SB(1, 1), b3 + hstep, voffB); PG8_STAGE(PG8_SA(1, 0), a3, voffA);
            PG8_WAIT_V(8); PG8_WAIT_L(0); PG8_BAR; PG8_MMA(1, 0, At, B0); PG8_MMA(1, 1, At, B1); PG8_BAR; PG8_SCHED;
            } else {
            PG8_LDB(B0, 0, 0); PG8_SCHED; PG8_LDA(At, 0, 0); PG8_STAGE(PG8_SA(1, 1), a1 + hstep, voffA);
            PG8_WAIT_L(8); PG8_BAR; PG8_WAIT_L(0); PG8_MMA(0, 0, At, B0); PG8_BAR; PG8_SCHED;
            PG8_LDB(B1, 0, 1); PG8_STAGE(PG8_SB(0, 0), b2, voffB);
            PG8_BAR; PG8_WAIT_L(0); PG8_MMA(0, 1, At, B1); PG8_BAR;
            PG8_LDA(At, 0, 1); PG8_STAGE(PG8_SA(0, 0), a2, voffA);
            PG8_BAR; PG8_WAIT_L(0); PG8_MMA(1, 0, At, B0); PG8_BAR; PG8_SCHED;
            PG8_STAGE(PG8_SB(0, 1), b2 + hstep, voffB);
            PG8_WAIT_V(6); PG8_BAR; PG8_MMA(1, 1, At, B1); PG8_BAR;
            PG8_LDB(B0, 1, 0); PG8_SCHED; PG8_LDA(At, 1, 0); PG8_STAGE(PG8_SA(0, 1), a2 + hstep, voffA);
            PG8_WAIT_L(8); PG8_BAR; PG8_WAIT_L(0); PG8_MMA(0, 0, At, B0); PG8_BAR; PG8_SCHED;
            PG8_LDB(B1, 1, 1); PG8_STAGE(PG8_SB(1, 0), b3, voffB);
            PG8_BAR; PG8_WAIT_L(0); PG8_MMA(0, 1, At, B1); PG8_BAR;
            PG8_LDA(At, 1, 1); PG8_STAGE(PG8_SA(1, 0), a3, voffA);
            PG8_BAR; PG8_WAIT_L(0); PG8_MMA(1, 0, At, B0); PG8_BAR; PG8_SCHED;
            PG8_STAGE(PG8_SB(1, 1), b3 + hstep, voffB);
            PG8_WAIT_V(6); PG8_BAR; PG8_MMA(1, 1, At, B1); PG8_BAR;
            }
        }
        if constexpr (ALIGN_EPI) { if (wr == 0) PG8_BAR; }
        if constexpr (!Epi::AFTER_DRAIN) { E(acc, cur, wr, wc, fr, fq); S.done(cur); }
        if (!has_next) break;
#pragma unroll
        for (int a = 0; a < 2; ++a)
#pragma unroll
            for (int b = 0; b < 2; ++b)
#pragma unroll
                for (int m = 0; m < 4; ++m)
#pragma unroll
                    for (int n = 0; n < 2; ++n) acc[a][b][m][n] = (f32x4){0.f, 0.f, 0.f, 0.f};
        cur = nxt; cA = nA; cB = nB; ++ui;
        if constexpr (ALIGN_EPI) { if (wr == 1) PG8_BAR; }
    }
    PG8_WAIT_V(0);
    if constexpr (!ALIGN_EPI) { if (wr == 0) PG8_BAR; }
    PG8_BAR;
    if constexpr (Epi::AFTER_DRAIN) { E.fused(acc, cur, wr, wc, fr, fq, lds, wid, lane); S.done(cur); }
#undef PG8_SA
#undef PG8_SB
#undef PG8_STAGE
#undef PG8_LDA
#undef PG8_LDB
#undef PG8_MMA
#undef PG8_WAIT_V
#undef PG8_WAIT_L
#undef PG8_BAR
#undef PG8_SCHED
}
}
template <class Epi>
DI void gemm_small_tile(const bf16_t* __restrict__ A, int lda, const bf16_t* __restrict__ W, int ldw, int mt, int nt, int K, char* smem, Epi epi) {
  bf16_t* As = (bf16_t*)smem;
  bf16_t* Bs = As + 2 * 256 * 72;
  const int tid = otid(), lane = tid & 63, wave = tid >> 6;
  const int wm = wave >> 1, wn = wave & 1, l = lane & 31, h = lane >> 5;
  const int nk = K >> 6;
  {
    const int m0 = mt * 256, n0 = nt * 128;
    f32x16 acc[2][2];
#pragma unroll
    for (int i = 0; i < 2; ++i)
#pragma unroll
      for (int j = 0; j < 2; ++j)
#pragma unroll
        for (int q = 0; q < 16; ++q) acc[i][j][q] = 0.f;
    uint4 sA0, sA1, sA2, sA3, sA4, sA5, sB0, sB1, sB2, sB3, sB4, sB5;
    const bf16_t* ap[4];
    const bf16_t* bp[2];
    int aoff[4], boff[2];
#pragma unroll
    for (int i = 0; i < 4; ++i) {
      int c = tid + THREADS * i, row = c >> 3, kc = c & 7;
      ap[i] = A + (size_t)(m0 + row) * lda + kc * 8;
      aoff[i] = row * 72 + kc * 8;
    }
#pragma unroll
    for (int i = 0; i < 2; ++i) {
      int c = tid + THREADS * i, row = c >> 3, kc = c & 7;
      bp[i] = W + (size_t)(n0 + row) * ldw + kc * 8;
      boff[i] = row * 72 + kc * 8;
    }
    const bf16_t* Ab = As + (wm * 64 + l) * 72 + 8 * h;
    const bf16_t* Bb = Bs + (wn * 64 + l) * 72 + 8 * h;
#define G_LOAD(P, KT) { const int k1_ = (KT) << 6; P##0 = *(const uint4*)(ap[0] + k1_); P##1 = *(const uint4*)(ap[1] + k1_); P##2 = *(const uint4*)(ap[2] + k1_); \
                        P##3 = *(const uint4*)(ap[3] + k1_); P##4 = *(const uint4*)(bp[0] + k1_); P##5 = *(const uint4*)(bp[1] + k1_); }
#define G_STORE(P, BUF) { *(uint4*)(As + (BUF) * 256 * 72 + aoff[0]) = P##0; *(uint4*)(As + (BUF) * 256 * 72 + aoff[1]) = P##1; *(uint4*)(As + (BUF) * 256 * 72 + aoff[2]) = P##2; \
                          *(uint4*)(As + (BUF) * 256 * 72 + aoff[3]) = P##3; *(uint4*)(Bs + (BUF) * 128 * 72 + boff[0]) = P##4; *(uint4*)(Bs + (BUF) * 128 * 72 + boff[1]) = P##5; }
#define G_COMPUTE(BUF) { _Pragma("unroll") for (int ks = 0; ks < 4; ++ks) { bf16x8 af[2], bfr[2]; \
        af[0] = *(const bf16x8*)(Ab + (BUF) * 256 * 72 + ks * 16); af[1] = *(const bf16x8*)(Ab + (BUF) * 256 * 72 + 32 * 72 + ks * 16); \
        bfr[0] = *(const bf16x8*)(Bb + (BUF) * 128 * 72 + ks * 16); bfr[1] = *(const bf16x8*)(Bb + (BUF) * 128 * 72 + 32 * 72 + ks * 16); \
        _Pragma("unroll") for (int i = 0; i < 2; ++i) _Pragma("unroll") for (int j = 0; j < 2; ++j) acc[i][j] = MFMA32(bfr[j], af[i], acc[i][j]); } }
    G_LOAD(sA, 0);
    sB0 = sA0; sB1 = sA1; sB2 = sA2; sB3 = sA3; sB4 = sA4; sB5 = sA5;
    if (nk > 1) G_LOAD(sB, 1);
    for (int kt = 0; kt < nk; kt += 2) {
      G_STORE(sA, 0);
      __syncthreads();
      if (kt + 2 < nk) G_LOAD(sA, kt + 2);
      G_COMPUTE(0);
      if (kt + 1 < nk) {
        G_STORE(sB, 1);
        __syncthreads();
        if (kt + 3 < nk) G_LOAD(sB, kt + 3);
        G_COMPUTE(1);
      }
    }
    __syncthreads();
#pragma unroll
    for (int i = 0; i < 2; ++i)
#pragma unroll
      for (int j = 0; j < 2; ++j) epi(m0 + wm * 64 + 32 * i + l, n0 + wn * 64 + 32 * j, h, acc[i][j]);
  }
#undef G_LOAD
#undef G_STORE
#undef G_COMPUTE
}
template <class Epi>
DI void gemm_small(const bf16_t* __restrict__ A, int lda, const bf16_t* __restrict__ W, int ldw, int mtiles, int ntiles, int K,
                   int& rot, char* smem, Epi epi) {
  const int G = gridDim.x, total = mtiles * ntiles;
  const int vcu = (G % 8 == 0) ? (obid() % 8) * (G / 8) + obid() / 8 : obid();
  int first = (int)((vcu + G - (rot % G)) % G);
#pragma unroll 1
  for (int tile = first; tile < total; tile += G) {
    const int mt = tile / ntiles, nt = tile - mt * ntiles;
    gemm_small_tile(A, lda, W, ldw, mt, nt, K, smem, epi);
  }
  rot += total;
}

struct EpiUq {
  bf16_t* bq;
  DI void operator()(int m, int nbase, int h, const f32x16& a) const {
    const float qs = 0.10206207261596577f * LOG2E;
    const bool rope = ((nbase % 96) == 64) && (m < NLAT);
    float o[16];
    if (rope) {
      const int t = m & (T_ - 1);
#pragma unroll
      for (int g = 0; g < 4; ++g) {
        const float pos = (g >> 1) ? (float)(t & 63) : (float)(t >> 6);
#pragma unroll
        for (int c = 0; c < 4; ++c) {
          const int fi = 4 * h + c;
          const float inv = fexp2(-(float)fi * (13.287712379549449f / 8.f));
          const float rev = pos * inv * 0.15915494309189535f;
          const float sn = __builtin_amdgcn_sinf(rev), cs = __builtin_amdgcn_cosf(rev);
          const float own = a[4 * g + c], par = a[4 * (g ^ 1) + c];
          o[4 * g + c] = (g & 1) ? (par * sn + own * cs) : (own * cs - par * sn);
        }
      }
    } else {
#pragma unroll
      for (int q = 0; q < 16; ++q) o[q] = a[q];
    }
    bf16_t* dst = bq + (size_t)m * 384 + nbase + 4 * h;
#pragma unroll
    for (int g = 0; g < 4; ++g) st4bf(dst + 8 * g, o[4 * g] * qs, o[4 * g + 1] * qs, o[4 * g + 2] * qs, o[4 * g + 3] * qs);
  }
};
struct EpiUkv {
  bf16_t *bk, *vtb;
  DI void operator()(int m, int nbase, int h, const f32x16& a) const {
    const int head = nbase >> 7, dd = nbase & 127;
    if (dd < 64) {
      bf16_t* dst = bk + (size_t)m * 384 + head * 96 + dd + 4 * h;
#pragma unroll
      for (int g = 0; g < 4; ++g) st4bf(dst + 8 * g, a[4 * g], a[4 * g + 1], a[4 * g + 2], a[4 * g + 3]);
    } else {
      const int b = batch_of_row(m), key = key_of_row(m);
      bf16_t* base = vtb + ((size_t)b * 256 + head * 64 + (dd - 64)) * KEYS + key;
#pragma unroll
      for (int g = 0; g < 4; ++g)
#pragma unroll
        for (int c = 0; c < 4; ++c) base[(size_t)(8 * g + 4 * h + c) * KEYS] = f2bf(a[4 * g + c]);
    }
  }
};
struct EpiUqkv {
  int type; bf16_t *bq, *bk, *vtb;
  DI void operator()(int m, int nbase, int h, const f32x16& a) const {
    if (type == 0) EpiUq{bq}(m, nbase, h, a); else EpiUkv{bk, vtb}(m, nbase, h, a);
  }
};
struct EpiWlora {
  bf16_t* dst; const float* w0;
  DI void operator()(int m, int nbase, int h, const f32x16& a) const {
    float o[16];
#pragma unroll
    for (int g = 0; g < 4; ++g)
#pragma unroll
      for (int c = 0; c < 4; ++c) {
        const float u = w0[nbase + 8 * g + 4 * h + c] + a[4 * g + c];
        const float ew = 0.6065306597126334f * sigmoidf_(u);
        o[4 * g + c] = 1.f - fexp(-ew);
      }
    bf16_t* d = dst + (size_t)m * 1792 + nbase + 4 * h;
#pragma unroll
    for (int g = 0; g < 4; ++g) st4bf(d + 8 * g, o[4 * g], o[4 * g + 1], o[4 * g + 2], o[4 * g + 3]);
  }
};
struct EpiAlora {
  bf16_t* dst; const float* a0;
  DI void operator()(int m, int nbase, int h, const f32x16& a) const {
    float o[16];
#pragma unroll
    for (int g = 0; g < 4; ++g)
#pragma unroll
      for (int c = 0; c < 4; ++c) o[4 * g + c] = sigmoidf_(a0[nbase + 8 * g + 4 * h + c] + a[4 * g + c]);
    bf16_t* d = dst + (size_t)m * 1792 + nbase + 4 * h;
#pragma unroll
    for (int g = 0; g < 4; ++g) st4bf(d + 8 * g, o[4 * g], o[4 * g + 1], o[4 * g + 2], o[4 * g + 3]);
  }
};
struct EpiBf16 {
  bf16_t* dst; int ld; bool sqrelu;
  DI void operator()(int m, int nbase, int h, const f32x16& a) const {
    bf16_t* d = dst + (size_t)m * ld + nbase + 4 * h;
#pragma unroll
    for (int g = 0; g < 4; ++g) {
      float v0 = a[4 * g], v1 = a[4 * g + 1], v2 = a[4 * g + 2], v3 = a[4 * g + 3];
      if (sqrelu) { v0 = fmaxf(v0, 0.f); v1 = fmaxf(v1, 0.f); v2 = fmaxf(v2, 0.f); v3 = fmaxf(v3, 0.f); v0 *= v0; v1 *= v1; v2 *= v2; v3 *= v3; }
      st4bf(d + 8 * g, v0, v1, v2, v3);
    }
  }
};

DI void unpack8(const uint4 u, float* f) {
  f[0] = __uint_as_float(u.x << 16); f[1] = __uint_as_float(u.x & 0xffff0000u); f[2] = __uint_as_float(u.y << 16); f[3] = __uint_as_float(u.y & 0xffff0000u);
  f[4] = __uint_as_float(u.z << 16); f[5] = __uint_as_float(u.z & 0xffff0000u); f[6] = __uint_as_float(u.w << 16); f[7] = __uint_as_float(u.w & 0xffff0000u);
}
DI uint4 pack8(const float* f) { return make_uint4(pack2(f[0], f[1]), pack2(f[2], f[3]), pack2(f[4], f[5]), pack2(f[6], f[7])); }
DI float allreduce8(float v) {
  v += dpp_mov<0xB1>(v);
  v += dpp_mov<0x4E>(v);
  v += dpp_mov<0x141>(v);
  return v;
}
DI uint4 dpp_u4_xor2(uint4 u) {
  uint4 r;
  r.x = (unsigned)__builtin_amdgcn_update_dpp(0, (int)u.x, 0x4E, 0xf, 0xf, false); r.y = (unsigned)__builtin_amdgcn_update_dpp(0, (int)u.y, 0x4E, 0xf, 0xf, false);
  r.z = (unsigned)__builtin_amdgcn_update_dpp(0, (int)u.z, 0x4E, 0xf, 0xf, false); r.w = (unsigned)__builtin_amdgcn_update_dpp(0, (int)u.w, 0x4E, 0xf, 0xf, false);
  return r;
}
DI uint4 dpp_u4_xor1(uint4 u) {
  uint4 r;
  r.x = (unsigned)__builtin_amdgcn_update_dpp(0, (int)u.x, 0xB1, 0xf, 0xf, false); r.y = (unsigned)__builtin_amdgcn_update_dpp(0, (int)u.y, 0xB1, 0xf, 0xf, false);
  r.z = (unsigned)__builtin_amdgcn_update_dpp(0, (int)u.z, 0xB1, 0xf, 0xf, false); r.w = (unsigned)__builtin_amdgcn_update_dpp(0, (int)u.w, 0xB1, 0xf, 0xf, false);
  return r;
}
template <bool DO_ABD, bool DO_C>
DI void prep_rows(const Params& p, int l, int first, int end, int step) {
  char* ws = p.ws;
  const int tid_ = otid(); const int lane = tid_ & 63, wave = tid_ >> 6;
  bf16_t* ZA = (bf16_t*)(ws + OFF_ZA); bf16_t* ZD = (bf16_t*)(ws + OFF_ZD); bf16_t* ZB = (bf16_t*)(ws + OFF_ZB);
  const bf16_t* ZC = (const bf16_t*)(ws + OFF_ZC);
  bf16_t* BK = (bf16_t*)(ws + OFF_BK); bf16_t* SC = (bf16_t*)(ws + OFF_SCANIN);
  bf16_t* TW = (bf16_t*)(ws + OFF_TMPW); bf16_t* TA = (bf16_t*)(ws + OFF_TMPA); bf16_t* TG = (bf16_t*)(ws + OFF_TMPG);
  float* INVN = (float*)(ws + OFF_INVN);
  const float* mu = p.rwkv_mu + l * C_COLS;
  const float* kk0 = p.rwkv_k_k + (l * 2 + 0) * 256; const float* kk1 = p.rwkv_k_k + (l * 2 + 1) * 256;
  const int j = lane & 7;
  float gA[8], gAp[8];
  {
    const float* gsrc = (lane < 32 ? p.gqa_q_norm : p.gqa_k_norm) + l * 64;
#pragma unroll
    for (int e = 0; e < 8; ++e) { gA[e] = gsrc[8 * j + e]; gAp[e] = gsrc[(8 * j + e) ^ 16]; }
  }
  float inv64[8], inv32[8];
#pragma unroll
  for (int e = 0; e < 8; ++e) {
    inv64[e] = fexp2(-(float)(8 * (j & 1) + e) * (13.287712379549449f / 16.f)) * 0.15915494309189535f;
    inv32[e] = fexp2(-(float)e * (13.287712379549449f / 8.f)) * 0.15915494309189535f;
  }
  float gB[8];
#pragma unroll
  for (int e = 0; e < 8; ++e) gB[e] = lane < 32 ? p.mla_q_norm[l * 256 + 8 * lane + e] : (lane < 48 ? p.mla_kv_norm[l * 128 + 8 * (lane - 32) + e] : 0.f);
  float muc[3][8], kkc0[8], kkc1[8];
#pragma unroll
  for (int i = 0; i < 3; ++i)
#pragma unroll
    for (int e = 0; e < 8; ++e) { const int c = lane + 64 * i; muc[i][e] = (c < 132) ? mu[8 * c + e] : 0.f; }
#pragma unroll
  for (int e = 0; e < 8; ++e) { const int kc = (8 * lane - 256) & 255; kkc0[e] = kk0[kc + e]; kkc1[e] = kk1[kc + e]; }
  const bool x2_64 = (j >> 1) & 1, col64 = (j >> 2) & 1;
  const int jj = lane & 3; const bool x2_32 = jj & 1, col32 = (jj >> 1) & 1;
  for (int row = first + wave; row < end; row += step) {
    const bool lat = row < NLAT;
    const int t = row & (T_ - 1);
    const float prow = (float)(t >> 6), pcol = (float)(t & 63);
    uint4 ua = make_uint4(0, 0, 0, 0), ud = ua, ub = ua;
    if constexpr (DO_ABD) {
      ua = *(const uint4*)(ZA + (size_t)row * 512 + 8 * lane);
      ud = *(const uint4*)(ZD + (size_t)row * 512 + 8 * lane);
      ub = *(const uint4*)(ZB + (size_t)row * 512 + 8 * lane);
    }
    const int pos = lat ? t : ((row - NLAT) & (CTXL - 1));
    const int lastp = lat ? (T_ - 1) : (CTXL - 1);
    const bool hp = pos > 0, hn = pos < lastp;
    const bf16_t* zc = ZC + (size_t)row * 1152 + 8 * lane;
    uint4 c0[3], cp[3], cn[3];
#pragma unroll
    for (int i = 0; i < 3; ++i) {
      const bool ok = DO_C && ((i < 2) || (lane < 4));
      c0[i] = ok ? *(const uint4*)(zc + 512 * i) : make_uint4(0, 0, 0, 0);
      cp[i] = (ok && hp) ? *(const uint4*)(zc + 512 * i - 1152) : make_uint4(0, 0, 0, 0);
      cn[i] = (ok && hn) ? *(const uint4*)(zc + 512 * i + 1152) : make_uint4(0, 0, 0, 0);
    }
    if constexpr (DO_ABD) {
    float sn64[8], cs64[8], sn32[8], cs32[8];
    {
      const float p64 = col64 ? pcol : prow, p32 = col32 ? pcol : prow;
#pragma unroll
      for (int e = 0; e < 8; ++e) {
        const float r64 = lat ? p64 * inv64[e] : 0.f, r32 = lat ? p32 * inv32[e] : 0.f;
        sn64[e] = __builtin_amdgcn_sinf(r64); cs64[e] = __builtin_amdgcn_cosf(r64);
        sn32[e] = __builtin_amdgcn_sinf(r32); cs32[e] = __builtin_amdgcn_cosf(r32);
      }
    }
    {
      float x[8], xp[8];
      unpack8(ua, x); unpack8(dpp_u4_xor2(ua), xp);
      float ss = 0.f;
#pragma unroll
      for (int e = 0; e < 8; ++e) ss += x[e] * x[e];
      ss = allreduce8(ss);
      const float rs = frsqrt(ss * (1.f / 64.f) + EPS);
      const float sc = lane < 32 ? 0.125f * LOG2E : 1.f;
      float o[8];
#pragma unroll
      for (int e = 0; e < 8; ++e) {
        const float own = x[e] * rs * gA[e], par = xp[e] * rs * gAp[e];
        o[e] = (x2_64 ? (par * sn64[e] + own * cs64[e]) : (own * cs64[e] - par * sn64[e])) * sc;
      }
      if (lane < 48) *(uint4*)(ZA + (size_t)row * 512 + 8 * lane) = pack8(o);
    }
    {
      float x[8], xp[8];
      unpack8(ud, x); unpack8(dpp_u4_xor2(ud), xp);
      const float sc = lane < 32 ? 0.125f * LOG2E : 1.f;
      float o[8];
#pragma unroll
      for (int e = 0; e < 8; ++e) o[e] = (x2_64 ? (xp[e] * sn64[e] + x[e] * cs64[e]) : (x[e] * cs64[e] - xp[e] * sn64[e])) * sc;
      if (lane < 48) *(uint4*)(ZD + (size_t)row * 512 + 8 * lane) = pack8(o);
    }
    {
      float x[8], xp[8];
      unpack8(ub, x); unpack8(dpp_u4_xor1(ub), xp);
      float ss = 0.f;
#pragma unroll
      for (int e = 0; e < 8; ++e) ss += x[e] * x[e];
      const float s16 = allreduce16(ss);
      const float s32 = s16 + __shfl_xor(s16, 16);
      const float rs = lane < 32 ? frsqrt(s32 * (1.f / 256.f) + EPS) : frsqrt(s16 * (1.f / 128.f) + EPS);
      float o[8];
#pragma unroll
      for (int e = 0; e < 8; ++e) o[e] = x[e] * rs * gB[e];
      if (lane < 48) *(uint4*)(ZB + (size_t)row * 512 + 8 * lane) = pack8(o);
      float kr[8];
#pragma unroll
      for (int e = 0; e < 8; ++e) kr[e] = x2_32 ? (xp[e] * sn32[e] + x[e] * cs32[e]) : (x[e] * cs32[e] - xp[e] * sn32[e]);
      if (lane >= 48 && lane < 52) {
        const uint4 kb = pack8(kr);
        bf16_t* bk = BK + (size_t)row * 384 + 64 + 8 * jj;
        *(uint4*)(bk) = kb; *(uint4*)(bk + 96) = kb; *(uint4*)(bk + 192) = kb; *(uint4*)(bk + 288) = kb;
      }
    }
    }
    if constexpr (DO_C) {
#pragma unroll
    for (int i = 0; i < 3; ++i) {
      const int c = lane + 64 * i;
      if (c < 132) {
        float z[8], zp[8], zn[8], zs[8];
        unpack8(c0[i], z); unpack8(cp[i], zp); unpack8(cn[i], zn);
#pragma unroll
        for (int e = 0; e < 8; ++e) zs[e] = z[e] + muc[i][e] * (0.5f * (zp[e] + zn[e]) - z[e]);
        if (c < 96) {
          const uint4 pk = pack8(zs);
          *(uint4*)(SC + (size_t)row * 1792 + 8 * c) = pk;
          if (i == 0) {
            float kq[8]; unpack8(pk, kq);
            float s0 = 0.f, s1 = 0.f;
#pragma unroll
            for (int e = 0; e < 8; ++e) { const float a0 = kq[e] * kkc0[e], a1 = kq[e] * kkc1[e]; s0 += a0 * a0; s1 += a1 * a1; }
            s0 = allreduce8(s0); s1 = allreduce8(s1);
            if (lane >= 32 && j == 0) {
              const int hd = (lane - 32) >> 3;
              INVN[(size_t)row * 8 + hd] = fminf(frsqrt(s0), 1e12f);
              INVN[(size_t)row * 8 + 4 + hd] = fminf(frsqrt(s1), 1e12f);
            }
          }
        } else if (c < 104) {
          float o[8];
#pragma unroll
          for (int e = 0; e < 8; ++e) { const float ex = fexp(2.f * zs[e]); o[e] = 1.f - 2.f * frcp(ex + 1.f); }
          *(uint4*)(TW + (size_t)row * 64 + 8 * (c - 96)) = pack8(o);
        } else if (c < 112) {
          *(uint4*)(TA + (size_t)row * 64 + 8 * (c - 104)) = pack8(zs);
        } else {
          float o[8];
#pragma unroll
          for (int e = 0; e < 8; ++e) o[e] = sigmoidf_(zs[e]);
          *(uint4*)(TG + (size_t)row * 192 + 8 * (c - 112)) = pack8(o);
        }
      } else if (c < 136) {
        *(uint4*)(TG + (size_t)row * 192 + 8 * (c - 112)) = make_uint4(0, 0, 0, 0);
      }
    }
    }
  }
}

template <int DK>
DI void attn_item(const bf16_t* __restrict__ Q, int ldq, const bf16_t* __restrict__ Kg, int ldk, const bf16_t* __restrict__ Vt,
                  int qrow0, int b, int lat_t0, int lat_t1, bool window, int qpos0, bool use_sink, float sink_l2,
                  bf16_t* out, int ldo, char* smem) {
  constexpr int KS = DK + 8, NKS = DK / 16, CPR = DK / 8;
  bf16_t* Ks = (bf16_t*)smem;
  bf16_t* Vs = Ks + 2 * 64 * KS;
  const int tid = otid(), lane = tid & 63, wave = tid >> 6, l = lane & 31, h = lane >> 5;
  const int pl = (l & ~12) | ((l & 4) << 1) | ((l & 8) >> 1);
  const int nlat = lat_t1 - lat_t0, ntile = nlat + 4;
  bf16x8 qf[NKS];
  {
    const bf16_t* qp = Q + (size_t)(qrow0 + wave * 32 + l) * ldq + 8 * h;
#pragma unroll
    for (int ks = 0; ks < NKS; ++ks) qf[ks] = *(const bf16x8*)(qp + ks * 16);
  }
  f32x16 o0, o1;
#pragma unroll
  for (int q = 0; q < 16; ++q) { o0[q] = 0.f; o1[q] = 0.f; }
  if (wave >= 4) __builtin_amdgcn_s_setprio(1);
  float m_run = use_sink ? sink_l2 : -64.f;
  f32x16 o2;
#pragma unroll
  for (int q = 0; q < 16; ++q) o2[q] = 0.f;
  o2[0] = (use_sink && h == 0) ? 1.f : 0.f;
  bf16x8 vones;
#pragma unroll
  for (int e = 0; e < 8; ++e) vones[e] = (l == 0) ? (short)0x3F80 : (short)0;
  const int qp_ = qpos0 + wave * 32 + l;

  uint4 rk0, rk1 = make_uint4(0, 0, 0, 0), rv;
  const int krow_a = tid / CPR, kc_a = tid % CPR;
  const int krow_b = (tid + 512) / CPR, kc_b = (tid + 512) % CPR;
  const int vrow = tid >> 3, vkc = tid & 7;
  auto tile_src = [&](int i, int& krow_base, int& vcol) {
    if (i < nlat) { const int kt = lat_t0 + i; krow_base = b * T_ + kt * 64; vcol = kt * 64; }
    else { const int c = i - nlat; krow_base = NLAT + b * CTXL + c * 64; vcol = T_ + c * 64; }
  };
  {
    int kb, vc; tile_src(0, kb, vc);
    rk0 = *(const uint4*)(Kg + (size_t)(kb + krow_a) * ldk + kc_a * 8);
    if (DK == 96 && tid < 256) rk1 = *(const uint4*)(Kg + (size_t)(kb + krow_b) * ldk + kc_b * 8);
    rv = *(const uint4*)(Vt + (size_t)vrow * KEYS + vc + vkc * 8);
    *(uint4*)(Ks + krow_a * KS + kc_a * 8) = rk0;
    if (DK == 96 && tid < 256) *(uint4*)(Ks + krow_b * KS + kc_b * 8) = rk1;
    *(uint4*)(Vs + vrow * 72 + vkc * 8) = rv;
  }
  __syncthreads();
  for (int it = 0; it < ntile; ++it) {
    const int buf = it & 1;
    if (it + 1 < ntile) {
      int kb, vc; tile_src(it + 1, kb, vc);
      rk0 = *(const uint4*)(Kg + (size_t)(kb + krow_a) * ldk + kc_a * 8);
      if (DK == 96 && tid < 256) rk1 = *(const uint4*)(Kg + (size_t)(kb + krow_b) * ldk + kc_b * 8);
      rv = *(const uint4*)(Vt + (size_t)vrow * KEYS + vc + vkc * 8);
    }
    const bf16_t* Kb = Ks + buf * 64 * KS + pl * KS + 8 * h;
    const bf16_t* Vb = Vs + buf * 64 * 72 + l * 72 + 8 * h;
    f32x16 s0, s1;
    {
      const float nm = -m_run;
#pragma unroll
      for (int q = 0; q < 16; ++q) { s0[q] = nm; s1[q] = nm; }
    }
#pragma unroll
    for (int ks = 0; ks < NKS; ++ks) {
      const bf16x8 k0 = *(const bf16x8*)(Kb + ks * 16);
      const bf16x8 k1 = *(const bf16x8*)(Kb + 32 * KS + ks * 16);
      s0 = MFMA32(k0, qf[ks], s0);
      s1 = MFMA32(k1, qf[ks], s1);
    }
    if (window && it < nlat) {
      const int kbase = (lat_t0 + it) * 64 + 8 * h - qp_;
#pragma unroll
      for (int q = 0; q < 16; ++q) {
        const int d0 = kbase + 16 * (q >> 3) + (q & 7);
        const int d1 = d0 + 32;
        if (d0 > 128 || d0 < -128) s0[q] = -1e30f;
        if (d1 > 128 || d1 < -128) s1[q] = -1e30f;
      }
    }
    int di = 0;
#pragma unroll
    for (int q = 0; q < 16; q += 2) {
      const int a0 = __float_as_int(s0[q]), a1 = __float_as_int(s1[q]), a2 = __float_as_int(s0[q + 1]), a3 = __float_as_int(s1[q + 1]);
      di = max(max(di, a0), max(a1, max(a2, a3)));
    }
    float d = __int_as_float(di);
    { const auto sw = __builtin_amdgcn_permlane32_swap(__float_as_uint(d), __float_as_uint(d), false, false); d = fmaxf(__uint_as_float(sw[0]), __uint_as_float(sw[1])); }
    if (__any(d > 8.f)) {
      const float alpha = fexp2(-d);
      m_run += d;
      o2[0] *= alpha;
#pragma unroll
      for (int q = 0; q < 16; ++q) { s0[q] -= d; s1[q] -= d; o0[q] *= alpha; o1[q] *= alpha; }
    }
#pragma unroll
    for (int q = 0; q < 16; ++q) { s0[q] = fexp2(s0[q]); s1[q] = fexp2(s1[q]); }
    bf16x8 pf[4];
#pragma unroll
    for (int s4 = 0; s4 < 4; ++s4) {
      unsigned u[4];
#pragma unroll
      for (int j = 0; j < 4; ++j) {
        const float e0 = (s4 < 2) ? s0[8 * (s4 & 1) + 2 * j] : s1[8 * (s4 & 1) + 2 * j];
        const float e1 = (s4 < 2) ? s0[8 * (s4 & 1) + 2 * j + 1] : s1[8 * (s4 & 1) + 2 * j + 1];
        u[j] = pack2(e0, e1);
      }
      pf[s4] = __builtin_bit_cast(bf16x8, make_uint4(u[0], u[1], u[2], u[3]));
    }
#pragma unroll
    for (int s4 = 0; s4 < 4; ++s4) {
      const bf16x8 v0 = *(const bf16x8*)(Vb + s4 * 16);
      const bf16x8 v1 = *(const bf16x8*)(Vb + 32 * 72 + s4 * 16);
      o0 = MFMA32(v0, pf[s4], o0);
      o1 = MFMA32(v1, pf[s4], o1);
      o2 = MFMA32(vones, pf[s4], o2);
    }
    if (it + 1 < ntile) {
      const int nb = buf ^ 1;
      *(uint4*)(Ks + nb * 64 * KS + krow_a * KS + kc_a * 8) = rk0;
      if (DK == 96 && tid < 256) *(uint4*)(Ks + nb * 64 * KS + krow_b * KS + kc_b * 8) = rk1;
      *(uint4*)(Vs + nb * 64 * 72 + vrow * 72 + vkc * 8) = rv;
    }
    __syncthreads();
  }
  __builtin_amdgcn_s_setprio(0);
  float lt;
  { const float l_run = o2[0]; const auto sw = __builtin_amdgcn_permlane32_swap(__float_as_uint(l_run), __float_as_uint(l_run), false, false); lt = __uint_as_float(sw[0]) + __uint_as_float(sw[1]); }
  const float inv = frcp(lt);
  bf16_t* op = out + (size_t)(qrow0 + wave * 32 + l) * ldo + 4 * h;
#pragma unroll
  for (int g = 0; g < 4; ++g) {
    st4bf(op + 8 * g, o0[4 * g] * inv, o0[4 * g + 1] * inv, o0[4 * g + 2] * inv, o0[4 * g + 3] * inv);
    st4bf(op + 32 + 8 * g, o1[4 * g] * inv, o1[4 * g + 1] * inv, o1[4 * g + 2] * inv, o1[4 * g + 3] * inv);
  }
}

DI void run_attn_item(const Params& p, int l, int kind, int b, int hq, int qt, bool isctx, char* smem) {
  char* ws = p.ws;
  const bf16_t* ZA = (const bf16_t*)(ws + OFF_ZA); const bf16_t* ZD = (const bf16_t*)(ws + OFF_ZD);
  const bf16_t* BQ = (const bf16_t*)(ws + OFF_BQ); const bf16_t* BK = (const bf16_t*)(ws + OFF_BK);
  const bf16_t* VTA = (const bf16_t*)(ws + OFF_VTA); const bf16_t* VTB = (const bf16_t*)(ws + OFF_VTB); const bf16_t* VTD = (const bf16_t*)(ws + OFF_VTD);
  bf16_t* OUTS = (bf16_t*)(ws + OFF_OUTS);
  const int qrow0 = isctx ? NLAT + b * CTXL : b * T_ + qt * 256;
  int t0 = 0, t1 = isctx ? 0 : 128;
  if (kind == 0) {
    attn_item<96>(BQ + hq * 96, 384, BK + hq * 96, 384, VTB + ((size_t)b * 256 + hq * 64) * KEYS, qrow0, b, t0, t1, false, 0, false, 0.f,
                  OUTS + 256 + hq * 64, 1024, smem);
  } else if (kind == 1) {
    attn_item<64>(ZA + hq * 64, 512, ZA + 256 + (hq >> 1) * 64, 512, VTA + ((size_t)b * 128 + (hq >> 1) * 64) * KEYS, qrow0, b, t0, t1, false, 0,
                  false, 0.f, OUTS + hq * 64, 1024, smem);
  } else {
    if (!isctx) { t0 = 4 * qt - 2; if (t0 < 0) t0 = 0; t1 = 4 * qt + 6; if (t1 > 128) t1 = 128; }
    attn_item<64>(ZD + hq * 64, 512, ZD + 256 + (hq >> 1) * 64, 512, VTD + ((size_t)b * 128 + (hq >> 1) * 64) * KEYS, qrow0, b, t0, t1, !isctx,
                  qt * 256, true, p.swa_sink[l * 4 + hq] * LOG2E, OUTS + 768 + hq * 64, 1024, smem);
  }
}

constexpr int SCH = 32;
constexpr int SST = 336;
DI int scan_row(int b, int dir, int s) {
  if (s < CTXL) return NLAT + b * CTXL + (dir ? CTXL - 1 - s : s);
  const int s2 = s - CTXL;
  return b * T_ + (dir ? T_ - 1 - s2 : s2);
}
DI void scan_block(const Params& p, int l, int sb, char* smem) {
  float* opbuf = (float*)smem;
  float* ybuf = opbuf + 2 * SCH * SST;
  const int tid = otid(), lane = tid & 63, wave = tid >> 6;
  const int chain = sb >> 2, rg = sb & 3, b = chain >> 3, hh = (chain >> 1) & 3, dir = chain & 1;
  const bf16_t* SC = (const bf16_t*)(p.ws + OFF_SCANIN);
  float* Y = (float*)(p.ws + OFF_Y) + (size_t)dir * NT * 256;
  const int nchunk = (CTXL + T_) / SCH;
  const float* INVN = (const float*)(p.ws + OFF_INVN);
  const int ht = tid - 256, fg = ht & 15;
  float kkc[4], kac[4];
#pragma unroll
  for (int e = 0; e < 4; ++e) {
    kkc[e] = p.rwkv_k_k[(l * 2 + dir) * 256 + hh * 64 + ((4 * fg + e) & 63)];
    kac[e] = p.rwkv_k_a[(l * 2 + dir) * 256 + hh * 64 + ((4 * fg + e) & 63)];
  }
  struct HStage { uint2 r0, k0, v0, w0, a0, r1, k1, v1, w1, a1; float n0, n1; };
  auto issue = [&](HStage& h, int ci) {
    {
      const int row = scan_row(b, dir, ci * SCH + (ht >> 4));
      const bf16_t* src = SC + (size_t)row * 1792 + hh * 64 + 4 * fg;
      h.r0 = *(const uint2*)(src); h.k0 = *(const uint2*)(src + 256); h.v0 = *(const uint2*)(src + 512);
      h.w0 = *(const uint2*)(src + (3 + dir) * 256); h.a0 = *(const uint2*)(src + (5 + dir) * 256);
      h.n0 = INVN[(size_t)row * 8 + dir * 4 + hh];
    }
    {
      const int row = scan_row(b, dir, ci * SCH + (ht >> 4) + 16);
      const bf16_t* src = SC + (size_t)row * 1792 + hh * 64 + 4 * fg;
      h.r1 = *(const uint2*)(src); h.k1 = *(const uint2*)(src + 256); h.v1 = *(const uint2*)(src + 512);
      h.w1 = *(const uint2*)(src + (3 + dir) * 256); h.a1 = *(const uint2*)(src + (5 + dir) * 256);
      h.n1 = INVN[(size_t)row * 8 + dir * 4 + hh];
    }
  };
  auto commit1 = [&](uint2 lr, uint2 lk, uint2 lv, uint2 lw, uint2 la, float inn, int ls, int bi) {
    float* st = opbuf + ((size_t)bi * SCH + ls) * SST + 4 * fg;
    float r4[4], k4[4], v4[4], w4[4], a4[4];
    r4[0] = __uint_as_float(lr.x << 16); r4[1] = __uint_as_float(lr.x & 0xffff0000u); r4[2] = __uint_as_float(lr.y << 16); r4[3] = __uint_as_float(lr.y & 0xffff0000u);
    k4[0] = __uint_as_float(lk.x << 16); k4[1] = __uint_as_float(lk.x & 0xffff0000u); k4[2] = __uint_as_float(lk.y << 16); k4[3] = __uint_as_float(lk.y & 0xffff0000u);
    v4[0] = __uint_as_float(lv.x << 16); v4[1] = __uint_as_float(lv.x & 0xffff0000u); v4[2] = __uint_as_float(lv.y << 16); v4[3] = __uint_as_float(lv.y & 0xffff0000u);
    w4[0] = __uint_as_float(lw.x << 16); w4[1] = __uint_as_float(lw.x & 0xffff0000u); w4[2] = __uint_as_float(lw.y << 16); w4[3] = __uint_as_float(lw.y & 0xffff0000u);
    a4[0] = __uint_as_float(la.x << 16); a4[1] = __uint_as_float(la.x & 0xffff0000u); a4[2] = __uint_as_float(la.y << 16); a4[3] = __uint_as_float(la.y & 0xffff0000u);
    float kk[4];
#pragma unroll
    for (int e = 0; e < 4; ++e) kk[e] = k4[e] * kkc[e] * inn;
    *(float4*)(st) = make_float4(1.f - w4[0], 1.f - w4[1], 1.f - w4[2], 1.f - w4[3]);
    *(float4*)(st + 64) = make_float4(-kk[0], -kk[1], -kk[2], -kk[3]);
    *(float4*)(st + 128) = make_float4(kk[0] * a4[0], kk[1] * a4[1], kk[2] * a4[2], kk[3] * a4[3]);
    *(float4*)(st + 192) = make_float4(k4[0] * (1.f + (a4[0] - 1.f) * kac[0]), k4[1] * (1.f + (a4[1] - 1.f) * kac[1]),
                                       k4[2] * (1.f + (a4[2] - 1.f) * kac[2]), k4[3] * (1.f + (a4[3] - 1.f) * kac[3]));
    *(float4*)(st + 256) = make_float4(r4[0], r4[1], r4[2], r4[3]);
    if ((fg >> 2) == rg) *(float4*)(opbuf + ((size_t)bi * SCH + ls) * SST + 320 + 4 * (fg & 3)) = make_float4(v4[0], v4[1], v4[2], v4[3]);
  };
  auto commit = [&](const HStage& h, int bi) {
    commit1(h.r0, h.k0, h.v0, h.w0, h.a0, h.n0, (ht >> 4), bi);
    commit1(h.r1, h.k1, h.v1, h.w1, h.a1, h.n1, (ht >> 4) + 16, bi);
  };
  auto flush = [&](int ci) {
    const float* yb = ybuf + (size_t)(ci & 1) * SCH * 256;
#pragma unroll
    for (int i = 0; i < 2; ++i) {
      const int o = ht + 256 * i, ls = o >> 4, r16 = o & 15;
      const float* src = yb + ls * 256 + r16 * 16;
      const float4 a = *(const float4*)(src), b4 = *(const float4*)(src + 4), c = *(const float4*)(src + 8), d = *(const float4*)(src + 12);
      const float y = ((a.x + a.y) + (a.z + a.w)) + ((b4.x + b4.y) + (b4.z + b4.w)) + ((c.x + c.y) + (c.z + c.w)) + ((d.x + d.y) + (d.z + d.w));
      Y[(size_t)scan_row(b, dir, ci * SCH + ls) * 256 + hh * 64 + rg * 16 + r16] = y;
    }
  };
  typedef float f2_t __attribute__((ext_vector_type(2)));
  f2_t Sa = {0.f, 0.f}, Sb = {0.f, 0.f};
  const int rowl = wave * 4 + (lane >> 4), c4 = lane & 15;
  auto process = [&](int bi) {
    const float* cb = opbuf + (size_t)bi * SCH * SST + 4 * c4;
    const float* vb = opbuf + (size_t)bi * SCH * SST + 320 + rowl;
    float* yb = ybuf + (size_t)bi * SCH * 256 + wave * 64 + lane;
    f2_t W0[3], W1[3], A0[3], A1[3], B0[3], B1[3], K0[3], K1[3], R0[3], R1[3]; float V_[3];
#define SC_LD2(DST0, DST1, PTR) { const float4 t_ = *(const float4*)(PTR); DST0 = (f2_t){t_.x, t_.y}; DST1 = (f2_t){t_.z, t_.w}; }
#define SC_LOAD(ST, SL) { const float* q_ = cb + (ST) * SST; SC_LD2(W0[SL], W1[SL], q_); SC_LD2(A0[SL], A1[SL], q_ + 64); SC_LD2(B0[SL], B1[SL], q_ + 128); \
                          SC_LD2(K0[SL], K1[SL], q_ + 192); SC_LD2(R0[SL], R1[SL], q_ + 256); V_[SL] = vb[(ST) * SST]; }
    SC_LOAD(0, 0);
    SC_LOAD(1, 1);
#pragma unroll
    for (int ls = 0; ls < SCH; ++ls) {
      if (ls + 2 < SCH) SC_LOAD(ls + 2, (ls + 2) % 3);
      const int sl = ls % 3;
      const f2_t vv = {V_[sl], V_[sl]};
      f2_t pp = __builtin_elementwise_fma(Sb, A1[sl], Sa * A0[sl]);
      float pa = pp.x + pp.y;
      const f2_t ta = __builtin_elementwise_fma(Sa, W0[sl], vv * K0[sl]);
      const f2_t tb = __builtin_elementwise_fma(Sb, W1[sl], vv * K1[sl]);
      pa = allreduce16(pa);
      const f2_t pv = {pa, pa};
      Sa = __builtin_elementwise_fma(pv, B0[sl], ta);
      Sb = __builtin_elementwise_fma(pv, B1[sl], tb);
      const f2_t yy = __builtin_elementwise_fma(Sb, R1[sl], Sa * R0[sl]);
      yb[ls * 256] = yy.x + yy.y;
    }
#undef SC_LOAD
#undef SC_LD2
  };
  HStage h0, h1;
  const bool helper = wave >= 4;
  if (helper) { issue(h0, 0); commit(h0, 0); issue(h1, 1); issue(h0, 2); }
  __syncthreads();
#pragma unroll 1
  for (int ci = 0; ci <= nchunk; ci += 2) {
    if (helper) {
      if (ci + 1 < nchunk) { commit(h1, 1); if (ci + 3 < nchunk) issue(h1, ci + 3); }
      if (ci >= 1) flush(ci - 1);
    } else if (ci < nchunk) process(0);
    __syncthreads();
    if (helper) {
      if (ci + 2 < nchunk) { commit(h0, 0); if (ci + 4 < nchunk) issue(h0, ci + 4); }
      if (ci < nchunk) flush(ci);
    } else if (ci + 1 < nchunk) process(1);
    __syncthreads();
  }
}

DI void phase_rwkv_out(const Params& p, int l, int nrows) {
  char* ws = p.ws;
  const int tid_ = otid(); const int lane = tid_ & 63, wave = tid_ >> 6;
  const float* Y0 = (const float*)(ws + OFF_Y); const float* Y1 = Y0 + (size_t)NT * 256;
  const bf16_t* SC = (const bf16_t*)(ws + OFF_SCANIN); const bf16_t* Gb = (const bf16_t*)(ws + OFF_G);
  bf16_t* OUTS = (bf16_t*)(ws + OFF_OUTS);
  const int c0 = 4 * lane;
  const float4 lw = *(const float4*)(p.rwkv_ln_w + l * 256 + c0), lb = *(const float4*)(p.rwkv_ln_b + l * 256 + c0);
  const float4 ka0 = *(const float4*)(p.rwkv_k_a + (l * 2 + 0) * 256 + c0), ka1 = *(const float4*)(p.rwkv_k_a + (l * 2 + 1) * 256 + c0);
  const float4 rk = *(const float4*)(p.rwkv_r_k + l * 256 + c0);
  const float lwv[4] = {lw.x, lw.y, lw.z, lw.w}, lbv[4] = {lb.x, lb.y, lb.z, lb.w};
  const float k0v[4] = {ka0.x, ka0.y, ka0.z, ka0.w}, k1v[4] = {ka1.x, ka1.y, ka1.z, ka1.w}, rkv[4] = {rk.x, rk.y, rk.z, rk.w};
  for (int row = obid() * 8 + wave; row < nrows; row += gridDim.x * 8) {
    const float4 ya = *(const float4*)(Y0 + (size_t)row * 256 + c0), yb = *(const float4*)(Y1 + (size_t)row * 256 + c0);
    const bf16_t* sc = SC + (size_t)row * 1792 + c0;
    const uint2 ur = *(const uint2*)(sc), uk = *(const uint2*)(sc + 256), uv = *(const uint2*)(sc + 512), ua0 = *(const uint2*)(sc + 5 * 256), ua1 = *(const uint2*)(sc + 6 * 256);
    const uint2 ug = *(const uint2*)(Gb + (size_t)row * 256 + c0);
    const float y[4] = {ya.x + yb.x, ya.y + yb.y, ya.z + yb.z, ya.w + yb.w};
    const float mean = allreduce16((y[0] + y[1]) + (y[2] + y[3])) * (1.f / 64.f);
    float d[4], var = 0.f;
#pragma unroll
    for (int e = 0; e < 4; ++e) { d[e] = y[e] - mean; var += d[e] * d[e]; }
    var = allreduce16(var) * (1.f / 64.f);
    const float rstd = frsqrt(var + 64e-5f);
#define U2F(U, E) (((E) & 1) ? __uint_as_float((((E) >> 1) ? (U).y : (U).x) & 0xffff0000u) : __uint_as_float((((E) >> 1) ? (U).y : (U).x) << 16))
    float bs = 0.f, r4[4], k4[4], v4[4], g4[4];
#pragma unroll
    for (int e = 0; e < 4; ++e) {
      r4[e] = U2F(ur, e); k4[e] = U2F(uk, e); v4[e] = U2F(uv, e); g4[e] = U2F(ug, e);
      const float a0 = U2F(ua0, e), a1 = U2F(ua1, e);
      const float kd0 = k4[e] * (1.f + (a0 - 1.f) * k0v[e]), kd1 = k4[e] * (1.f + (a1 - 1.f) * k1v[e]);
      bs += r4[e] * (kd0 + kd1) * rkv[e];
    }
#undef U2F
    bs = allreduce16(bs);
    float o[4];
#pragma unroll
    for (int e = 0; e < 4; ++e) o[e] = ((d[e] * rstd * lwv[e] + lbv[e]) + bs * v4[e]) * g4[e];
    st4bf(OUTS + (size_t)row * 1024 + 512 + c0, o[0], o[1], o[2], o[3]);
  }
}

#define XB_TMO      128
#define XB_XCNT(j)  (256  + 64 * (j))
#define XB_XSUB(j)  (1280 + 64 * (j))
#define XB_XGEN(j)  (2304 + 64 * (j))
#define XB_TOP      3328
#define XB_TOPGEN   3392
#define XCD_BAR_WORDS 3456
#define XB_SPIN_CAP (1u << 22)
#define LAS __attribute__((address_space(3)))
DI unsigned xb_ld(unsigned* p) { return __hip_atomic_load(p, __ATOMIC_RELAXED, __HIP_MEMORY_SCOPE_AGENT); }
DI unsigned xb_add(unsigned* p, unsigned v) { return __hip_atomic_fetch_add(p, v, __ATOMIC_RELAXED, __HIP_MEMORY_SCOPE_AGENT); }
DI unsigned xb_xcc_id() { return (unsigned)__builtin_amdgcn_s_getreg((3 << 11) | 20) & 0xFu; }
#define XB_SPIN(cond, bar) do { unsigned _sp = 0; while (cond) { __builtin_amdgcn_s_sleep(1); \
    if ((++_sp & 255u) == 0u) { if (xb_ld(&(bar)[XB_TMO])) break; if (_sp > XB_SPIN_CAP) { atomicAdd(&(bar)[XB_TMO], 1u); break; } } } } while (0)
struct XcdBarrier { unsigned* bar; unsigned x; volatile LAS unsigned* st; };
DI XcdBarrier xcd_barrier_post(unsigned* bar, volatile LAS unsigned* st) {
  XcdBarrier b; b.bar = bar; b.x = xb_xcc_id(); b.st = st;
  if (threadIdx.x == 0) (void)xb_add(&bar[XB_XCNT(b.x)], 1u);
  return b;
}
DI void xcd_barrier_complete(unsigned* bar, unsigned x, unsigned& nloc, unsigned& nx) {
  const unsigned G = gridDim.x * gridDim.y * gridDim.z;
  unsigned sum, cnt, mine, sp = 0u;
  for (;;) {
    sum = 0u; cnt = 0u; mine = 0u;
#pragma unroll
    for (unsigned j = 0; j < 16; ++j) { const unsigned c = xb_ld(&bar[XB_XCNT(j)]); sum += c; cnt += (c > 0u) ? 1u : 0u; mine = (j == x) ? c : mine; }
    if (sum == G) break;
    __builtin_amdgcn_s_sleep(1);
    if ((++sp & 255u) == 0u) { if (xb_ld(&bar[XB_TMO])) break; if (sp > XB_SPIN_CAP) { atomicAdd(&bar[XB_TMO], 1u); break; } }
  }
  nloc = mine > 0u ? mine : 1u; nx = cnt > 0u ? cnt : 1u;
}
DI void xcd_barrier(const XcdBarrier& b) {
  asm volatile("s_waitcnt vmcnt(0)" ::: "memory");
  __syncthreads();
  if (otid() == 0) {
    unsigned* bar = b.bar;
    __builtin_amdgcn_s_waitcnt(0);
    unsigned nloc = b.st[0], nx = b.st[1];
    if (nloc == 0u) { xcd_barrier_complete(bar, b.x, nloc, nx); b.st[0] = nloc; b.st[1] = nx; }
    const unsigned old = xb_add(&bar[XB_XSUB(b.x)], 1u);
    const unsigned gen = old / nloc;
    if (old + 1u == (gen + 1u) * nloc) {
      __builtin_amdgcn_fence(__ATOMIC_RELEASE, "agent");
      asm volatile("s_waitcnt vmcnt(0)" ::: "memory");
      const unsigned og = xb_add(&bar[XB_TOP], 1u);
      const unsigned tg = og / nx;
      if (og + 1u == (tg + 1u) * nx) xb_add(&bar[XB_TOPGEN], 1u);
      else XB_SPIN(xb_ld(&bar[XB_TOPGEN]) == tg, bar);
      __builtin_amdgcn_fence(__ATOMIC_ACQUIRE, "agent");
      xb_add(&bar[XB_XGEN(b.x)], 1u);
      asm volatile("s_waitcnt vmcnt(0)" ::: "memory");
    } else {
      XB_SPIN(xb_ld(&bar[XB_XGEN(b.x)]) == gen, bar);
      __builtin_amdgcn_fence(__ATOMIC_ACQUIRE, "agent");
      asm volatile("s_waitcnt vmcnt(0)" ::: "memory");
    }
  }
  __syncthreads();
}

typedef const uint64_t __attribute__((address_space(4))) cu64_t;
DI Params load_params(cu64_t*& ka) {
  asm volatile("" : "+s"(ka));
  Params p;
  const float** d = (const float**)&p;
#pragma unroll
  for (int i = 0; i < 32; ++i) d[i] = (const float*)(const float __attribute__((address_space(1)))*)ka[i];
  p.out = (float*)(float __attribute__((address_space(1)))*)ka[32];
  p.ws = (char*)(char __attribute__((address_space(1)))*)ka[33];
  return p;
}
#define LP() const Params p = load_params(ka)
__global__ void __launch_bounds__(THREADS) fwd_megakernel(Params p_unused) {
  extern __shared__ __attribute__((aligned(16))) char smem[];
  cg::grid_group grid = cg::this_grid();
  cu64_t* ka = (cu64_t*)__builtin_amdgcn_kernarg_segment_ptr();
  int* s_item = (int*)(smem + LDS_MAIN);
  if (threadIdx.x < 16) ((volatile LAS unsigned*)(smem + LDS_MAIN))[threadIdx.x] = 0u;
  __syncthreads();
  XcdBarrier xbar;
  { LP(); xbar = xcd_barrier_post((unsigned*)(p.ws + OFF_CTL), (volatile LAS unsigned*)(smem + LDS_MAIN + 16)); }
#define PH_BEGIN { LP(); char* ws = p.ws; (void)ws; float* mods = (float*)(ws + OFF_MODS); (void)mods; float* XC = (float*)(ws + OFF_XC); (void)XC; bf16_t* H = (bf16_t*)(ws + OFF_H); (void)H; int rot = 0; (void)rot;
#define XBAR() { LP(); xbar.bar = (unsigned*)(p.ws + OFF_CTL); xbar.x = xb_xcc_id(); xcd_barrier(xbar); }
#define PH_END } XBAR();
#define PH_END_CG } if (gridDim.x == 0x7fffffffu) grid.sync(); XBAR();

  PH_BEGIN
    phase_mods(p, smem);
    phase_convert(p, 0, smem);
  PH_END_CG
  PH_BEGIN
    phase_rows(p, NT, nullptr, p.x, p.ctx, nullptr, nullptr, nullptr, 0, nullptr, true, mods, 0, 1024, p.g_pre_mix, H);
  PH_END

  volatile int* s_layer = (volatile int*)(smem + LDS_MAIN + 48);
#pragma unroll 1
  for (;;) {
    const int l = __builtin_amdgcn_readfirstlane(*s_layer);
    if (l >= 2) break;
    const bool last = (l == 1);
    const int nrows = last ? NLAT : NT;
    PH_BEGIN
      pg8::PEpiWin e{(bf16_t*)(ws + OFF_ZA), (bf16_t*)(ws + OFF_ZB), (bf16_t*)(ws + OFF_ZC), (bf16_t*)(ws + OFF_ZD), (bf16_t*)(ws + OFF_VTA), (bf16_t*)(ws + OFF_VTD)};
      const int vcu = (gridDim.x % 8 == 0) ? (obid() % 8) * ((int)gridDim.x / 8) + obid() / 8 : obid();
      pg8::Gemm g{H, (const bf16_t*)(ws + OFF_WIN), NT, NWIN, 1024, 1024}; pg8::WinCOrder S{(int)gridDim.x, vcu};
      pg8::gemm_phase<pg8::PEpiWin, pg8::WinCOrder, true, true>((PG8_LAS unsigned char*)smem, g, S, e);
    PH_END
    PH_BEGIN
      prep_rows<false, true>(p, l, obid() * 8, NT, (int)gridDim.x * 8);
    PH_END
    PH_BEGIN
      gemm_small((const bf16_t*)(ws + OFF_TMPW), 64, (const bf16_t*)(ws + OFF_WW2), 64, NT / 256, 4, 64, rot, smem,
                 EpiWlora{(bf16_t*)(ws + OFF_SCANIN) + 3 * 256, p.rwkv_w0 + l * 512});
      gemm_small((const bf16_t*)(ws + OFF_TMPA), 64, (const bf16_t*)(ws + OFF_WA2), 64, NT / 256, 4, 64, rot, smem,
                 EpiAlora{(bf16_t*)(ws + OFF_SCANIN) + 5 * 256, p.rwkv_a0 + l * 512});
      gemm_small((const bf16_t*)(ws + OFF_TMPG), 192, (const bf16_t*)(ws + OFF_WG2), 192, NT / 256, 2, 192, rot, smem, EpiBf16{(bf16_t*)(ws + OFF_G), 256, false});
    PH_END
    PH_BEGIN
      for (int sb = obid(); sb < 64; sb += gridDim.x) scan_block(p, l, sb, smem);
      const int NWQ = 384, NPREP = 264, NPROJ = 462, NJOB = NWQ + NPREP + NPROJ;
      const int nitems = NJOB + (last ? 768 : 792);
      unsigned* counters = (unsigned*)(ws + OFF_CTL + 32768);
      bool win_ok = false;
      bool prep_ok = false;
      bool proj_ok = false;
#pragma unroll 1
      for (;;) {
        if (otid() == 0) {
          const int it = (int)atomicAdd(&counters[l * 64], 1u);
          if (it >= NWQ && it < nitems && !win_ok) {
            unsigned sp = 0;
            while (xb_ld(&counters[l * 64 + 48]) < (unsigned)NWQ) { __builtin_amdgcn_s_sleep(2); if (++sp > (1u << 24)) break; }
            __builtin_amdgcn_fence(__ATOMIC_ACQUIRE, "agent");
            asm volatile("s_waitcnt vmcnt(0)" ::: "memory");
            win_ok = true;
          }
          if (it >= NWQ + NPREP && it < nitems && !prep_ok) {
            unsigned sp = 0;
            while (xb_ld(&counters[l * 64 + 32]) < (unsigned)NPREP) { __builtin_amdgcn_s_sleep(2); if (++sp > (1u << 24)) break; }
            __builtin_amdgcn_fence(__ATOMIC_ACQUIRE, "agent");
            asm volatile("s_waitcnt vmcnt(0)" ::: "memory");
            prep_ok = true;
          }
          const int q0 = it - NJOB;
          const bool is_mla = (q0 >= 256 && q0 < 512) || (q0 >= 768 && q0 < 776);
          if (is_mla && it < nitems && !proj_ok) {
            unsigned sp = 0;
            while (xb_ld(&counters[l * 64 + 16]) < (unsigned)NPROJ) { __builtin_amdgcn_s_sleep(2); if (++sp > (1u << 24)) break; }
            __builtin_amdgcn_fence(__ATOMIC_ACQUIRE, "agent");
            asm volatile("s_waitcnt vmcnt(0)" ::: "memory");
            proj_ok = true;
          }
          *s_item = it;
        }
        __syncthreads();
        const int item = *s_item;
        __syncthreads();
        if (item >= nitems) break;
        if (item < NWQ) {
          const int mt = item / 6, k6 = item - 6 * mt;
          pg8::PEpiWin e{(bf16_t*)(ws + OFF_ZA), (bf16_t*)(ws + OFF_ZB), (bf16_t*)(ws + OFF_ZC), (bf16_t*)(ws + OFF_ZD), (bf16_t*)(ws + OFF_VTA), (bf16_t*)(ws + OFF_VTD)};
          pg8::Gemm g{H, (const bf16_t*)(ws + OFF_WIN), NT, NWIN, 1024, 1024};
          pg8::PieceOrder S{mt, k6 < 4 ? k6 : k6 + 5, true};
          pg8::gemm_phase<pg8::PEpiWin, pg8::PieceOrder, false, true>((PG8_LAS unsigned char*)smem, g, S, e);
          asm volatile("s_waitcnt vmcnt(0)" ::: "memory");
          __syncthreads();
          if (otid() == 0) {
            __builtin_amdgcn_fence(__ATOMIC_RELEASE, "agent");
            asm volatile("s_waitcnt vmcnt(0)" ::: "memory");
            (void)xb_add(&counters[l * 64 + 48], 1u);
          }
        } else if (item < NWQ + NPREP) {
          const int pjb = item - NWQ;
          prep_rows<true, false>(p, l, pjb * 64, pjb * 64 + 64, 8);
          asm volatile("s_waitcnt vmcnt(0)" ::: "memory");
          __syncthreads();
          if (otid() == 0) {
            __builtin_amdgcn_fence(__ATOMIC_RELEASE, "agent");
            asm volatile("s_waitcnt vmcnt(0)" ::: "memory");
            (void)xb_add(&counters[l * 64 + 32], 1u);
          }
        } else if (item < NJOB) {
          const bf16_t* ZB = (const bf16_t*)(ws + OFF_ZB);
          const int pj = item - NWQ - NPREP;
          const bool isq = pj < 198;
          const int j = isq ? pj : pj - 198;
          const int mt = isq ? j / 3 : j >> 2, nt = isq ? j - 3 * mt : j & 3;
          gemm_small_tile(isq ? ZB : ZB + 256, 512, (const bf16_t*)(ws + (isq ? OFF_WUQ : OFF_WUKV)), isq ? 256 : 128, mt, nt, isq ? 256 : 128, smem,
                          EpiUqkv{isq ? 0 : 1, (bf16_t*)(ws + OFF_BQ), (bf16_t*)(ws + OFF_BK), (bf16_t*)(ws + OFF_VTB)});
          asm volatile("s_waitcnt vmcnt(0)" ::: "memory");
          __syncthreads();
          if (otid() == 0) {
            __builtin_amdgcn_fence(__ATOMIC_RELEASE, "agent");
            asm volatile("s_waitcnt vmcnt(0)" ::: "memory");
            (void)xb_add(&counters[l * 64 + 16], 1u);
          }
        } else {
          const int q = item - NJOB;
          int kind, b, hq, qt; bool isctx = false;
          if (q < 768) { const int k3 = q >> 8; kind = (k3 == 0) ? 1 : (k3 == 1 ? 0 : 2); const int j = q & 255; b = j >> 7; hq = (j >> 5) & 3; qt = j & 31; }
          else { const int j = q - 768; kind = j >> 3; b = (j >> 2) & 1; hq = j & 3; qt = 0; isctx = true; }
          run_attn_item(p, l, kind, b, hq, qt, isctx, smem);
        }
      }
    PH_END
    PH_BEGIN
      phase_rwkv_out(p, l, nrows);
    PH_END
    PH_BEGIN
      {
        pg8::PEpiBf16 e{(bf16_t*)(ws + OFF_YMIX), 1024, false};
        pg8::Gemm g{(const bf16_t*)(ws + OFF_OUTS), (const bf16_t*)(ws + OFF_WOUT), NLAT, 1024, 1024, 1024}; pg8::StaticOrder S; S.init(NLAT, 1024, (int)gridDim.x, obid());
        pg8::gemm_phase<pg8::PEpiBf16, pg8::StaticOrder, true, true>((PG8_LAS unsigned char*)smem, g, S, e);
      }
      if (!last) {
        const int idx = obid(), u = idx >> 2, ks = idx & 3;
        pg8::PieceOrder S{64 + (u >> 2), u & 3, idx < 32};
        pg8::PEpiF32 e{(float*)(ws + OFF_SLAB1) + (size_t)ks * NCTX * 1024 - (size_t)NLAT * 1024, 1024};
        pg8::Gemm g{(const bf16_t*)(ws + OFF_OUTS) + ks * 256, (const bf16_t*)(ws + OFF_WOUT) + ks * 256, NT, 1024, 256, 1024};
        pg8::gemm_phase<pg8::PEpiF32, pg8::PieceOrder, false, true>((PG8_LAS unsigned char*)smem, g, S, e);
      }
    PH_END
    PH_BEGIN
      const float* modl = mods + (size_t)l * 3 * 6144;
      phase_rows(p, nrows, (const bf16_t*)(ws + OFF_YMIX), l == 0 ? p.x : p.out, l == 0 ? p.ctx : XC, p.out, XC, modl, 2048, p.g_post_mix + l * 1024, true,
                 modl, 3072, 4096, p.g_pre_mlp + l * 1024, (bf16_t*)(ws + OFF_H2), (const float*)(ws + OFF_SLAB1), last ? 0 : 4);
    PH_END
    PH_BEGIN
      pg8::PEpiBf16 e{(bf16_t*)(ws + OFF_U), 4096, true};
      pg8::Gemm g{(const bf16_t*)(ws + OFF_H2), (const bf16_t*)(ws + OFF_W1), nrows, 4096, 1024, 1024}; pg8::StaticOrder S; S.init(nrows, 4096, (int)gridDim.x, obid());
      pg8::gemm_phase<pg8::PEpiBf16, pg8::StaticOrder, true, true>((PG8_LAS unsigned char*)smem, g, S, e);
    PH_END
    PH_BEGIN
      {
        pg8::PEpiBf16 e{(bf16_t*)(ws + OFF_Y2), 1024, false};
        pg8::Gemm g{(const bf16_t*)(ws + OFF_U), (const bf16_t*)(ws + OFF_W2), NLAT, 1024, 4096, 4096}; pg8::StaticOrder S; S.init(NLAT, 1024, (int)gridDim.x, obid());
        pg8::gemm_phase<pg8::PEpiBf16, pg8::StaticOrder, true, true>((PG8_LAS unsigned char*)smem, g, S, e);
      }
      if (!last) {
        const int idx = obid(), u = idx >> 3, ks = idx & 7;
        pg8::PieceOrder S{64 + (u >> 2), u & 3, idx < 64};
        pg8::PEpiF32 e{(float*)(ws + OFF_SLAB2) + (size_t)ks * NCTX * 1024 - (size_t)NLAT * 1024, 1024};
        pg8::Gemm g{(const bf16_t*)(ws + OFF_U) + ks * 512, (const bf16_t*)(ws + OFF_W2) + ks * 512, NT, 1024, 512, 4096};
        pg8::gemm_phase<pg8::PEpiF32, pg8::PieceOrder, false, true>((PG8_LAS unsigned char*)smem, g, S, e);
      }
    PH_END
    PH_BEGIN
      if (!last) phase_convert(p, l + 1, smem);
      const float* modl = mods + (size_t)l * 3 * 6144;
      phase_rows(p, nrows, (const bf16_t*)(ws + OFF_Y2), p.out, XC, p.out, XC, modl, 5120, p.g_post_mlp + l * 1024, !last,
                 mods + (size_t)(l + 1) * 3 * 6144, 0, 1024, p.g_pre_mix + (last ? 0 : (l + 1) * 1024), H, (const float*)(ws + OFF_SLAB2), last ? 0 : 8);
    }
    if (last) break;
    XBAR();
    if (otid() == 0) *s_layer = l + 1;
    __syncthreads();
  }
}

extern "C" void kernel_launch(void* const* d_in, const int* in_sizes, int n_in, void* d_out, int out_size, void* d_ws, size_t ws_size,
                              hipStream_t stream) {
  static int grid_blocks = 0;
  if (grid_blocks == 0) {
    if (n_in != 32 || ws_size < WS_NEED) { fprintf(stderr, "kernel_launch: unexpected n_in %d / ws_size %zu\n", n_in, ws_size); grid_blocks = -1; return; }
    int dev = 0, cus = 0, per_cu = 0;
    hipGetDevice(&dev);
    hipDeviceGetAttribute(&cus, hipDeviceAttributeMultiprocessorCount, dev);
    hipFuncSetAttribute((const void*)fwd_megakernel, hipFuncAttributeMaxDynamicSharedMemorySize, LDS_BYTES);
    hipOccupancyMaxActiveBlocksPerMultiprocessor(&per_cu, (const void*)fwd_megakernel, THREADS, LDS_BYTES);
    if (per_cu < 1) { fprintf(stderr, "kernel_launch: occupancy query says %d blocks per CU\n", per_cu); grid_blocks = -1; return; }
    grid_blocks = cus;
  }
  if (grid_blocks < 0) return;
  hipMemsetAsync((char*)d_ws + OFF_CTL, 0, 65536, stream);
  Params p{};
  const float** pp = (const float**)&p;
  for (int i = 0; i < 32; ++i) pp[i] = (const float*)d_in[i];
  p.out = (float*)d_out;
  p.ws = (char*)d_ws;
  void* args[] = {&p};
  hipError_t e = hipLaunchCooperativeKernel((const void*)fwd_megakernel, dim3(grid_blocks), dim3(THREADS), args, LDS_BYTES, stream);
  if (e != hipSuccess) fprintf(stderr, "cooperative launch failed: %s (grid %d)\n", hipGetErrorString(e), grid_blocks);
}
```

```cpp
#include <hip/hip_runtime.h>
#include <hip/hip_cooperative_groups.h>
#include <cstdio>
#include <cstdint>
namespace cg = cooperative_groups;

typedef unsigned short bf16_t;
using bf16x8 = __attribute__((ext_vector_type(8))) short;
using f32x16 = __attribute__((ext_vector_type(16))) float;
#define DI __device__ __forceinline__
#define MFMA32(a, b, c) __builtin_amdgcn_mfma_f32_32x32x16_bf16((a), (b), (c), 0, 0, 0)

constexpr int D_ = 1024, T_ = 8192, NLAT = 16384, NCTX = 512, NT = 16896, CTXL = 256;
constexpr int NWIN = 2816;
constexpr int IN_COLS = 2496, C_COLS = 1056, DFF = 4096;
constexpr int KEYS = 8448;
constexpr float EPS = 1e-6f, LOG2E = 1.4426950408889634f;
constexpr int THREADS = 512;
constexpr int LDS_MAIN = 151552;
constexpr int LDS_BYTES = LDS_MAIN + 64;

constexpr size_t MiB = 1048576;
constexpr size_t OFF_CTL = 0;
constexpr size_t OFF_MODS = 65536;
constexpr size_t OFF_INVN = 262144;
constexpr size_t OFF_XC = 1 * MiB;
constexpr size_t OFF_W = 3 * MiB;
constexpr size_t OFF_WIN = OFF_W;
constexpr size_t OFF_WOUT = OFF_WIN + (size_t)NWIN * 1024 * 2;
constexpr size_t OFF_W1 = OFF_WOUT + (size_t)1024 * 1024 * 2;
constexpr size_t OFF_W2 = OFF_W1 + (size_t)4096 * 1024 * 2;
constexpr size_t OFF_WUQ = OFF_W2 + (size_t)4096 * 1024 * 2;
constexpr size_t OFF_WUKV = OFF_WUQ + 384 * 256 * 2;
constexpr size_t OFF_WW2 = OFF_WUKV + 512 * 128 * 2;
constexpr size_t OFF_WA2 = OFF_WW2 + 2 * 256 * 64 * 2;
constexpr size_t OFF_WG2 = OFF_WA2 + 2 * 256 * 64 * 2;
constexpr size_t OFF_R = 27 * MiB + MiB / 8;
constexpr size_t EIGHTH = MiB / 8;
constexpr size_t OFF_H = OFF_R;
constexpr size_t OFF_BQ = OFF_R;
constexpr size_t OFF_BK = OFF_R + 99 * EIGHTH;
constexpr size_t OFF_VTB = OFF_R + 198 * EIGHTH;
constexpr size_t OFF_ZA = OFF_R + 33 * MiB;
constexpr size_t OFF_ZD = OFF_ZA + 132 * EIGHTH;
constexpr size_t OFF_ZB = OFF_ZD + 132 * EIGHTH;
constexpr size_t OFF_ZC = OFF_ZB + 132 * EIGHTH;
constexpr size_t OFF_OUTS = OFF_ZC;
constexpr size_t OFF_SCANIN = OFF_ZC + 297 * EIGHTH;
constexpr size_t OFF_G = OFF_SCANIN + 462 * EIGHTH;
constexpr size_t OFF_Y = OFF_G + 66 * EIGHTH;
constexpr size_t OFF_TMPW = OFF_Y;
constexpr size_t OFF_TMPA = OFF_TMPW + (size_t)NT * 64 * 2;
constexpr size_t OFF_TMPG = OFF_TMPA + (size_t)NT * 64 * 2;
constexpr size_t OFF_VTA = OFF_Y + 33 * MiB;
constexpr size_t OFF_VTD = OFF_VTA + 33 * EIGHTH;
constexpr size_t OFF_YMIX = OFF_R;
constexpr size_t OFF_H2 = 223 * MiB;
constexpr size_t OFF_U = OFF_R;
constexpr size_t OFF_Y2 = OFF_R + 132 * MiB;
constexpr size_t OFF_SLAB1 = OFF_ZB;
constexpr size_t OFF_SLAB2 = 226 * MiB;
constexpr size_t WS_NEED = 256 * MiB;
static_assert(OFF_VTD + 33 * EIGHTH <= 256 * MiB, "ws");
static_assert(OFF_Y2 + (size_t)NT * 1024 * 4 <= 256 * MiB && OFF_H2 + (size_t)NT * 1024 * 2 <= 256 * MiB, "ws2");
static_assert(OFF_WG2 + 256 * 192 * 2 <= OFF_R, "ws w");

struct Params {
  const float *x, *c, *ctx, *c_ctx, *w_mod, *b_mod, *g_pre_mix, *g_post_mix, *g_pre_mlp, *g_post_mlp, *w_in,
      *gqa_q_norm, *gqa_k_norm, *mla_q_norm, *mla_kv_norm, *mla_w_uq, *mla_w_ukv, *rwkv_mu, *rwkv_w0, *rwkv_w2,
      *rwkv_a0, *rwkv_a2, *rwkv_k_k, *rwkv_k_a, *rwkv_r_k, *rwkv_g2, *rwkv_ln_w, *rwkv_ln_b, *swa_sink, *w_out,
      *w_mlp1, *w_mlp2;
  float* out;
  char* ws;
};

DI int obid() { int b = blockIdx.x; asm volatile("" : "+s"(b)); return b; }
DI int otid() { int t = threadIdx.x; asm volatile("" : "+v"(t)); return t; }
DI float bf2f(bf16_t b) { return __uint_as_float(((unsigned)b) << 16); }
typedef __bf16 bf2v_t __attribute__((ext_vector_type(2)));
typedef float f2v_t __attribute__((ext_vector_type(2)));
DI unsigned pack2(float a, float b) { f2v_t f = {a, b}; bf2v_t r = __builtin_convertvector(f, bf2v_t); return __builtin_bit_cast(unsigned, r); }
DI bf16_t f2bf(float x) { return (bf16_t)(pack2(x, 0.f) & 0xffffu); }
DI void st4bf(bf16_t* p, float a, float b, float c, float d) { uint2 v; v.x = pack2(a, b); v.y = pack2(c, d); *(uint2*)p = v; }
DI float wave_sum_slow(float v) {
#pragma unroll
  for (int o = 32; o > 0; o >>= 1) v += __shfl_xor(v, o);
  return v;
}
DI float fexp2(float x) { return __builtin_amdgcn_exp2f(x); }
DI float fexp(float x) { return __builtin_amdgcn_exp2f(x * LOG2E); }
DI float frcp(float x) { return __builtin_amdgcn_rcpf(x); }
DI float sigmoidf_(float x) { return frcp(1.f + fexp(-x)); }
DI float frsqrt(float x) { return __builtin_amdgcn_rsqf(x); }
DI int key_of_row(int m) { return m < NLAT ? (m & (T_ - 1)) : T_ + ((m - NLAT) & (CTXL - 1)); }
DI int batch_of_row(int m) { return m < NLAT ? (m >> 13) : ((m - NLAT) >> 8); }
DI int mods_slot(int m) { return m < NLAT ? (m >> 13) : 2; }
template <int CTRL> DI float dpp_mov(float v) {
  return __builtin_bit_cast(float, __builtin_amdgcn_update_dpp(0, __builtin_bit_cast(int, v), CTRL, 0xf, 0xf, false));
}
DI float allreduce16(float v) {
  v += dpp_mov<0x128>(v);
  v += dpp_mov<0x124>(v);
  v += dpp_mov<0x122>(v);
  v += dpp_mov<0x121>(v);
  return v;
}
DI float wave_sum(float v) {
  v = allreduce16(v);
  { const auto sw = __builtin_amdgcn_permlane32_swap(__float_as_uint(v), __float_as_uint(v), false, false); v = __uint_as_float(sw[0]) + __uint_as_float(sw[1]); }
  v += __shfl_xor(v, 16);
  return v;
}

DI void phase_mods(const Params& p, char* smem) {
  float* s_silu = (float*)smem;
  float* s_red = s_silu + 3 * 1024;
  const int tid = otid(), lane = tid & 63, wave = tid >> 6;
  for (int i = tid; i < 3 * 1024; i += THREADS) {
    int sI = i >> 10, k = i & 1023;
    float v = (sI < 2) ? p.c[sI * 1024 + k] : p.c_ctx[k];
    s_silu[i] = v * sigmoidf_(v);
  }
  __syncthreads();
  float* mods = (float*)(p.ws + OFF_MODS);
  for (int item = obid(); item < 192; item += gridDim.x) {
    const int l = item / 96, n0 = (item % 96) * 64;
    float a0 = 0.f, a1 = 0.f, a2 = 0.f;
    const float* w = p.w_mod + (size_t)l * 1024 * 6144 + (size_t)(wave * 128) * 6144 + n0 + lane;
#pragma unroll 16
    for (int kk = 0; kk < 128; ++kk) {
      const int k = wave * 128 + kk;
      const float wv = w[(size_t)kk * 6144];
      a0 += s_silu[k] * wv; a1 += s_silu[1024 + k] * wv; a2 += s_silu[2048 + k] * wv;
    }
    s_red[(wave * 3 + 0) * 64 + lane] = a0; s_red[(wave * 3 + 1) * 64 + lane] = a1; s_red[(wave * 3 + 2) * 64 + lane] = a2;
    __syncthreads();
    if (tid < 192) {
      const int sI = tid >> 6, j = tid & 63;
      float acc = p.b_mod[l * 6144 + n0 + j];
#pragma unroll
      for (int w8 = 0; w8 < 8; ++w8) acc += s_red[(w8 * 3 + sI) * 64 + j];
      mods[(size_t)(l * 3 + sI) * 6144 + n0 + j] = acc;
    }
    __syncthreads();
  }
}

struct RowMapId { DI int operator()(int n) const { return n; } };
struct RowMapWin { DI int operator()(int n) const { return n < 512 ? n : (n < 928 ? n : (n < 1984 ? n + 96 : n + 320)); } };
template <class RM>
DI void conv_T(const float* __restrict__ src, int K, int N, bf16_t* __restrict__ dst, int ldd, int Kpad, RM rm, int& rot, char* smem) {
  float* tile = (float*)smem;
  const int tid = otid(), G = gridDim.x;
  const int kt_n = Kpad >> 6, nt_n = N >> 6, total = kt_n * nt_n;
  int first = (int)((obid() + G - (rot % G)) % G);
  const int lk = tid >> 4, ln4 = (tid & 15) * 4;
  const int sn = tid >> 3, sk8 = (tid & 7) * 8;
  for (int t = first; t < total; t += G) {
    const int k0 = (t / nt_n) << 6, n0 = (t % nt_n) << 6;
    float4 v0 = make_float4(0.f, 0.f, 0.f, 0.f), v1 = make_float4(0.f, 0.f, 0.f, 0.f);
    if (k0 + lk < K) v0 = *(const float4*)(src + (size_t)(k0 + lk) * N + n0 + ln4);
    if (k0 + lk + 32 < K) v1 = *(const float4*)(src + (size_t)(k0 + lk + 32) * N + n0 + ln4);
    *(float4*)(tile + lk * 68 + ln4) = v0;
    *(float4*)(tile + (lk + 32) * 68 + ln4) = v1;
    __syncthreads();
    float f[8];
#pragma unroll
    for (int e = 0; e < 8; ++e) f[e] = tile[(sk8 + e) * 68 + sn];
    *(uint4*)(dst + (size_t)rm(n0 + sn) * ldd + k0 + sk8) = make_uint4(pack2(f[0], f[1]), pack2(f[2], f[3]), pack2(f[4], f[5]), pack2(f[6], f[7]));
    __syncthreads();
  }
  rot += total;
}
DI void phase_convert(const Params& p, int l, char* smem) {
  char* ws = p.ws;
  int rot = 0;
  conv_T(p.w_in + (size_t)l * 1024 * IN_COLS, 1024, IN_COLS, (bf16_t*)(ws + OFF_WIN), 1024, 1024, RowMapWin(), rot, smem);
  conv_T(p.w_out + (size_t)l * 1024 * 1024, 1024, 1024, (bf16_t*)(ws + OFF_WOUT), 1024, 1024, RowMapId(), rot, smem);
  conv_T(p.w_mlp1 + (size_t)l * 1024 * 4096, 1024, 4096, (bf16_t*)(ws + OFF_W1), 1024, 1024, RowMapId(), rot, smem);
  conv_T(p.w_mlp2 + (size_t)l * 4096 * 1024, 4096, 1024, (bf16_t*)(ws + OFF_W2), 4096, 4096, RowMapId(), rot, smem);
  conv_T(p.mla_w_uq + (size_t)l * 256 * 384, 256, 384, (bf16_t*)(ws + OFF_WUQ), 256, 256, RowMapId(), rot, smem);
  conv_T(p.mla_w_ukv + (size_t)l * 128 * 512, 128, 512, (bf16_t*)(ws + OFF_WUKV), 128, 128, RowMapId(), rot, smem);
  for (int d = 0; d < 2; ++d) {
    conv_T(p.rwkv_w2 + (size_t)(l * 2 + d) * 64 * 256, 64, 256, (bf16_t*)(ws + OFF_WW2) + d * 256 * 64, 64, 64, RowMapId(), rot, smem);
    conv_T(p.rwkv_a2 + (size_t)(l * 2 + d) * 64 * 256, 64, 256, (bf16_t*)(ws + OFF_WA2) + d * 256 * 64, 64, 64, RowMapId(), rot, smem);
  }
  conv_T(p.rwkv_g2 + (size_t)l * 160 * 256, 160, 256, (bf16_t*)(ws + OFF_WG2), 192, 192, RowMapId(), rot, smem);
}

DI void phase_rows(const Params& p, int nrows, const bf16_t* __restrict__ y, const float* xl_src, const float* xc_src,
                   float* xl_dst, float* xc_dst, const float* mods_y, int gt_off, const float* __restrict__ gpost, bool do_h,
                   const float* mods_h, int sh_off, int sc_off, const float* __restrict__ gpre, bf16_t* hdst, const float* yslab = nullptr, int nslab = 0) {
  const int tid_ = otid(); const int lane = tid_ & 63, wave = tid_ >> 6;
  float4 gpo[4], gpr[4], gtv[4], scv[4], shv[4];
#pragma unroll
  for (int i = 0; i < 4; ++i) {
    const int c = i * 256 + lane * 4;
    gpo[i] = y ? *(const float4*)(gpost + c) : make_float4(0.f, 0.f, 0.f, 0.f);
    gpr[i] = do_h ? *(const float4*)(gpre + c) : make_float4(0.f, 0.f, 0.f, 0.f);
    gtv[i] = scv[i] = shv[i] = make_float4(0.f, 0.f, 0.f, 0.f);
  }
  int cur_slot = -1;
  for (int row = obid() * 8 + wave; row < nrows; row += gridDim.x * 8) {
    const int slot = mods_slot(row);
    const float* xs = row < NLAT ? xl_src + (size_t)row * 1024 : xc_src + (size_t)(row - NLAT) * 1024;
    float4 xv[4];
#pragma unroll
    for (int i = 0; i < 4; ++i) { typedef float f4v_t __attribute__((ext_vector_type(4))); const f4v_t t_ = __builtin_nontemporal_load((const f4v_t*)(xs + i * 256 + lane * 4)); xv[i] = make_float4(t_.x, t_.y, t_.z, t_.w); }
    if (slot != cur_slot) {
      cur_slot = slot;
#pragma unroll
      for (int i = 0; i < 4; ++i) {
        const int c = i * 256 + lane * 4;
        if (y) gtv[i] = *(const float4*)(mods_y + (size_t)slot * 6144 + gt_off + c);
        if (do_h) { scv[i] = *(const float4*)(mods_h + (size_t)slot * 6144 + sc_off + c); shv[i] = *(const float4*)(mods_h + (size_t)slot * 6144 + sh_off + c); }
      }
    }
    if (y) {
      float4 yv[4];
      float ss = 0.f;
#pragma unroll
      for (int i = 0; i < 4; ++i) {
        if (nslab > 0 && row >= NLAT) {
          float4 a = make_float4(0.f, 0.f, 0.f, 0.f);
          for (int sidx = 0; sidx < nslab; ++sidx) {
            const float4 t4 = *(const float4*)(yslab + ((size_t)sidx * NCTX + (row - NLAT)) * 1024 + i * 256 + lane * 4);
            a.x += t4.x; a.y += t4.y; a.z += t4.z; a.w += t4.w;
          }
          yv[i] = a;
        } else
        { const uint2 u_ = *(const uint2*)(y + (size_t)row * 1024 + i * 256 + lane * 4);
          yv[i] = make_float4(__uint_as_float(u_.x << 16), __uint_as_float(u_.x & 0xffff0000u), __uint_as_float(u_.y << 16), __uint_as_float(u_.y & 0xffff0000u)); }
        ss += yv[i].x * yv[i].x + yv[i].y * yv[i].y + yv[i].z * yv[i].z + yv[i].w * yv[i].w;
      }
      ss = wave_sum(ss);
      const float rs = frsqrt(ss * (1.f / 1024.f) + EPS);
      float* xd = row < NLAT ? xl_dst + (size_t)row * 1024 : xc_dst + (size_t)(row - NLAT) * 1024;
#pragma unroll
      for (int i = 0; i < 4; ++i) {
        const int c = i * 256 + lane * 4;
        const float4 g = gpo[i], t = gtv[i];
        xv[i].x += t.x * (yv[i].x * rs * g.x); xv[i].y += t.y * (yv[i].y * rs * g.y);
        xv[i].z += t.z * (yv[i].z * rs * g.z); xv[i].w += t.w * (yv[i].w * rs * g.w);
        { typedef float f4v_t __attribute__((ext_vector_type(4))); const f4v_t t_ = {xv[i].x, xv[i].y, xv[i].z, xv[i].w}; __builtin_nontemporal_store(t_, (f4v_t*)(xd + c)); }
      }
    }
    if (do_h) {
      float ss = 0.f;
#pragma unroll
      for (int i = 0; i < 4; ++i) ss += xv[i].x * xv[i].x + xv[i].y * xv[i].y + xv[i].z * xv[i].z + xv[i].w * xv[i].w;
      ss = wave_sum(ss);
      const float rs = frsqrt(ss * (1.f / 1024.f) + EPS);
#pragma unroll
      for (int i = 0; i < 4; ++i) {
        const int c = i * 256 + lane * 4;
        const float4 g = gpr[i], a = scv[i], b = shv[i];
        st4bf(hdst + (size_t)row * 1024 + c, xv[i].x * rs * g.x * (1.f + a.x) + b.x, xv[i].y * rs * g.y * (1.f + a.y) + b.y,
              xv[i].z * rs * g.z * (1.f + a.z) + b.z, xv[i].w * rs * g.w * (1.f + a.w) + b.w);
      }
    }
  }
}

namespace pg8 {
#define PG8_LAS __attribute__((address_space(3)))
typedef unsigned short bf16_t;
typedef short bf16x8 __attribute__((ext_vector_type(8)));
typedef float f32x4 __attribute__((ext_vector_type(4)));
typedef unsigned u32x4 __attribute__((ext_vector_type(4)));
constexpr int BM = 256, BK = 64, HALF = 128, HTB = HALF * BK * 2  , STAGE_BYTES = 8 * HTB, NXCD = 8, WGM = 8;

__host__ __device__ __forceinline__ int lds_byte(int r, int c) { const int st = (r >> 4) * 2 + (c >> 5), rr = r & 15, cc = c & 31, ob = rr * 64 + cc * 2; return st * 1024 + (ob ^ (((ob >> 9) & 1) << 5)); }
__host__ __device__ __forceinline__ void stage_rc(int b, int& R, int& C) { const int st = b / 1024, sb = b % 1024, swz = sb ^ (((sb >> 9) & 1) << 5); R = (st >> 1) * 16 + swz / 64; C = (st & 1) * 32 + (swz % 64) / 2; }
__host__ __device__ __forceinline__ int perm32(int rho) { const int n = rho >> 4, i = rho & 15; return 8 * (i >> 2) + 4 * n + (i & 3); }

struct Unit { int pm, pn; };
struct Gemm { const bf16_t* A; const bf16_t* Bt; int M, N, K, ld; };

struct StaticOrder {
    int nM, nN, nwg, G, c;
    __host__ __device__ void init(int M, int N, int G_, int c_) { nM = M / BM; nN = N / BM; nwg = nM * nN; G = G_; c = c_; }
    __host__ __device__ bool next(int i, Unit& u) const {
        const long L = (long)i * G + c; if (L >= nwg) return false;
        int wgid = (int)L; { const int q = nwg / NXCD, r = nwg % NXCD, xcd = wgid % NXCD, off = wgid / NXCD; wgid = (xcd < r ? xcd * (q + 1) : r * (q + 1) + (xcd - r) * q) + off; }
        const int nig = WGM * nN, gid = wgid / nig, fm = gid * WGM, gsz = (nM - fm) < WGM ? (nM - fm) : WGM;
        u.pm = fm + ((wgid % nig) % gsz); u.pn = (wgid % nig) / gsz; return true;
    }
    __device__ __forceinline__ void a_ready(const Unit&) const {}
    __device__ __forceinline__ void done(const Unit&) const {}
};

struct PEpiBf16 {
    static constexpr bool PERM = true, AFTER_DRAIN = false;
    bf16_t* O; int ldc; bool sqrelu;
    __device__ __forceinline__ void operator()(const f32x4 (&acc)[2][2][4][2], const Unit& u, int wr, int wc, int fr, int fq) const {
        const int row0 = u.pm * BM + wr * 64 + fr, col0 = u.pn * BM + wc * 32 + 8 * fq;
#pragma unroll
        for (int ai = 0; ai < 2; ++ai)
#pragma unroll
            for (int m = 0; m < 4; ++m) { bf16_t* rowp = O + (size_t)(row0 + ai * HALF + m * 16) * ldc + col0;
#pragma unroll
                for (int bj = 0; bj < 2; ++bj) { f32x4 v0 = acc[ai][bj][m][0], v1 = acc[ai][bj][m][1];
                    if (sqrelu) { v0 = __builtin_elementwise_max(v0, (f32x4){0.f, 0.f, 0.f, 0.f}); v1 = __builtin_elementwise_max(v1, (f32x4){0.f, 0.f, 0.f, 0.f}); v0 = v0 * v0; v1 = v1 * v1; }
                    u32x4 w; w.x = ::pack2(v0[0], v0[1]); w.y = ::pack2(v0[2], v0[3]); w.z = ::pack2(v1[0], v1[1]); w.w = ::pack2(v1[2], v1[3]);
                    *(u32x4*)(rowp + bj * HALF) = w; } }
    }
};
struct PieceOrder {
    int pm, pn; bool have;
    __device__ __forceinline__ bool next(int i, Unit& u) const { if (i != 0 || !have) return false; u.pm = pm; u.pn = pn; return true; }
    __device__ __forceinline__ void a_ready(const Unit&) const {}
    __device__ __forceinline__ void done(const Unit&) const {}
};
struct WinCOrder {
    int G, c;
    __device__ __forceinline__ bool next(int i, Unit& u) const {
        const long L = (long)i * G + c; if (L >= 342) return false;
        if (L < 330) { u.pm = (int)(L / 5); u.pn = 4 + (int)(L % 5); }
        else { const int j = (int)L - 330, k6 = j % 6; u.pm = 64 + j / 6; u.pn = k6 < 4 ? k6 : k6 + 5; }
        return true; }
    __device__ __forceinline__ void a_ready(const Unit&) const {}
    __device__ __forceinline__ void done(const Unit&) const {}
};
struct PEpiF32 {
    static constexpr bool PERM = true, AFTER_DRAIN = false;
    float* O; int ldc;
    __device__ __forceinline__ void operator()(const f32x4 (&acc)[2][2][4][2], const Unit& u, int wr, int wc, int fr, int fq) const {
        const int row0 = u.pm * BM + wr * 64 + fr, col0 = u.pn * BM + wc * 32 + 8 * fq;
#pragma unroll
        for (int ai = 0; ai < 2; ++ai)
#pragma unroll
            for (int m = 0; m < 4; ++m) { float* rowp = O + (size_t)(row0 + ai * HALF + m * 16) * ldc + col0;
#pragma unroll
                for (int bj = 0; bj < 2; ++bj) { *(f32x4*)(rowp + bj * HALF) = acc[ai][bj][m][0]; *(f32x4*)(rowp + bj * HALF + 4) = acc[ai][bj][m][1]; } }
    }
};
struct PEpiWin {
    static constexpr bool PERM = true, AFTER_DRAIN = false;
    bf16_t *za, *zb, *zc, *zd, *vta, *vtd;
    __device__ __forceinline__ void operator()(const f32x4 (&acc)[2][2][4][2], const Unit& u, int wr, int wc, int fr, int fq) const {
        const int row0 = u.pm * BM + wr * 64 + fr;
#pragma unroll
        for (int bj = 0; bj < 2; ++bj) {
            const int pc = u.pn * BM + bj * HALF + wc * 32 + 8 * fq;
            bf16_t* dst; int col, ld; bf16_t* vt = nullptr; bool ok = true;
            if (pc < 512) { col = pc; dst = za; ld = 512; if (col >= 384) vt = vta; }
            else if (pc < 1024) { col = pc - 512; dst = zb; ld = 512; }
            else if (pc < 2304) { col = pc - 1024; dst = zc; ld = 1152; ok = col < 1152; }
            else { col = pc - 2304; dst = zd; ld = 512; if (col >= 384) vt = vtd; }
#pragma unroll
            for (int ai = 0; ai < 2; ++ai)
#pragma unroll
                for (int m = 0; m < 4; ++m) {
                    const int r = row0 + ai * HALF + m * 16;
                    const f32x4 v0 = acc[ai][bj][m][0], v1 = acc[ai][bj][m][1];
                    if (vt) {
                        bf16_t* base = vt + ((size_t)::batch_of_row(r) * 128 + (col - 384)) * KEYS + ::key_of_row(r);
                        base[0] = ::f2bf(v0[0]); base[(size_t)KEYS] = ::f2bf(v0[1]); base[(size_t)2 * KEYS] = ::f2bf(v0[2]); base[(size_t)3 * KEYS] = ::f2bf(v0[3]);
                        base[(size_t)4 * KEYS] = ::f2bf(v1[0]); base[(size_t)5 * KEYS] = ::f2bf(v1[1]); base[(size_t)6 * KEYS] = ::f2bf(v1[2]); base[(size_t)7 * KEYS] = ::f2bf(v1[3]);
                    } else if (ok) {
                        u32x4 w; w.x = ::pack2(v0[0], v0[1]); w.y = ::pack2(v0[2], v0[3]); w.z = ::pack2(v1[0], v1[1]); w.w = ::pack2(v1[2], v1[3]);
                        *(u32x4*)(dst + (size_t)r * ld + col) = w;
                    }
                }
        }
    }
};

template <class Epi, class Sched, bool ALIGN_EPI = false, bool SP2 = false>
__device__ __forceinline__ void gemm_phase(PG8_LAS unsigned char* lds, const Gemm g, const Sched& S, const Epi& E) {
    const int tid = otid(), wid = __builtin_amdgcn_readfirstlane(tid >> 6), lane = tid & 63, wr = wid >> 2, wc = wid & 3, fr = lane & 15, fq = lane >> 4;
    const int K = g.ld, nt = g.K / BK;
    unsigned voffA[2], voffB[2];
#pragma unroll
    for (int i = 0; i < 2; ++i) { int R, C; stage_rc(tid * 16 + i * 8192, R, C); const int Rb = Epi::PERM ? ((R & ~31) + perm32(R & 31)) : R;
        voffA[i] = (unsigned)(R * K + C) * 2u; voffB[i] = (unsigned)(Rb * K + C) * 2u; }
    const size_t kstep = (size_t)(BK * 2);
    const size_t hstep = (size_t)HALF * K * 2;
    const size_t tstep = 2 * hstep;
    const unsigned ldsw = (unsigned)wid * 1024u;
    const int aoff = lds_byte(wr * 64 + fr, fq * 8), boff = lds_byte(wc * 32 + fr, fq * 8);
#define PG8_SA(b, h) (((b) * 2 + (h)) * HTB)
#define PG8_SB(b, h) ((4 + (b) * 2 + (h)) * HTB)
#define PG8_STAGE(bufoff, gbase, voff) do { _Pragma("unroll") for (int _i = 0; _i < 2; ++_i) \
        __builtin_amdgcn_global_load_lds((const unsigned*)((const char*)(gbase) + (voff)[_i]), (PG8_LAS unsigned*)(lds + (bufoff) + ldsw + _i * 8192), 16, 0, 0); } while (0)
#define PG8_LDA(dst, b, h) do { _Pragma("unroll") for (int m = 0; m < 4; ++m) _Pragma("unroll") for (int k = 0; k < 2; ++k) dst[m][k] = *(const PG8_LAS bf16x8*)(lds + PG8_SA(b, h) + aoff + m * 2048 + k * 1024); } while (0)
#define PG8_LDB(dst, b, h) do { _Pragma("unroll") for (int n = 0; n < 2; ++n) _Pragma("unroll") for (int k = 0; k < 2; ++k) dst[n][k] = *(const PG8_LAS bf16x8*)(lds + PG8_SB(b, h) + boff + n * 2048 + k * 1024); } while (0)
#define PG8_MMA(ai, bj, At, Bt) do { __builtin_amdgcn_s_setprio(1); _Pragma("unroll") for (int m = 0; m < 4; ++m) _Pragma("unroll") for (int n = 0; n < 2; ++n) _Pragma("unroll") for (int k = 0; k < 2; ++k) \
        acc[ai][bj][m][n] = __builtin_amdgcn_mfma_f32_16x16x32_bf16(Bt[n][k], At[m][k], acc[ai][bj][m][n], 0, 0, 0); __builtin_amdgcn_s_setprio(0); } while (0)
#define PG8_WAIT_V(n) asm volatile("s_waitcnt vmcnt(" #n ")" ::: "memory")
#define PG8_WAIT_L(n) asm volatile("s_waitcnt lgkmcnt(" #n ")" ::: "memory")
#define PG8_BAR __builtin_amdgcn_s_barrier()
#define PG8_SCHED __builtin_amdgcn_sched_barrier(0)
    Unit cur, nxt; int ui = 0;
    if (!S.next(0, cur)) return;
    f32x4 acc[2][2][4][2];
#pragma unroll
    for (int a = 0; a < 2; ++a)
#pragma unroll
        for (int b = 0; b < 2; ++b)
#pragma unroll
            for (int m = 0; m < 4; ++m)
#pragma unroll
                for (int n = 0; n < 2; ++n) acc[a][b][m][n] = (f32x4){0.f, 0.f, 0.f, 0.f};
    bf16x8 At[4][2], B0[2][2], B1[2][2];
    const char* cA = (const char*)g.A + (size_t)cur.pm * tstep; const char* cB = (const char*)g.Bt + (size_t)cur.pn * tstep;
    S.a_ready(cur);
    if constexpr (SP2) {
        PG8_STAGE(PG8_SB(0, 0), cB, voffB); PG8_STAGE(PG8_SB(0, 1), cB + hstep, voffB); PG8_STAGE(PG8_SA(0, 0), cA, voffA); PG8_STAGE(PG8_SA(0, 1), cA + hstep, voffA);
        if (wr == 1) PG8_BAR;
        PG8_WAIT_V(2); PG8_BAR;
        PG8_STAGE(PG8_SB(1, 0), cB + kstep, voffB); PG8_STAGE(PG8_SA(1, 0), cA + kstep, voffA); PG8_STAGE(PG8_SB(1, 1), cB + hstep + kstep, voffB);
        PG8_WAIT_V(6); PG8_BAR;
    } else {
        PG8_STAGE(PG8_SB(0, 0), cB, voffB); PG8_STAGE(PG8_SA(0, 0), cA, voffA); PG8_STAGE(PG8_SB(0, 1), cB + hstep, voffB); PG8_STAGE(PG8_SA(0, 1), cA + hstep, voffA);
        if (wr == 1) PG8_BAR;
        PG8_WAIT_V(4); PG8_BAR;
        PG8_STAGE(PG8_SB(1, 0), cB + kstep, voffB); PG8_STAGE(PG8_SA(1, 0), cA + kstep, voffA); PG8_STAGE(PG8_SB(1, 1), cB + hstep + kstep, voffB);
        PG8_WAIT_V(6); PG8_BAR;
    }
    for (;;) {
        const bool has_next = S.next(ui + 1, nxt);
        const char* nA = has_next ? (const char*)g.A + (size_t)nxt.pm * tstep : cA; const char* nB = has_next ? (const char*)g.Bt + (size_t)nxt.pn * tstep : cB;
        for (int t = 0; t < nt; t += 2) {
            const bool last = (t == nt - 2);
            const char* a1 = cA + (size_t)(t + 1) * kstep;
            const char* a2 = last ? nA : cA + (size_t)(t + 2) * kstep; const char* b2 = last ? nB : cB + (size_t)(t + 2) * kstep;
            const char* a3 = a2 + kstep; const char* b3 = b2 + kstep;
            if (last && has_next) S.a_ready(nxt);
            if constexpr (SP2) {
            PG8_LDB(B0, 0, 0); PG8_LDB(B1, 0, 1); PG8_SCHED; PG8_LDA(At, 0, 0); PG8_STAGE(PG8_SA(1, 1), a1 + hstep, voffA);
            PG8_WAIT_V(8); PG8_WAIT_L(0); PG8_BAR; PG8_MMA(0, 0, At, B0); PG8_MMA(0, 1, At, B1); PG8_BAR; PG8_SCHED;
            PG8_LDA(At, 0, 1); PG8_STAGE(PG8_SB(0, 0), b2, voffB); PG8_STAGE(PG8_SB(0, 1), b2 + hstep, voffB); PG8_STAGE(PG8_SA(0, 0), a2, voffA);
            PG8_WAIT_V(8); PG8_WAIT_L(0); PG8_BAR; PG8_MMA(1, 0, At, B0); PG8_MMA(1, 1, At, B1); PG8_BAR; PG8_SCHED;
            PG8_LDB(B0, 1, 0); PG8_LDB(B1, 1, 1); PG8_SCHED; PG8_LDA(At, 1, 0); PG8_STAGE(PG8_SA(0, 1), a2 + hstep, voffA);
            PG8_WAIT_V(8); PG8_WAIT_L(0); PG8_BAR; PG8_MMA(0, 0, At, B0); PG8_MMA(0, 1, At, B1); PG8_BAR; PG8_SCHED;
            PG8_LDA(At, 1, 1); PG8_STAGE(PG8_SB(1, 0), b3, voffB); PG8_STAGE(PG8_SB(1, 1), b3 + hstep, voffB); PG8_STAGE(PG8_SA(1, 0), a3, voffA);
            PG8_WAIT_V(8); PG8_WAIT_L(0); PG8_BAR; PG8_MMA(1, 0, At, B0); PG8_MMA(1, 1, At, B1); PG8_BAR; PG8_SCHED;
            } else {
            PG8_LDB(B0, 0, 0); PG8_SCHED; PG8_LDA(At, 0, 0); PG8_STAGE(PG8_SA(1, 1), a1 + hstep, voffA);
            PG8_WAIT_L(8); PG8_BAR; PG8_WAIT_L(0); PG8_MMA(0, 0, At, B0); PG8_BAR; PG8_SCHED;
            PG8_LDB(B1, 0, 1); PG8_STAGE(PG8_SB(0, 0), b2, voffB);
            PG8_BAR; PG8_WAIT_L(0); PG8_MMA(0, 1, At, B1); PG8_BAR;
            PG8_LDA(At, 0, 1); PG8_STAGE(PG8_SA(0, 0), a2, voffA);
            PG8_BAR; PG8_WAIT_L(0); PG8_MMA(1, 0, At, B0); PG8_BAR; PG8_SCHED;
            PG8_STAGE(PG8_SB(0, 1), b2 + hstep, voffB);
            PG8_WAIT_V(6); PG8_BAR; PG8_MMA(1, 1, At, B1); PG8_BAR;
            PG8_LDB(B0, 1, 0); PG8_SCHED; PG8_LDA(At, 1, 0); PG8_STAGE(PG8_SA(0, 1), a2 + hstep, voffA);
            PG8_WAIT_L(8); PG8_BAR; PG8_WAIT_L(0); PG8_MMA(0, 0, At, B0); PG8_BAR; PG8_SCHED;
            PG8_LDB(B1, 1, 1); PG8_STAGE(PG8_SB(1, 0), b3, voffB);
            PG8_BAR; PG8_WAIT_L(0); PG8_MMA(0, 1, At, B1); PG8_BAR;
            PG8_LDA(At, 1, 1); PG8_STAGE(PG8_SA(1, 0), a3, voffA);
            PG8_BAR; PG8_WAIT_L(0); PG8_MMA(1, 0, At, B0); PG8_BAR; PG8_SCHED;
            PG8_STAGE(PG8_SB(1, 1), b3 + hstep, voffB);
            PG8_WAIT_V(6); PG8_BAR; PG8_MMA(1, 1, At, B1); PG8_BAR;
            }
        }
        if constexpr (ALIGN_EPI) { if (wr == 0) PG8_BAR; }
        if constexpr (!Epi::AFTER_DRAIN) { E(acc, cur, wr, wc, fr, fq); S.done(cur); }
        if (!has_next) break;
#pragma unroll
        for (int a = 0; a < 2; ++a)
#pragma unroll
            for (int b = 0; b < 2; ++b)
#pragma unroll
                for (int m = 0; m < 4; ++m)
#pragma unroll
                    for (int n = 0; n < 2; ++n) acc[a][b][m][n] = (f32x4){0.f, 0.f, 0.f, 0.f};
        cur = nxt; cA = nA; cB = nB; ++ui;
        if constexpr (ALIGN_EPI) { if (wr == 1) PG8_BAR; }
    }
    PG8_WAIT_V(0);
    if constexpr (!ALIGN_EPI) { if (wr == 0) PG8_BAR; }
    PG8_BAR;
    if constexpr (Epi::AFTER_DRAIN) { E.fused(acc, cur, wr, wc, fr, fq, lds, wid, lane); S.done(cur); }
#undef PG8_SA
#undef PG8_SB
#undef PG8_STAGE
#undef PG8_LDA
#undef PG8_LDB
#undef PG8_MMA
#undef PG8_WAIT_V
#undef PG8_WAIT_L
#undef PG8_BAR
#undef PG8_SCHED
}
}
template <class Epi>
DI void gemm_small_tile(const bf16_t* __restrict__ A, int lda, const bf16_t* __restrict__ W, int ldw, int mt, int nt, int K, char* smem, Epi epi) {
  bf16_t* As = (bf16_t*)smem;
  bf16_t* Bs = As + 2 * 256 * 72;
  const int tid = otid(), lane = tid & 63, wave = tid >> 6;
  const int wm = wave >> 1, wn = wave & 1, l = lane & 31, h = lane >> 5;
  const int nk = K >> 6;
  {
    const int m0 = mt * 256, n0 = nt * 128;
    f32x16 acc[2][2];
#pragma unroll
    for (int i = 0; i < 2; ++i)
#pragma unroll
      for (int j = 0; j < 2; ++j)
#pragma unroll
        for (int q = 0; q < 16; ++q) acc[i][j][q] = 0.f;
    uint4 sA0, sA1, sA2, sA3, sA4, sA5, sB0, sB1, sB2, sB3, sB4, sB5;
    const bf16_t* ap[4];
    const bf16_t* bp[2];
    int aoff[4], boff[2];
#pragma unroll
    for (int i = 0; i < 4; ++i) {
      int c = tid + THREADS * i, row = c >> 3, kc = c & 7;
      ap[i] = A + (size_t)(m0 + row) * lda + kc * 8;
      aoff[i] = row * 72 + kc * 8;
    }
#pragma unroll
    for (int i = 0; i < 2; ++i) {
      int c = tid + THREADS * i, row = c >> 3, kc = c & 7;
      bp[i] = W + (size_t)(n0 + row) * ldw + kc * 8;
      boff[i] = row * 72 + kc * 8;
    }
    const bf16_t* Ab = As + (wm * 64 + l) * 72 + 8 * h;
    const bf16_t* Bb = Bs + (wn * 64 + l) * 72 + 8 * h;
#define G_LOAD(P, KT) { const int k1_ = (KT) << 6; P##0 = *(const uint4*)(ap[0] + k1_); P##1 = *(const uint4*)(ap[1] + k1_); P##2 = *(const uint4*)(ap[2] + k1_); \
                        P##3 = *(const uint4*)(ap[3] + k1_); P##4 = *(const uint4*)(bp[0] + k1_); P##5 = *(const uint4*)(bp[1] + k1_); }
#define G_STORE(P, BUF) { *(uint4*)(As + (BUF) * 256 * 72 + aoff[0]) = P##0; *(uint4*)(As + (BUF) * 256 * 72 + aoff[1]) = P##1; *(uint4*)(As + (BUF) * 256 * 72 + aoff[2]) = P##2; \
                          *(uint4*)(As + (BUF) * 256 * 72 + aoff[3]) = P##3; *(uint4*)(Bs + (BUF) * 128 * 72 + boff[0]) = P##4; *(uint4*)(Bs + (BUF) * 128 * 72 + boff[1]) = P##5; }
#define G_COMPUTE(BUF) { _Pragma("unroll") for (int ks = 0; ks < 4; ++ks) { bf16x8 af[2], bfr[2]; \
        af[0] = *(const bf16x8*)(Ab + (BUF) * 256 * 72 + ks * 16); af[1] = *(const bf16x8*)(Ab + (BUF) * 256 * 72 + 32 * 72 + ks * 16); \
        bfr[0] = *(const bf16x8*)(Bb + (BUF) * 128 * 72 + ks * 16); bfr[1] = *(const bf16x8*)(Bb + (BUF) * 128 * 72 + 32 * 72 + ks * 16); \
        _Pragma("unroll") for (int i = 0; i < 2; ++i) _Pragma("unroll") for (int j = 0; j < 2; ++j) acc[i][j] = MFMA32(bfr[j], af[i], acc[i][j]); } }
    G_LOAD(sA, 0);
    sB0 = sA0; sB1 = sA1; sB2 = sA2; sB3 = sA3; sB4 = sA4; sB5 = sA5;
    if (nk > 1) G_LOAD(sB, 1);
    for (int kt = 0; kt < nk; kt += 2) {
      G_STORE(sA, 0);
      __syncthreads();
      if (kt + 2 < nk) G_LOAD(sA, kt + 2);
      G_COMPUTE(0);
      if (kt + 1 < nk) {
        G_STORE(sB, 1);
        __syncthreads();
        if (kt + 3 < nk) G_LOAD(sB, kt + 3);
        G_COMPUTE(1);
      }
    }
    __syncthreads();
#pragma unroll
    for (int i = 0; i < 2; ++i)
#pragma unroll
      for (int j = 0; j < 2; ++j) epi(m0 + wm * 64 + 32 * i + l, n0 + wn * 64 + 32 * j, h, acc[i][j]);
  }
#undef G_LOAD
#undef G_STORE
#undef G_COMPUTE
}
template <class Epi>
DI void gemm_small(const bf16_t* __restrict__ A, int lda, const bf16_t* __restrict__ W, int ldw, int mtiles, int ntiles, int K,
                   int& rot, char* smem, Epi epi) {
  const int G = gridDim.x, total = mtiles * ntiles;
  const int vcu = (G % 8 == 0) ? (obid() % 8) * (G / 8) + obid() / 8 : obid();
  int first = (int)((vcu + G - (rot % G)) % G);
#pragma unroll 1
  for (int tile = first; tile < total; tile += G) {
    const int mt = tile / ntiles, nt = tile - mt * ntiles;
    gemm_small_tile(A, lda, W, ldw, mt, nt, K, smem, epi);
  }
  rot += total;
}

struct EpiUq {
  bf16_t* bq;
  DI void operator()(int m, int nbase, int h, const f32x16& a) const {
    const float qs = 0.10206207261596577f * LOG2E;
    const bool rope = ((nbase % 96) == 64) && (m < NLAT);
    float o[16];
    if (rope) {
      const int t = m & (T_ - 1);
#pragma unroll
      for (int g = 0; g < 4; ++g) {
        const float pos = (g >> 1) ? (float)(t & 63) : (float)(t >> 6);
#pragma unroll
        for (int c = 0; c < 4; ++c) {
          const int fi = 4 * h + c;
          const float inv = fexp2(-(float)fi * (13.287712379549449f / 8.f));
          const float rev = pos * inv * 0.15915494309189535f;
          const float sn = __builtin_amdgcn_sinf(rev), cs = __builtin_amdgcn_cosf(rev);
          const float own = a[4 * g + c], par = a[4 * (g ^ 1) + c];
          o[4 * g + c] = (g & 1) ? (par * sn + own * cs) : (own * cs - par * sn);
        }
      }
    } else {
#pragma unroll
      for (int q = 0; q < 16; ++q) o[q] = a[q];
    }
    bf16_t* dst = bq + (size_t)m * 384 + nbase + 4 * h;
#pragma unroll
    for (int g = 0; g < 4; ++g) st4bf(dst + 8 * g, o[4 * g] * qs, o[4 * g + 1] * qs, o[4 * g + 2] * qs, o[4 * g + 3] * qs);
  }
};
struct EpiUkv {
  bf16_t *bk, *vtb;
  DI void operator()(int m, int nbase, int h, const f32x16& a) const {
    const int head = nbase >> 7, dd = nbase & 127;
    if (dd < 64) {
      bf16_t* dst = bk + (size_t)m * 384 + head * 96 + dd + 4 * h;
#pragma unroll
      for (int g = 0; g < 4; ++g) st4bf(dst + 8 * g, a[4 * g], a[4 * g + 1], a[4 * g + 2], a[4 * g + 3]);
    } else {
      const int b = batch_of_row(m), key = key_of_row(m);
      bf16_t* base = vtb + ((size_t)b * 256 + head * 64 + (dd - 64)) * KEYS + key;
#pragma unroll
      for (int g = 0; g < 4; ++g)
#pragma unroll
        for (int c = 0; c < 4; ++c) base[(size_t)(8 * g + 4 * h + c) * KEYS] = f2bf(a[4 * g + c]);
    }
  }
};
struct EpiUqkv {
  int type; bf16_t *bq, *bk, *vtb;
  DI void operator()(int m, int nbase, int h, const f32x16& a) const {
    if (type == 0) EpiUq{bq}(m, nbase, h, a); else EpiUkv{bk, vtb}(m, nbase, h, a);
  }
};
struct EpiWlora {
  bf16_t* dst; const float* w0;
  DI void operator()(int m, int nbase, int h, const f32x16& a) const {
    float o[16];
#pragma unroll
    for (int g = 0; g < 4; ++g)
#pragma unroll
      for (int c = 0; c < 4; ++c) {
        const float u = w0[nbase + 8 * g + 4 * h + c] + a[4 * g + c];
        const float ew = 0.6065306597126334f * sigmoidf_(u);
        o[4 * g + c] = 1.f - fexp(-ew);
      }
    bf16_t* d = dst + (size_t)m * 1792 + nbase + 4 * h;
#pragma unroll
    for (int g = 0; g < 4; ++g) st4bf(d + 8 * g, o[4 * g], o[4 * g + 1], o[4 * g + 2], o[4 * g + 3]);
  }
};
struct EpiAlora {
  bf16_t* dst; const float* a0;
  DI void operator()(int m, int nbase, int h, const f32x16& a) const {
    float o[16];
#pragma unroll
    for (int g = 0; g < 4; ++g)
#pragma unroll
      for (int c = 0; c < 4; ++c) o[4 * g + c] = sigmoidf_(a0[nbase + 8 * g + 4 * h + c] + a[4 * g + c]);
    bf16_t* d = dst + (size_t)m * 1792 + nbase + 4 * h;
#pragma unroll
    for (int g = 0; g < 4; ++g) st4bf(d + 8 * g, o[4 * g], o[4 * g + 1], o[4 * g + 2], o[4 * g + 3]);
  }
};
struct EpiBf16 {
  bf16_t* dst; int ld; bool sqrelu;
  DI void operator()(int m, int nbase, int h, const f32x16& a) const {
    bf16_t* d = dst + (size_t)m * ld + nbase + 4 * h;
#pragma unroll
    for (int g = 0; g < 4; ++g) {
      float v0 = a[4 * g], v1 = a[4 * g + 1], v2 = a[4 * g + 2], v3 = a[4 * g + 3];
      if (sqrelu) { v0 = fmaxf(v0, 0.f); v1 = fmaxf(v1, 0.f); v2 = fmaxf(v2, 0.f); v3 = fmaxf(v3, 0.f); v0 *= v0; v1 *= v1; v2 *= v2; v3 *= v3; }
      st4bf(d + 8 * g, v0, v1, v2, v3);
    }
  }
};

DI void unpack8(const uint4 u, float* f) {
  f[0] = __uint_as_float(u.x << 16); f[1] = __uint_as_float(u.x & 0xffff0000u); f[2] = __uint_as_float(u.y << 16); f[3] = __uint_as_float(u.y & 0xffff0000u);
  f[4] = __uint_as_float(u.z << 16); f[5] = __uint_as_float(u.z & 0xffff0000u); f[6] = __uint_as_float(u.w << 16); f[7] = __uint_as_float(u.w & 0xffff0000u);
}
DI uint4 pack8(const float* f) { return make_uint4(pack2(f[0], f[1]), pack2(f[2], f[3]), pack2(f[4], f[5]), pack2(f[6], f[7])); }
DI float allreduce8(float v) {
  v += dpp_mov<0xB1>(v);
  v += dpp_mov<0x4E>(v);
  v += dpp_mov<0x141>(v);
  return v;
}
DI uint4 dpp_u4_xor2(uint4 u) {
  uint4 r;
  r.x = (unsigned)__builtin_amdgcn_update_dpp(0, (int)u.x, 0x4E, 0xf, 0xf, false); r.y = (unsigned)__builtin_amdgcn_update_dpp(0, (int)u.y, 0x4E, 0xf, 0xf, false);
  r.z = (unsigned)__builtin_amdgcn_update_dpp(0, (int)u.z, 0x4E, 0xf, 0xf, false); r.w = (unsigned)__builtin_amdgcn_update_dpp(0, (int)u.w, 0x4E, 0xf, 0xf, false);
  return r;
}
DI uint4 dpp_u4_xor1(uint4 u) {
  uint4 r;
  r.x = (unsigned)__builtin_amdgcn_update_dpp(0, (int)u.x, 0xB1, 0xf, 0xf, false); r.y = (unsigned)__builtin_amdgcn_update_dpp(0, (int)u.y, 0xB1, 0xf, 0xf, false);
  r.z = (unsigned)__builtin_amdgcn_update_dpp(0, (int)u.z, 0xB1, 0xf, 0xf, false); r.w = (unsigned)__builtin_amdgcn_update_dpp(0, (int)u.w, 0xB1, 0xf, 0xf, false);
  return r;
}
template <bool DO_ABD, bool DO_C>
DI void prep_rows(const Params& p, int l, int first, int end, int step) {
  char* ws = p.ws;
  const int tid_ = otid(); const int lane = tid_ & 63, wave = tid_ >> 6;
  bf16_t* ZA = (bf16_t*)(ws + OFF_ZA); bf16_t* ZD = (bf16_t*)(ws + OFF_ZD); bf16_t* ZB = (bf16_t*)(ws + OFF_ZB);
  const bf16_t* ZC = (const bf16_t*)(ws + OFF_ZC);
  bf16_t* BK = (bf16_t*)(ws + OFF_BK); bf16_t* SC = (bf16_t*)(ws + OFF_SCANIN);
  bf16_t* TW = (bf16_t*)(ws + OFF_TMPW); bf16_t* TA = (bf16_t*)(ws + OFF_TMPA); bf16_t* TG = (bf16_t*)(ws + OFF_TMPG);
  float* INVN = (float*)(ws + OFF_INVN);
  const float* mu = p.rwkv_mu + l * C_COLS;
  const float* kk0 = p.rwkv_k_k + (l * 2 + 0) * 256; const float* kk1 = p.rwkv_k_k + (l * 2 + 1) * 256;
  const int j = lane & 7;
  float gA[8], gAp[8];
  {
    const float* gsrc = (lane < 32 ? p.gqa_q_norm : p.gqa_k_norm) + l * 64;
#pragma unroll
    for (int e = 0; e < 8; ++e) { gA[e] = gsrc[8 * j + e]; gAp[e] = gsrc[(8 * j + e) ^ 16]; }
  }
  float inv64[8], inv32[8];
#pragma unroll
  for (int e = 0; e < 8; ++e) {
    inv64[e] = fexp2(-(float)(8 * (j & 1) + e) * (13.287712379549449f / 16.f)) * 0.15915494309189535f;
    inv32[e] = fexp2(-(float)e * (13.287712379549449f / 8.f)) * 0.15915494309189535f;
  }
  float gB[8];
#pragma unroll
  for (int e = 0; e < 8; ++e) gB[e] = lane < 32 ? p.mla_q_norm[l * 256 + 8 * lane + e] : (lane < 48 ? p.mla_kv_norm[l * 128 + 8 * (lane - 32) + e] : 0.f);
  float muc[3][8], kkc0[8], kkc1[8];
#pragma unroll
  for (int i = 0; i < 3; ++i)
#pragma unroll
    for (int e = 0; e < 8; ++e) { const int c = lane + 64 * i; muc[i][e] = (c < 132) ? mu[8 * c + e] : 0.f; }
#pragma unroll
  for (int e = 0; e < 8; ++e) { const int kc = (8 * lane - 256) & 255; kkc0[e] = kk0[kc + e]; kkc1[e] = kk1[kc + e]; }
  const bool x2_64 = (j >> 1) & 1, col64 = (j >> 2) & 1;
  const int jj = lane & 3; const bool x2_32 = jj & 1, col32 = (jj >> 1) & 1;
  for (int row = first + wave; row < end; row += step) {
    const bool lat = row < NLAT;
    const int t = row & (T_ - 1);
    const float prow = (float)(t >> 6), pcol = (float)(t & 63);
    uint4 ua = make_uint4(0, 0, 0, 0), ud = ua, ub = ua;
    if constexpr (DO_ABD) {
      ua = *(const uint4*)(ZA + (size_t)row * 512 + 8 * lane);
      ud = *(const uint4*)(ZD + (size_t)row * 512 + 8 * lane);
      ub = *(const uint4*)(ZB + (size_t)row * 512 + 8 * lane);
    }
    const int pos = lat ? t : ((row - NLAT) & (CTXL - 1));
    const int lastp = lat ? (T_ - 1) : (CTXL - 1);
    const bool hp = pos > 0, hn = pos < lastp;
    const bf16_t* zc = ZC + (size_t)row * 1152 + 8 * lane;
    uint4 c0[3], cp[3], cn[3];
#pragma unroll
    for (int i = 0; i < 3; ++i) {
      const bool ok = DO_C && ((i < 2) || (lane < 4));
      c0[i] = ok ? *(const uint4*)(zc + 512 * i) : make_uint4(0, 0, 0, 0);
      cp[i] = (ok && hp) ? *(const uint4*)(zc + 512 * i - 1152) : make_uint4(0, 0, 0, 0);
      cn[i] = (ok && hn) ? *(const uint4*)(zc + 512 * i + 1152) : make_uint4(0, 0, 0, 0);
    }
    if constexpr (DO_ABD) {
    float sn64[8], cs64[8], sn32[8], cs32[8];
    {
      const float p64 = col64 ? pcol : prow, p32 = col32 ? pcol : prow;
#pragma unroll
      for (int e = 0; e < 8; ++e) {
        const float r64 = lat ? p64 * inv64[e] : 0.f, r32 = lat ? p32 * inv32[e] : 0.f;
        sn64[e] = __builtin_amdgcn_sinf(r64); cs64[e] = __builtin_amdgcn_cosf(r64);
        sn32[e] = __builtin_amdgcn_sinf(r32); cs32[e] = __builtin_amdgcn_cosf(r32);
      }
    }
    {
      float x[8], xp[8];
      unpack8(ua, x); unpack8(dpp_u4_xor2(ua), xp);
      float ss = 0.f;
#pragma unroll
      for (int e = 0; e < 8; ++e) ss += x[e] * x[e];
      ss = allreduce8(ss);
      const float rs = frsqrt(ss * (1.f / 64.f) + EPS);
      const float sc = lane < 32 ? 0.125f * LOG2E : 1.f;
      float o[8];
#pragma unroll
      for (int e = 0; e < 8; ++e) {
        const float own = x[e] * rs * gA[e], par = xp[e] * rs * gAp[e];
        o[e] = (x2_64 ? (par * sn64[e] + own * cs64[e]) : (own * cs64[e] - par * sn64[e])) * sc;
      }
      if (lane < 48) *(uint4*)(ZA + (size_t)row * 512 + 8 * lane) = pack8(o);
    }
    {
      float x[8], xp[8];
      unpack8(ud, x); unpack8(dpp_u4_xor2(ud), xp);
      const float sc = lane < 32 ? 0.125f * LOG2E : 1.f;
      float o[8];
#pragma unroll
      for (int e = 0; e < 8; ++e) o[e] = (x2_64 ? (xp[e] * sn64[e] + x[e] * cs64[e]) : (x[e] * cs64[e] - xp[e] * sn64[e])) * sc;
      if (lane < 48) *(uint4*)(ZD + (size_t)row * 512 + 8 * lane) = pack8(o);
    }
    {
      float x[8], xp[8];
      unpack8(ub, x); unpack8(dpp_u4_xor1(ub), xp);
      float ss = 0.f;
#pragma unroll
      for (int e = 0; e < 8; ++e) ss += x[e] * x[e];
      const float s16 = allreduce16(ss);
      const float s32 = s16 + __shfl_xor(s16, 16);
      const float rs = lane < 32 ? frsqrt(s32 * (1.f / 256.f) + EPS) : frsqrt(s16 * (1.f / 128.f) + EPS);
      float o[8];
#pragma unroll
      for (int e = 0; e < 8; ++e) o[e] = x[e] * rs * gB[e];
      if (lane < 48) *(uint4*)(ZB + (size_t)row * 512 + 8 * lane) = pack8(o);
      float kr[8];
#pragma unroll
      for (int e = 0; e < 8; ++e) kr[e] = x2_32 ? (xp[e] * sn32[e] + x[e] * cs32[e]) : (x[e] * cs32[e] - xp[e] * sn32[e]);
      if (lane >= 48 && lane < 52) {
        const uint4 kb = pack8(kr);
        bf16_t* bk = BK + (size_t)row * 384 + 64 + 8 * jj;
        *(uint4*)(bk) = kb; *(uint4*)(bk + 96) = kb; *(uint4*)(bk + 192) = kb; *(uint4*)(bk + 288) = kb;
      }
    }
    }
    if constexpr (DO_C) {
#pragma unroll
    for (int i = 0; i < 3; ++i) {
      const int c = lane + 64 * i;
      if (c < 132) {
        float z[8], zp[8], zn[8], zs[8];
        unpack8(c0[i], z); unpack8(cp[i], zp); unpack8(cn[i], zn);
#pragma unroll
        for (int e = 0; e < 8; ++e) zs[e] = z[e] + muc[i][e] * (0.5f * (zp[e] + zn[e]) - z[e]);
        if (c < 96) {
          const uint4 pk = pack8(zs);
          *(uint4*)(SC + (size_t)row * 1792 + 8 * c) = pk;
          if (i == 0) {
            float kq[8]; unpack8(pk, kq);
            float s0 = 0.f, s1 = 0.f;
#pragma unroll
            for (int e = 0; e < 8; ++e) { const float a0 = kq[e] * kkc0[e], a1 = kq[e] * kkc1[e]; s0 += a0 * a0; s1 += a1 * a1; }
            s0 = allreduce8(s0); s1 = allreduce8(s1);
            if (lane >= 32 && j == 0) {
              const int hd = (lane - 32) >> 3;
              INVN[(size_t)row * 8 + hd] = fminf(frsqrt(s0), 1e12f);
              INVN[(size_t)row * 8 + 4 + hd] = fminf(frsqrt(s1), 1e12f);
            }
          }
        } else if (c < 104) {
          float o[8];
#pragma unroll
          for (int e = 0; e < 8; ++e) { const float ex = fexp(2.f * zs[e]); o[e] = 1.f - 2.f * frcp(ex + 1.f); }
          *(uint4*)(TW + (size_t)row * 64 + 8 * (c - 96)) = pack8(o);
        } else if (c < 112) {
          *(uint4*)(TA + (size_t)row * 64 + 8 * (c - 104)) = pack8(zs);
        } else {
          float o[8];
#pragma unroll
          for (int e = 0; e < 8; ++e) o[e] = sigmoidf_(zs[e]);
          *(uint4*)(TG + (size_t)row * 192 + 8 * (c - 112)) = pack8(o);
        }
      } else if (c < 136) {
        *(uint4*)(TG + (size_t)row * 192 + 8 * (c - 112)) = make_uint4(0, 0, 0, 0);
      }
    }
    }
  }
}

template <int DK>
DI void attn_item(const bf16_t* __restrict__ Q, int ldq, const bf16_t* __restrict__ Kg, int ldk, const bf16_t* __restrict__ Vt,
                  int qrow0, int b, int lat_t0, int lat_t1, bool window, int qpos0, bool use_sink, float sink_l2,
                  bf16_t* out, int ldo, char* smem) {
  constexpr int KS = DK + 8, NKS = DK / 16, CPR = DK / 8;
  bf16_t* Ks = (bf16_t*)smem;
  bf16_t* Vs = Ks + 2 * 64 * KS;
  const int tid = otid(), lane = tid & 63, wave = tid >> 6, l = lane & 31, h = lane >> 5;
  const int pl = (l & ~12) | ((l & 4) << 1) | ((l & 8) >> 1);
  const int nlat = lat_t1 - lat_t0, ntile = nlat + 4;
  bf16x8 qf[NKS];
  {
    const bf16_t* qp = Q + (size_t)(qrow0 + wave * 32 + l) * ldq + 8 * h;
#pragma unroll
    for (int ks = 0; ks < NKS; ++ks) qf[ks] = *(const bf16x8*)(qp + ks * 16);
  }
  f32x16 o0, o1;
#pragma unroll
  for (int q = 0; q < 16; ++q) { o0[q] = 0.f; o1[q] = 0.f; }
  if (wave >= 4) __builtin_amdgcn_s_setprio(1);
  float m_run = use_sink ? sink_l2 : -64.f;
  f32x16 o2;
#pragma unroll
  for (int q = 0; q < 16; ++q) o2[q] = 0.f;
  o2[0] = (use_sink && h == 0) ? 1.f : 0.f;
  bf16x8 vones;
#pragma unroll
  for (int e = 0; e < 8; ++e) vones[e] = (l == 0) ? (short)0x3F80 : (short)0;
  const int qp_ = qpos0 + wave * 32 + l;

  uint4 rk0, rk1 = make_uint4(0, 0, 0, 0), rv;
  const int krow_a = tid / CPR, kc_a = tid % CPR;
  const int krow_b = (tid + 512) / CPR, kc_b = (tid + 512) % CPR;
  const int vrow = tid >> 3, vkc = tid & 7;
  auto tile_src = [&](int i, int& krow_base, int& vcol) {
    if (i < nlat) { const int kt = lat_t0 + i; krow_base = b * T_ + kt * 64; vcol = kt * 64; }
    else { const int c = i - nlat; krow_base = NLAT + b * CTXL + c * 64; vcol = T_ + c * 64; }
  };
  {
    int kb, vc; tile_src(0, kb, vc);
    rk0 = *(const uint4*)(Kg + (size_t)(kb + krow_a) * ldk + kc_a * 8);
    if (DK == 96 && tid < 256) rk1 = *(const uint4*)(Kg + (size_t)(kb + krow_b) * ldk + kc_b * 8);
    rv = *(const uint4*)(Vt + (size_t)vrow * KEYS + vc + vkc * 8);
    *(uint4*)(Ks + krow_a * KS + kc_a * 8) = rk0;
    if (DK == 96 && tid < 256) *(uint4*)(Ks + krow_b * KS + kc_b * 8) = rk1;
    *(uint4*)(Vs + vrow * 72 + vkc * 8) = rv;
  }
  __syncthreads();
  for (int it = 0; it < ntile; ++it) {
    const int buf = it & 1;
    if (it + 1 < ntile) {
      int kb, vc; tile_src(it + 1, kb, vc);
      rk0 = *(const uint4*)(Kg + (size_t)(kb + krow_a) * ldk + kc_a * 8);
      if (DK == 96 && tid < 256) rk1 = *(const uint4*)(Kg + (size_t)(kb + krow_b) * ldk + kc_b * 8);
      rv = *(const uint4*)(Vt + (size_t)vrow * KEYS + vc + vkc * 8);
    }
    const bf16_t* Kb = Ks + buf * 64 * KS + pl * KS + 8 * h;
    const bf16_t* Vb = Vs + buf * 64 * 72 + l * 72 + 8 * h;
    f32x16 s0, s1;
    {
      const float nm = -m_run;
#pragma unroll
      for (int q = 0; q < 16; ++q) { s0[q] = nm; s1[q] = nm; }
    }
#pragma unroll
    for (int ks = 0; ks < NKS; ++ks) {
      const bf16x8 k0 = *(const bf16x8*)(Kb + ks * 16);
      const bf16x8 k1 = *(const bf16x8*)(Kb + 32 * KS + ks * 16);
      s0 = MFMA32(k0, qf[ks], s0);
      s1 = MFMA32(k1, qf[ks], s1);
    }
    if (window && it < nlat) {
      const int kbase = (lat_t0 + it) * 64 + 8 * h - qp_;
#pragma unroll
      for (int q = 0; q < 16; ++q) {
        const int d0 = kbase + 16 * (q >> 3) + (q & 7);
        const int d1 = d0 + 32;
        if (d0 > 128 || d0 < -128) s0[q] = -1e30f;
        if (d1 > 128 || d1 < -128) s1[q] = -1e30f;
      }
    }
    int di = 0;
#pragma unroll
    for (int q = 0; q < 16; q += 2) {
      const int a0 = __float_as_int(s0[q]), a1 = __float_as_int(s1[q]), a2 = __float_as_int(s0[q + 1]), a3 = __float_as_int(s1[q + 1]);
      di = max(max(di, a0), max(a1, max(a2, a3)));
    }
    float d = __int_as_float(di);
    { const auto sw = __builtin_amdgcn_permlane32_swap(__float_as_uint(d), __float_as_uint(d), false, false); d = fmaxf(__uint_as_float(sw[0]), __uint_as_float(sw[1])); }
    if (__any(d > 8.f)) {
      const float alpha = fexp2(-d);
      m_run += d;
      o2[0] *= alpha;
#pragma unroll
      for (int q = 0; q < 16; ++q) { s0[q] -= d; s1[q] -= d; o0[q] *= alpha; o1[q] *= alpha; }
    }
#pragma unroll
    for (int q = 0; q < 16; ++q) { s0[q] = fexp2(s0[q]); s1[q] = fexp2(s1[q]); }
    bf16x8 pf[4];
#pragma unroll
    for (int s4 = 0; s4 < 4; ++s4) {
      unsigned u[4];
#pragma unroll
      for (int j = 0; j < 4; ++j) {
        const float e0 = (s4 < 2) ? s0[8 * (s4 & 1) + 2 * j] : s1[8 * (s4 & 1) + 2 * j];
        const float e1 = (s4 < 2) ? s0[8 * (s4 & 1) + 2 * j + 1] : s1[8 * (s4 & 1) + 2 * j + 1];
        u[j] = pack2(e0, e1);
      }
      pf[s4] = __builtin_bit_cast(bf16x8, make_uint4(u[0], u[1], u[2], u[3]));
    }
#pragma unroll
    for (int s4 = 0; s4 < 4; ++s4) {
      const bf16x8 v0 = *(const bf16x8*)(Vb + s4 * 16);
      const bf16x8 v1 = *(const bf16x8*)(Vb + 32 * 72 + s4 * 16);
      o0 = MFMA32(v0, pf[s4], o0);
      o1 = MFMA32(v1, pf[s4], o1);
      o2 = MFMA32(vones, pf[s4], o2);
    }
    if (it + 1 < ntile) {
      const int nb = buf ^ 1;
      *(uint4*)(Ks + nb * 64 * KS + krow_a * KS + kc_a * 8) = rk0;
      if (DK == 96 && tid < 256) *(uint4*)(Ks + nb * 64 * KS + krow_b * KS + kc_b * 8) = rk1;
      *(uint4*)(Vs + nb * 64 * 72 + vrow * 72 + vkc * 8) = rv;
    }
    __syncthreads();
  }
  __builtin_amdgcn_s_setprio(0);
  float lt;
  { const float l_run = o2[0]; const auto sw = __builtin_amdgcn_permlane32_swap(__float_as_uint(l_run), __float_as_uint(l_run), false, false); lt = __uint_as_float(sw[0]) + __uint_as_float(sw[1]); }
  const float inv = frcp(lt);
  bf16_t* op = out + (size_t)(qrow0 + wave * 32 + l) * ldo + 4 * h;
#pragma unroll
  for (int g = 0; g < 4; ++g) {
    st4bf(op + 8 * g, o0[4 * g] * inv, o0[4 * g + 1] * inv, o0[4 * g + 2] * inv, o0[4 * g + 3] * inv);
    st4bf(op + 32 + 8 * g, o1[4 * g] * inv, o1[4 * g + 1] * inv, o1[4 * g + 2] * inv, o1[4 * g + 3] * inv);
  }
}

DI void run_attn_item(const Params& p, int l, int kind, int b, int hq, int qt, bool isctx, char* smem) {
  char* ws = p.ws;
  const bf16_t* ZA = (const bf16_t*)(ws + OFF_ZA); const bf16_t* ZD = (const bf16_t*)(ws + OFF_ZD);
  const bf16_t* BQ = (const bf16_t*)(ws + OFF_BQ); const bf16_t* BK = (const bf16_t*)(ws + OFF_BK);
  const bf16_t* VTA = (const bf16_t*)(ws + OFF_VTA); const bf16_t* VTB = (const bf16_t*)(ws + OFF_VTB); const bf16_t* VTD = (const bf16_t*)(ws + OFF_VTD);
  bf16_t* OUTS = (bf16_t*)(ws + OFF_OUTS);
  const int qrow0 = isctx ? NLAT + b * CTXL : b * T_ + qt * 256;
  int t0 = 0, t1 = isctx ? 0 : 128;
  if (kind == 0) {
    attn_item<96>(BQ + hq * 96, 384, BK + hq * 96, 384, VTB + ((size_t)b * 256 + hq * 64) * KEYS, qrow0, b, t0, t1, false, 0, false, 0.f,
                  OUTS + 256 + hq * 64, 1024, smem);
  } else if (kind == 1) {
    attn_item<64>(ZA + hq * 64, 512, ZA + 256 + (hq >> 1) * 64, 512, VTA + ((size_t)b * 128 + (hq >> 1) * 64) * KEYS, qrow0, b, t0, t1, false, 0,
                  false, 0.f, OUTS + hq * 64, 1024, smem);
  } else {
    if (!isctx) { t0 = 4 * qt - 2; if (t0 < 0) t0 = 0; t1 = 4 * qt + 6; if (t1 > 128) t1 = 128; }
    attn_item<64>(ZD + hq * 64, 512, ZD + 256 + (hq >> 1) * 64, 512, VTD + ((size_t)b * 128 + (hq >> 1) * 64) * KEYS, qrow0, b, t0, t1, !isctx,
                  qt * 256, true, p.swa_sink[l * 4 + hq] * LOG2E, OUTS + 768 + hq * 64, 1024, smem);
  }
}

constexpr int SCH = 32;
constexpr int SST = 336;
DI int scan_row(int b, int dir, int s) {
  if (s < CTXL) return NLAT + b * CTXL + (dir ? CTXL - 1 - s : s);
  const int s2 = s - CTXL;
  return b * T_ + (dir ? T_ - 1 - s2 : s2);
}
DI void scan_block(const Params& p, int l, int sb, char* smem) {
  float* opbuf = (float*)smem;
  float* ybuf = opbuf + 2 * SCH * SST;
  const int tid = otid(), lane = tid & 63, wave = tid >> 6;
  const int chain = sb >> 2, rg = sb & 3, b = chain >> 3, hh = (chain >> 1) & 3, dir = chain & 1;
  const bf16_t* SC = (const bf16_t*)(p.ws + OFF_SCANIN);
  float* Y = (float*)(p.ws + OFF_Y) + (size_t)dir * NT * 256;
  const int nchunk = (CTXL + T_) / SCH;
  const float* INVN = (const float*)(p.ws + OFF_INVN);
  const int ht = tid - 256, fg = ht & 15;
  float kkc[4], kac[4];
#pragma unroll
  for (int e = 0; e < 4; ++e) {
    kkc[e] = p.rwkv_k_k[(l * 2 + dir) * 256 + hh * 64 + ((4 * fg + e) & 63)];
    kac[e] = p.rwkv_k_a[(l * 2 + dir) * 256 + hh * 64 + ((4 * fg + e) & 63)];
  }
  struct HStage { uint2 r0, k0, v0, w0, a0, r1, k1, v1, w1, a1; float n0, n1; };
  auto issue = [&](HStage& h, int ci) {
    {
      const int row = scan_row(b, dir, ci * SCH + (ht >> 4));
      const bf16_t* src = SC + (size_t)row * 1792 + hh * 64 + 4 * fg;
      h.r0 = *(const uint2*)(src); h.k0 = *(const uint2*)(src + 256); h.v0 = *(const uint2*)(src + 512);
      h.w0 = *(const uint2*)(src + (3 + dir) * 256); h.a0 = *(const uint2*)(src + (5 + dir) * 256);
      h.n0 = INVN[(size_t)row * 8 + dir * 4 + hh];
    }
    {
      const int row = scan_row(b, dir, ci * SCH + (ht >> 4) + 16);
      const bf16_t* src = SC + (size_t)row * 1792 + hh * 64 + 4 * fg;
      h.r1 = *(const uint2*)(src); h.k1 = *(const uint2*)(src + 256); h.v1 = *(const uint2*)(src + 512);
      h.w1 = *(const uint2*)(src + (3 + dir) * 256); h.a1 = *(const uint2*)(src + (5 + dir) * 256);
      h.n1 = INVN[(size_t)row * 8 + dir * 4 + hh];
    }
  };
  auto commit1 = [&](uint2 lr, uint2 lk, uint2 lv, uint2 lw, uint2 la, float inn, int ls, int bi) {
    float* st = opbuf + ((size_t)bi * SCH + ls) * SST + 4 * fg;
    float r4[4], k4[4], v4[4], w4[4], a4[4];
    r4[0] = __uint_as_float(lr.x << 16); r4[1] = __uint_as_float(lr.x & 0xffff0000u); r4[2] = __uint_as_float(lr.y << 16); r4[3] = __uint_as_float(lr.y & 0xffff0000u);
    k4[0] = __uint_as_float(lk.x << 16); k4[1] = __uint_as_float(lk.x & 0xffff0000u); k4[2] = __uint_as_float(lk.y << 16); k4[3] = __uint_as_float(lk.y & 0xffff0000u);
    v4[0] = __uint_as_float(lv.x << 16); v4[1] = __uint_as_float(lv.x & 0xffff0000u); v4[2] = __uint_as_float(lv.y << 16); v4[3] = __uint_as_float(lv.y & 0xffff0000u);
    w4[0] = __uint_as_float(lw.x << 16); w4[1] = __uint_as_float(lw.x & 0xffff0000u); w4[2] = __uint_as_float(lw.y << 16); w4[3] = __uint_as_float(lw.y & 0xffff0000u);
    a4[0] = __uint_as_float(la.x << 16); a4[1] = __uint_as_float(la.x & 0xffff0000u); a4[2] = __uint_as_float(la.y << 16); a4[3] = __uint_as_float(la.y & 0xffff0000u);
    float kk[4];
#pragma unroll
    for (int e = 0; e < 4; ++e) kk[e] = k4[e] * kkc[e] * inn;
    *(float4*)(st) = make_float4(1.f - w4[0], 1.f - w4[1], 1.f - w4[2], 1.f - w4[3]);
    *(float4*)(st + 64) = make_float4(-kk[0], -kk[1], -kk[2], -kk[3]);
    *(float4*)(st + 128) = make_float4(kk[0] * a4[0], kk[1] * a4[1], kk[2] * a4[2], kk[3] * a4[3]);
    *(float4*)(st + 192) = make_float4(k4[0] * (1.f + (a4[0] - 1.f) * kac[0]), k4[1] * (1.f + (a4[1] - 1.f) * kac[1]),
                                       k4[2] * (1.f + (a4[2] - 1.f) * kac[2]), k4[3] * (1.f + (a4[3] - 1.f) * kac[3]));
    *(float4*)(st + 256) = make_float4(r4[0], r4[1], r4[2], r4[3]);
    if ((fg >> 2) == rg) *(float4*)(opbuf + ((size_t)bi * SCH + ls) * SST + 320 + 4 * (fg & 3)) = make_float4(v4[0], v4[1], v4[2], v4[3]);
  };
  auto commit = [&](const HStage& h, int bi) {
    commit1(h.r0, h.k0, h.v0, h.w0, h.a0, h.n0, (ht >> 4), bi);
    commit1(h.r1, h.k1, h.v1, h.w1, h.a1, h.n1, (ht >> 4) + 16, bi);
  };
  auto flush = [&](int ci) {
    const float* yb = ybuf + (size_t)(ci & 1) * SCH * 256;
#pragma unroll
    for (int i = 0; i < 2; ++i) {
      const int o = ht + 256 * i, ls = o >> 4, r16 = o & 15;
      const float* src = yb + ls * 256 + r16 * 16;
      const float4 a = *(const float4*)(src), b4 = *(const float4*)(src + 4), c = *(const float4*)(src + 8), d = *(const float4*)(src + 12);
      const float y = ((a.x + a.y) + (a.z + a.w)) + ((b4.x + b4.y) + (b4.z + b4.w)) + ((c.x + c.y) + (c.z + c.w)) + ((d.x + d.y) + (d.z + d.w));
      Y[(size_t)scan_row(b, dir, ci * SCH + ls) * 256 + hh * 64 + rg * 16 + r16] = y;
    }
  };
  typedef float f2_t __attribute__((ext_vector_type(2)));
  f2_t Sa = {0.f, 0.f}, Sb = {0.f, 0.f};
  const int rowl = wave * 4 + (lane >> 4), c4 = lane & 15;
  auto process = [&](int bi) {
    const float* cb = opbuf + (size_t)bi * SCH * SST + 4 * c4;
    const float* vb = opbuf + (size_t)bi * SCH * SST + 320 + rowl;
    float* yb = ybuf + (size_t)bi * SCH * 256 + wave * 64 + lane;
    f2_t W0[3], W1[3], A0[3], A1[3], B0[3], B1[3], K0[3], K1[3], R0[3], R1[3]; float V_[3];
#define SC_LD2(DST0, DST1, PTR) { const float4 t_ = *(const float4*)(PTR); DST0 = (f2_t){t_.x, t_.y}; DST1 = (f2_t){t_.z, t_.w}; }
#define SC_LOAD(ST, SL) { const float* q_ = cb + (ST) * SST; SC_LD2(W0[SL], W1[SL], q_); SC_LD2(A0[SL], A1[SL], q_ + 64); SC_LD2(B0[SL], B1[SL], q_ + 128); \
                          SC_LD2(K0[SL], K1[SL], q_ + 192); SC_LD2(R0[SL], R1[SL], q_ + 256); V_[SL] = vb[(ST) * SST]; }
    SC_LOAD(0, 0);
    SC_LOAD(1, 1);
#pragma unroll
    for (int ls = 0; ls < SCH; ++ls) {
      if (ls + 2 < SCH) SC_LOAD(ls + 2, (ls + 2) % 3);
      const int sl = ls % 3;
      const f2_t vv = {V_[sl], V_[sl]};
      f2_t pp = __builtin_elementwise_fma(Sb, A1[sl], Sa * A0[sl]);
      float pa = pp.x + pp.y;
      const f2_t ta = __builtin_elementwise_fma(Sa, W0[sl], vv * K0[sl]);
      const f2_t tb = __builtin_elementwise_fma(Sb, W1[sl], vv * K1[sl]);
      pa = allreduce16(pa);
      const f2_t pv = {pa, pa};
      Sa = __builtin_elementwise_fma(pv, B0[sl], ta);
      Sb = __builtin_elementwise_fma(pv, B1[sl], tb);
      const f2_t yy = __builtin_elementwise_fma(Sb, R1[sl], Sa * R0[sl]);
      yb[ls * 256] = yy.x + yy.y;
    }
#undef SC_LOAD
#undef SC_LD2
  };
  HStage h0, h1;
  const bool helper = wave >= 4;
  if (helper) { issue(h0, 0); commit(h0, 0); issue(h1, 1); issue(h0, 2); }
  __syncthreads();
#pragma unroll 1
  for (int ci = 0; ci <= nchunk; ci += 2) {
    if (helper) {
      if (ci + 1 < nchunk) { commit(h1, 1); if (ci + 3 < nchunk) issue(h1, ci + 3); }
      if (ci >= 1) flush(ci - 1);
    } else if (ci < nchunk) process(0);
    __syncthreads();
    if (helper) {
      if (ci + 2 < nchunk) { commit(h0, 0); if (ci + 4 < nchunk) issue(h0, ci + 4); }
      if (ci < nchunk) flush(ci);
    } else if (ci + 1 < nchunk) process(1);
    __syncthreads();
  }
}

DI void phase_rwkv_out(const Params& p, int l, int nrows) {
  char* ws = p.ws;
  const int tid_ = otid(); const int lane = tid_ & 63, wave = tid_ >> 6;
  const float* Y0 = (const float*)(ws + OFF_Y); const float* Y1 = Y0 + (size_t)NT * 256;
  const bf16_t* SC = (const bf16_t*)(ws + OFF_SCANIN); const bf16_t* Gb = (const bf16_t*)(ws + OFF_G);
  bf16_t* OUTS = (bf16_t*)(ws + OFF_OUTS);
  const int c0 = 4 * lane;
  const float4 lw = *(const float4*)(p.rwkv_ln_w + l * 256 + c0), lb = *(const float4*)(p.rwkv_ln_b + l * 256 + c0);
  const float4 ka0 = *(const float4*)(p.rwkv_k_a + (l * 2 + 0) * 256 + c0), ka1 = *(const float4*)(p.rwkv_k_a + (l * 2 + 1) * 256 + c0);
  const float4 rk = *(const float4*)(p.rwkv_r_k + l * 256 + c0);
  const float lwv[4] = {lw.x, lw.y, lw.z, lw.w}, lbv[4] = {lb.x, lb.y, lb.z, lb.w};
  const float k0v[4] = {ka0.x, ka0.y, ka0.z, ka0.w}, k1v[4] = {ka1.x, ka1.y, ka1.z, ka1.w}, rkv[4] = {rk.x, rk.y, rk.z, rk.w};
  for (int row = obid() * 8 + wave; row < nrows; row += gridDim.x * 8) {
    const float4 ya = *(const float4*)(Y0 + (size_t)row * 256 + c0), yb = *(const float4*)(Y1 + (size_t)row * 256 + c0);
    const bf16_t* sc = SC + (size_t)row * 1792 + c0;
    const uint2 ur = *(const uint2*)(sc), uk = *(const uint2*)(sc + 256), uv = *(const uint2*)(sc + 512), ua0 = *(const uint2*)(sc + 5 * 256), ua1 = *(const uint2*)(sc + 6 * 256);
    const uint2 ug = *(const uint2*)(Gb + (size_t)row * 256 + c0);
    const float y[4] = {ya.x + yb.x, ya.y + yb.y, ya.z + yb.z, ya.w + yb.w};
    const float mean = allreduce16((y[0] + y[1]) + (y[2] + y[3])) * (1.f / 64.f);
    float d[4], var = 0.f;
#pragma unroll
    for (int e = 0; e < 4; ++e) { d[e] = y[e] - mean; var += d[e] * d[e]; }
    var = allreduce16(var) * (1.f / 64.f);
    const float rstd = frsqrt(var + 64e-5f);
#define U2F(U, E) (((E) & 1) ? __uint_as_float((((E) >> 1) ? (U).y : (U).x) & 0xffff0000u) : __uint_as_float((((E) >> 1) ? (U).y : (U).x) << 16))
    float bs = 0.f, r4[4], k4[4], v4[4], g4[4];
#pragma unroll
    for (int e = 0; e < 4; ++e) {
      r4[e] = U2F(ur, e); k4[e] = U2F(uk, e); v4[e] = U2F(uv, e); g4[e] = U2F(ug, e);
      const float a0 = U2F(ua0, e), a1 = U2F(ua1, e);
      const float kd0 = k4[e] * (1.f + (a0 - 1.f) * k0v[e]), kd1 = k4[e] * (1.f + (a1 - 1.f) * k1v[e]);
      bs += r4[e] * (kd0 + kd1) * rkv[e];
    }
#undef U2F
    bs = allreduce16(bs);
    float o[4];
#pragma unroll
    for (int e = 0; e < 4; ++e) o[e] = ((d[e] * rstd * lwv[e] + lbv[e]) + bs * v4[e]) * g4[e];
    st4bf(OUTS + (size_t)row * 1024 + 512 + c0, o[0], o[1], o[2], o[3]);
  }
}

#define XB_TMO      128
#define XB_XCNT(j)  (256  + 64 * (j))
#define XB_XSUB(j)  (1280 + 64 * (j))
#define XB_XGEN(j)  (2304 + 64 * (j))
#define XB_TOP      3328
#define XB_TOPGEN   3392
#define XCD_BAR_WORDS 3456
#define XB_SPIN_CAP (1u << 22)
#define LAS __attribute__((address_space(3)))
DI unsigned xb_ld(unsigned* p) { return __hip_atomic_load(p, __ATOMIC_RELAXED, __HIP_MEMORY_SCOPE_AGENT); }
DI unsigned xb_add(unsigned* p, unsigned v) { return __hip_atomic_fetch_add(p, v, __ATOMIC_RELAXED, __HIP_MEMORY_SCOPE_AGENT); }
DI unsigned xb_xcc_id() { return (unsigned)__builtin_amdgcn_s_getreg((3 << 11) | 20) & 0xFu; }
#define XB_SPIN(cond, bar) do { unsigned _sp = 0; while (cond) { __builtin_amdgcn_s_sleep(1); \
    if ((++_sp & 255u) == 0u) { if (xb_ld(&(bar)[XB_TMO])) break; if (_sp > XB_SPIN_CAP) { atomicAdd(&(bar)[XB_TMO], 1u); break; } } } } while (0)
struct XcdBarrier { unsigned* bar; unsigned x; volatile LAS unsigned* st; };
DI XcdBarrier xcd_barrier_post(unsigned* bar, volatile LAS unsigned* st) {
  XcdBarrier b; b.bar = bar; b.x = xb_xcc_id(); b.st = st;
  if (threadIdx.x == 0) (void)xb_add(&bar[XB_XCNT(b.x)], 1u);
  return b;
}
DI void xcd_barrier_complete(unsigned* bar, unsigned x, unsigned& nloc, unsigned& nx) {
  const unsigned G = gridDim.x * gridDim.y * gridDim.z;
  unsigned sum, cnt, mine, sp = 0u;
  for (;;) {
    sum = 0u; cnt = 0u; mine = 0u;
#pragma unroll
    for (unsigned j = 0; j < 16; ++j) { const unsigned c = xb_ld(&bar[XB_XCNT(j)]); sum += c; cnt += (c > 0u) ? 1u : 0u; mine = (j == x) ? c : mine; }
    if (sum == G) break;
    __builtin_amdgcn_s_sleep(1);
    if ((++sp & 255u) == 0u) { if (xb_ld(&bar[XB_TMO])) break; if (sp > XB_SPIN_CAP) { atomicAdd(&bar[XB_TMO], 1u); break; } }
  }
  nloc = mine > 0u ? mine : 1u; nx = cnt > 0u ? cnt : 1u;
}
DI void xcd_barrier(const XcdBarrier& b) {
  asm volatile("s_waitcnt vmcnt(0)" ::: "memory");
  __syncthreads();
  if (otid() == 0) {
    unsigned* bar = b.bar;
    __builtin_amdgcn_s_waitcnt(0);
    unsigned nloc = b.st[0], nx = b.st[1];
    if (nloc == 0u) { xcd_barrier_complete(bar, b.x, nloc, nx); b.st[0] = nloc; b.st[1] = nx; }
    const unsigned old = xb_add(&bar[XB_XSUB(b.x)], 1u);
    const unsigned gen = old / nloc;
    if (old + 1u == (gen + 1u) * nloc) {
      __builtin_amdgcn_fence(__ATOMIC_RELEASE, "agent");
      asm volatile("s_waitcnt vmcnt(0)" ::: "memory");
      const unsigned og = xb_add(&bar[XB_TOP], 1u);
      const unsigned tg = og / nx;
      if (og + 1u == (tg + 1u) * nx) xb_add(&bar[XB_TOPGEN], 1u);
      else XB_SPIN(xb_ld(&bar[XB_TOPGEN]) == tg, bar);
      __builtin_amdgcn_fence(__ATOMIC_ACQUIRE, "agent");
      xb_add(&bar[XB_XGEN(b.x)], 1u);
      asm volatile("s_waitcnt vmcnt(0)" ::: "memory");
    } else {
      XB_SPIN(xb_ld(&bar[XB_XGEN(b.x)]) == gen, bar);
      __builtin_amdgcn_fence(__ATOMIC_ACQUIRE, "agent");
      asm volatile("s_waitcnt vmcnt(0)" ::: "memory");
    }
  }
  __syncthreads();
}

typedef const uint64_t __attribute__((address_space(4))) cu64_t;
DI Params load_params(cu64_t*& ka) {
  asm volatile("" : "+s"(ka));
  Params p;
  const float** d = (const float**)&p;
#pragma unroll
  for (int i = 0; i < 32; ++i) d[i] = (const float*)(const float __attribute__((address_space(1)))*)ka[i];
  p.out = (float*)(float __attribute__((address_space(1)))*)ka[32];
  p.ws = (char*)(char __attribute__((address_space(1)))*)ka[33];
  return p;
}
#define LP() const Params p = load_params(ka)
__global__ void __launch_bounds__(THREADS) fwd_megakernel(Params p_unused) {
  extern __shared__ __attribute__((aligned(16))) char smem[];
  cg::grid_group grid = cg::this_grid();
  cu64_t* ka = (cu64_t*)__builtin_amdgcn_kernarg_segment_ptr();
  int* s_item = (int*)(smem + LDS_MAIN);
  if (threadIdx.x < 16) ((volatile LAS unsigned*)(smem + LDS_MAIN))[threadIdx.x] = 0u;
  __syncthreads();
  XcdBarrier xbar;
  { LP(); xbar = xcd_barrier_post((unsigned*)(p.ws + OFF_CTL), (volatile LAS unsigned*)(smem + LDS_MAIN + 16)); }
#define PH_BEGIN { LP(); char* ws = p.ws; (void)ws; float* mods = (float*)(ws + OFF_MODS); (void)mods; float* XC = (float*)(ws + OFF_XC); (void)XC; bf16_t* H = (bf16_t*)(ws + OFF_H); (void)H; int rot = 0; (void)rot;
#define XBAR() { LP(); xbar.bar = (unsigned*)(p.ws + OFF_CTL); xbar.x = xb_xcc_id(); xcd_barrier(xbar); }
#define PH_END } XBAR();
#define PH_END_CG } if (gridDim.x == 0x7fffffffu) grid.sync(); XBAR();

  PH_BEGIN
    phase_mods(p, smem);
    phase_convert(p, 0, smem);
  PH_END_CG
  PH_BEGIN
    phase_rows(p, NT, nullptr, p.x, p.ctx, nullptr, nullptr, nullptr, 0, nullptr, true, mods, 0, 1024, p.g_pre_mix, H);
  PH_END

  volatile int* s_layer = (volatile int*)(smem + LDS_MAIN + 48);
#pragma unroll 1
  for (;;) {
    const int l = __builtin_amdgcn_readfirstlane(*s_layer);
    if (l >= 2) break;
    const bool last = (l == 1);
    const int nrows = last ? NLAT : NT;
    PH_BEGIN
      pg8::PEpiWin e{(bf16_t*)(ws + OFF_ZA), (bf16_t*)(ws + OFF_ZB), (bf16_t*)(ws + OFF_ZC), (bf16_t*)(ws + OFF_ZD), (bf16_t*)(ws + OFF_VTA), (bf16_t*)(ws + OFF_VTD)};
      const int vcu = (gridDim.x % 8 == 0) ? (obid() % 8) * ((int)gridDim.x / 8) + obid() / 8 : obid();
      pg8::Gemm g{H, (const bf16_t*)(ws + OFF_WIN), NT, NWIN, 1024, 1024}; pg8::WinCOrder S{(int)gridDim.x, vcu};
      pg8::gemm_phase<pg8::PEpiWin, pg8::WinCOrder, true, true>((PG8_LAS unsigned char*)smem, g, S, e);
    PH_END
    PH_BEGIN
      prep_rows<false, true>(p, l, obid() * 8, NT, (int)gridDim.x * 8);
    PH_END
    PH_BEGIN
      gemm_small((const bf16_t*)(ws + OFF_TMPW), 64, (const bf16_t*)(ws + OFF_WW2), 64, NT / 256, 4, 64, rot, smem,
                 EpiWlora{(bf16_t*)(ws + OFF_SCANIN) + 3 * 256, p.rwkv_w0 + l * 512});
      gemm_small((const bf16_t*)(ws + OFF_TMPA), 64, (const bf16_t*)(ws + OFF_WA2), 64, NT / 256, 4, 64, rot, smem,
                 EpiAlora{(bf16_t*)(ws + OFF_SCANIN) + 5 * 256, p.rwkv_a0 + l * 512});
      gemm_small((const bf16_t*)(ws + OFF_TMPG), 192, (const bf16_t*)(ws + OFF_WG2), 192, NT / 256, 2, 192, rot, smem, EpiBf16{(bf16_t*)(ws + OFF_G), 256, false});
    PH_END
    PH_BEGIN
      for (int sb = obid(); sb < 64; sb += gridDim.x) scan_block(p, l, sb, smem);
      const int NWQ = 384, NPREP = 264, NPROJ = 462, NJOB = NWQ + NPREP + NPROJ;
      const int nitems = NJOB + (last ? 768 : 792);
      unsigned* counters = (unsigned*)(ws + OFF_CTL + 32768);
      bool win_ok = false;
      bool prep_ok = false;
      bool proj_ok = false;
#pragma unroll 1
      for (;;) {
        if (otid() == 0) {
          const int it = (int)atomicAdd(&counters[l * 64], 1u);
          if (it >= NWQ && it < nitems && !win_ok) {
            unsigned sp = 0;
            while (xb_ld(&counters[l * 64 + 48]) < (unsigned)NWQ) { __builtin_amdgcn_s_sleep(2); if (++sp > (1u << 24)) break; }
            __builtin_amdgcn_fence(__ATOMIC_ACQUIRE, "agent");
            asm volatile("s_waitcnt vmcnt(0)" ::: "memory");
            win_ok = true;
          }
          if (it >= NWQ + NPREP && it < nitems && !prep_ok) {
            unsigned sp = 0;
            while (xb_ld(&counters[l * 64 + 32]) < (unsigned)NPREP) { __builtin_amdgcn_s_sleep(2); if (++sp > (1u << 24)) break; }
            __builtin_amdgcn_fence(__ATOMIC_ACQUIRE, "agent");
            asm volatile("s_waitcnt vmcnt(0)" ::: "memory");
            prep_ok = true;
          }
          const int q0 = it - NJOB;
          const bool is_mla = (q0 >= 256 && q0 < 512) || (q0 >= 768 && q0 < 776);
          if (is_mla && it < nitems && !proj_ok) {
            unsigned sp = 0;
            while (xb_ld(&counters[l * 64 + 16]) < (unsigned)NPROJ) { __builtin_amdgcn_s_sleep(2); if (++sp > (1u << 24)) break; }
            __builtin_amdgcn_fence(__ATOMIC_ACQUIRE, "agent");
            asm volatile("s_waitcnt vmcnt(0)" ::: "memory");
            proj_ok = true;
          }
          *s_item = it;
        }
        __syncthreads();
        const int item = *s_item;
        __syncthreads();
        if (item >= nitems) break;
        if (item < NWQ) {
          const int mt = item / 6, k6 = item - 6 * mt;
          pg8::PEpiWin e{(bf16_t*)(ws + OFF_ZA), (bf16_t*)(ws + OFF_ZB), (bf16_t*)(ws + OFF_ZC), (bf16_t*)(ws + OFF_ZD), (bf16_t*)(ws + OFF_VTA), (bf16_t*)(ws + OFF_VTD)};
          pg8::Gemm g{H, (const bf16_t*)(ws + OFF_WIN), NT, NWIN, 1024, 1024};
          pg8::PieceOrder S{mt, k6 < 4 ? k6 : k6 + 5, true};
          pg8::gemm_phase<pg8::PEpiWin, pg8::PieceOrder, false, true>((PG8_LAS unsigned char*)smem, g, S, e);
          asm volatile("s_waitcnt vmcnt(0)" ::: "memory");
          __syncthreads();
          if (otid() == 0) {
            __builtin_amdgcn_fence(__ATOMIC_RELEASE, "agent");
            asm volatile("s_waitcnt vmcnt(0)" ::: "memory");
            (void)xb_add(&counters[l * 64 + 48], 1u);
          }
        } else if (item < NWQ + NPREP) {
          const int pjb = item - NWQ;
          prep_rows<true, false>(p, l, pjb * 64, pjb * 64 + 64, 8);
          asm volatile("s_waitcnt vmcnt(0)" ::: "memory");
          __syncthreads();
          if (otid() == 0) {
            __builtin_amdgcn_fence(__ATOMIC_RELEASE, "agent");
            asm volatile("s_waitcnt vmcnt(0)" ::: "memory");
            (void)xb_add(&counters[l * 64 + 32], 1u);
          }
        } else if (item < NJOB) {
          const bf16_t* ZB = (const bf16_t*)(ws + OFF_ZB);
          const int pj = item - NWQ - NPREP;
          const bool isq = pj < 198;
          const int j = isq ? pj : pj - 198;
          const int mt = isq ? j / 3 : j >> 2, nt = isq ? j - 3 * mt : j & 3;
          gemm_small_tile(isq ? ZB : ZB + 256, 512, (const bf16_t*)(ws + (isq ? OFF_WUQ : OFF_WUKV)), isq ? 256 : 128, mt, nt, isq ? 256 : 128, smem,
                          EpiUqkv{isq ? 0 : 1, (bf16_t*)(ws + OFF_BQ), (bf16_t*)(ws + OFF_BK), (bf16_t*)(ws + OFF_VTB)});
          asm volatile("s_waitcnt vmcnt(0)" ::: "memory");
          __syncthreads();
          if (otid() == 0) {
            __builtin_amdgcn_fence(__ATOMIC_RELEASE, "agent");
            asm volatile("s_waitcnt vmcnt(0)" ::: "memory");
            (void)xb_add(&counters[l * 64 + 16], 1u);
          }
        } else {
          const int q = item - NJOB;
          int kind, b, hq, qt; bool isctx = false;
          if (q < 768) { const int k3 = q >> 8; kind = (k3 == 0) ? 1 : (k3 == 1 ? 0 : 2); const int j = q & 255; b = j >> 7; hq = (j >> 5) & 3; qt = j & 31; }
          else { const int j = q - 768; kind = j >> 3; b = (j >> 2) & 1; hq = j & 3; qt = 0; isctx = true; }
          run_attn_item(p, l, kind, b, hq, qt, isctx, smem);
        }
      }
    PH_END
    PH_BEGIN
      phase_rwkv_out(p, l, nrows);
    PH_END
    PH_BEGIN
      {
        pg8::PEpiBf16 e{(bf16_t*)(ws + OFF_YMIX), 1024, false};
        pg8::Gemm g{(const bf16_t*)(ws + OFF_OUTS), (const bf16_t*)(ws + OFF_WOUT), NLAT, 1024, 1024, 1024}; pg8::StaticOrder S; S.init(NLAT, 1024, (int)gridDim.x, obid());
        pg8::gemm_phase<pg8::PEpiBf16, pg8::StaticOrder, true, true>((PG8_LAS unsigned char*)smem, g, S, e);
      }
      if (!last) {
        const int idx = obid(), u = idx >> 2, ks = idx & 3;
        pg8::PieceOrder S{64 + (u >> 2), u & 3, idx < 32};
        pg8::PEpiF32 e{(float*)(ws + OFF_SLAB1) + (size_t)ks * NCTX * 1024 - (size_t)NLAT * 1024, 1024};
        pg8::Gemm g{(const bf16_t*)(ws + OFF_OUTS) + ks * 256, (const bf16_t*)(ws + OFF_WOUT) + ks * 256, NT, 1024, 256, 1024};
        pg8::gemm_phase<pg8::PEpiF32, pg8::PieceOrder, false, true>((PG8_LAS unsigned char*)smem, g, S, e);
      }
    PH_END
    PH_BEGIN
      const float* modl = mods + (size_t)l * 3 * 6144;
      phase_rows(p, nrows, (const bf16_t*)(ws + OFF_YMIX), l == 0 ? p.x : p.out, l == 0 ? p.ctx : XC, p.out, XC, modl, 2048, p.g_post_mix + l * 1024, true,
                 modl, 3072, 4096, p.g_pre_mlp + l * 1024, (bf16_t*)(ws + OFF_H2), (const float*)(ws + OFF_SLAB1), last ? 0 : 4);
    PH_END
    PH_BEGIN
      pg8::PEpiBf16 e{(bf16_t*)(ws + OFF_U), 4096, true};
      pg8::Gemm g{(const bf16_t*)(ws + OFF_H2), (const bf16_t*)(ws + OFF_W1), nrows, 4096, 1024, 1024}; pg8::StaticOrder S; S.init(nrows, 4096, (int)gridDim.x, obid());
      pg8::gemm_phase<pg8::PEpiBf16, pg8::StaticOrder, true, true>((PG8_LAS unsigned char*)smem, g, S, e);
    PH_END
    PH_BEGIN
      {
        pg8::PEpiBf16 e{(bf16_t*)(ws + OFF_Y2), 1024, false};
        pg8::Gemm g{(const bf16_t*)(ws + OFF_U), (const bf16_t*)(ws + OFF_W2), NLAT, 1024, 4096, 4096}; pg8::StaticOrder S; S.init(NLAT, 1024, (int)gridDim.x, obid());
        pg8::gemm_phase<pg8::PEpiBf16, pg8::StaticOrder, true, true>((PG8_LAS unsigned char*)smem, g, S, e);
      }
      if (!last) {
        const int idx = obid(), u = idx >> 3, ks = idx & 7;
        pg8::PieceOrder S{64 + (u >> 2), u & 3, idx < 64};
        pg8::PEpiF32 e{(float*)(ws + OFF_SLAB2) + (size_t)ks * NCTX * 1024 - (size_t)NLAT * 1024, 1024};
        pg8::Gemm g{(const bf16_t*)(ws + OFF_U) + ks * 512, (const bf16_t*)(ws + OFF_W2) + ks * 512, NT, 1024, 512, 4096};
        pg8::gemm_phase<pg8::PEpiF32, pg8::PieceOrder, false, true>((PG8_LAS unsigned char*)smem, g, S, e);
      }
    PH_END
    PH_BEGIN
      if (!last) phase_convert(p, l + 1, smem);
      const float* modl = mods + (size_t)l * 3 * 6144;
      phase_rows(p, nrows, (const bf16_t*)(ws + OFF_Y2), p.out, XC, p.out, XC, modl, 5120, p.g_post_mlp + l * 1024, !last,
                 mods + (size_t)(l + 1) * 3 * 6144, 0, 1024, p.g_pre_mix + (last ? 0 : (l + 1) * 1024), H, (const float*)(ws + OFF_SLAB2), last ? 0 : 8);
    }
    if (last) break;
    XBAR();
    if (otid() == 0) *s_layer = l + 1;
    __syncthreads();
  }
}

extern "C" void kernel_launch(void* const* d_in, const int* in_sizes, int n_in, void* d_out, int out_size, void* d_ws, size_t ws_size,
                              hipStream_t stream) {
  static int grid_blocks = 0;
  if (grid_blocks == 0) {
    if (n_in != 32 || ws_size < WS_NEED) { fprintf(stderr, "kernel_launch: unexpected n_in %d / ws_size %zu\n", n_in, ws_size); grid_blocks = -1; return; }
    int dev = 0, cus = 0, per_cu = 0;
    hipGetDevice(&dev);
    hipDeviceGetAttribute(&cus, hipDeviceAttributeMultiprocessorCount, dev);
    hipFuncSetAttribute((const void*)fwd_megakernel, hipFuncAttributeMaxDynamicSharedMemorySize, LDS_BYTES);
    hipOccupancyMaxActiveBlocksPerMultiprocessor(&per_cu, (const void*)fwd_megakernel, THREADS, LDS_BYTES);
    if (per_cu < 1) { fprintf(stderr, "kernel_launch: occupancy query says %d blocks per CU\n", per_cu); grid_blocks = -1; return; }
    grid_blocks = cus;
  }
  if (grid_blocks < 0) return;
  hipMemsetAsync((char*)d_ws + OFF_CTL, 0, 65536, stream);
  Params p{};
  const float** pp = (const float**)&p;
  for (int i = 0; i < 32; ++i) pp[i] = (const float*)d_in[i];
  p.out = (float*)d_out;
  p.ws = (char*)d_ws;
  void* args[] = {&p};
  hipError_t e = hipLaunchCooperativeKernel((const void*)fwd_megakernel, dim3(grid_blocks), dim3(THREADS), args, LDS_BYTES, stream);
  if (e != hipSuccess) fprintf(stderr, "cooperative launch failed: %s (grid %d)\n", hipGetErrorString(e), grid_blocks);
}
```

```cpp
#include <hip/hip_runtime.h>
#include <hip/hip_cooperative_groups.h>
#include <cstdio>
#include <cstdint>
namespace cg = cooperative_groups;

typedef unsigned short bf16_t;
using bf16x8 = __attribute__((ext_vector_type(8))) short;
using f32x16 = __attribute__((ext_vector_type(16))) float;
#define DI __device__ __forceinline__
#define MFMA32(a, b, c) __builtin_amdgcn_mfma_f32_32x32x16_bf16((a), (b), (c), 0, 0, 0)

constexpr int D_ = 1024, T_ = 8192, NLAT = 16384, NCTX = 512, NT = 16896, CTXL = 256;
constexpr int NWIN = 2816;
constexpr int IN_COLS = 2496, C_COLS = 1056, DFF = 4096;
constexpr int KEYS = 8448;
constexpr float EPS = 1e-6f, LOG2E = 1.4426950408889634f;
constexpr int THREADS = 512;
constexpr int LDS_MAIN = 151552;
constexpr int LDS_BYTES = LDS_MAIN + 64;

constexpr size_t MiB = 1048576;
constexpr size_t OFF_CTL = 0;
constexpr size_t OFF_MODS = 65536;
constexpr size_t OFF_INVN = 262144;
constexpr size_t OFF_XC = 1 * MiB;
constexpr size_t OFF_W = 3 * MiB;
constexpr size_t OFF_WIN = OFF_W;
constexpr size_t OFF_WOUT = OFF_WIN + (size_t)NWIN * 1024 * 2;
constexpr size_t OFF_W1 = OFF_WOUT + (size_t)1024 * 1024 * 2;
constexpr size_t OFF_W2 = OFF_W1 + (size_t)4096 * 1024 * 2;
constexpr size_t OFF_WUQ = OFF_W2 + (size_t)4096 * 1024 * 2;
constexpr size_t OFF_WUKV = OFF_WUQ + 384 * 256 * 2;
constexpr size_t OFF_WW2 = OFF_WUKV + 512 * 128 * 2;
constexpr size_t OFF_WA2 = OFF_WW2 + 2 * 256 * 64 * 2;
constexpr size_t OFF_WG2 = OFF_WA2 + 2 * 256 * 64 * 2;
constexpr size_t OFF_R = 27 * MiB + MiB / 8;
constexpr size_t EIGHTH = MiB / 8;
constexpr size_t OFF_H = OFF_R;
constexpr size_t OFF_BQ = OFF_R;
constexpr size_t OFF_BK = OFF_R + 99 * EIGHTH;
constexpr size_t OFF_VTB = OFF_R + 198 * EIGHTH;
constexpr size_t OFF_ZA = OFF_R + 33 * MiB;
constexpr size_t OFF_ZD = OFF_ZA + 132 * EIGHTH;
constexpr size_t OFF_ZB = OFF_ZD + 132 * EIGHTH;
constexpr size_t OFF_ZC = OFF_ZB + 132 * EIGHTH;
constexpr size_t OFF_OUTS = OFF_ZC;
constexpr size_t OFF_SCANIN = OFF_ZC + 297 * EIGHTH;
constexpr size_t OFF_G = OFF_SCANIN + 462 * EIGHTH;
constexpr size_t OFF_Y = OFF_G + 66 * EIGHTH;
constexpr size_t OFF_TMPW = OFF_Y;
constexpr size_t OFF_TMPA = OFF_TMPW + (size_t)NT * 64 * 2;
constexpr size_t OFF_TMPG = OFF_TMPA + (size_t)NT * 64 * 2;
constexpr size_t OFF_VTA = OFF_Y + 33 * MiB;
constexpr size_t OFF_VTD = OFF_VTA + 33 * EIGHTH;
constexpr size_t OFF_YMIX = OFF_R;
constexpr size_t OFF_H2 = 223 * MiB;
constexpr size_t OFF_U = OFF_R;
constexpr size_t OFF_Y2 = OFF_R + 132 * MiB;
constexpr size_t OFF_SLAB1 = OFF_ZB;
constexpr size_t OFF_SLAB2 = 226 * MiB;
constexpr size_t WS_NEED = 256 * MiB;
static_assert(OFF_VTD + 33 * EIGHTH <= 256 * MiB, "ws");
static_assert(OFF_Y2 + (size_t)NT * 1024 * 4 <= 256 * MiB && OFF_H2 + (size_t)NT * 1024 * 2 <= 256 * MiB, "ws2");
static_assert(OFF_WG2 + 256 * 192 * 2 <= OFF_R, "ws w");

struct Params {
  const float *x, *c, *ctx, *c_ctx, *w_mod, *b_mod, *g_pre_mix, *g_post_mix, *g_pre_mlp, *g_post_mlp, *w_in,
      *gqa_q_norm, *gqa_k_norm, *mla_q_norm, *mla_kv_norm, *mla_w_uq, *mla_w_ukv, *rwkv_mu, *rwkv_w0, *rwkv_w2,
      *rwkv_a0, *rwkv_a2, *rwkv_k_k, *rwkv_k_a, *rwkv_r_k, *rwkv_g2, *rwkv_ln_w, *rwkv_ln_b, *swa_sink, *w_out,
      *w_mlp1, *w_mlp2;
  float* out;
  char* ws;
};

DI int obid() { int b = blockIdx.x; asm volatile("" : "+s"(b)); return b; }
DI int otid() { int t = threadIdx.x; asm volatile("" : "+v"(t)); return t; }
DI float bf2f(bf16_t b) { return __uint_as_float(((unsigned)b) << 16); }
typedef __bf16 bf2v_t __attribute__((ext_vector_type(2)));
typedef float f2v_t __attribute__((ext_vector_type(2)));
DI unsigned pack2(float a, float b) { f2v_t f = {a, b}; bf2v_t r = __builtin_convertvector(f, bf2v_t); return __builtin_bit_cast(unsigned, r); }
DI bf16_t f2bf(float x) { return (bf16_t)(pack2(x, 0.f) & 0xffffu); }
DI void st4bf(bf16_t* p, float a, float b, float c, float d) { uint2 v; v.x = pack2(a, b); v.y = pack2(c, d); *(uint2*)p = v; }
DI float wave_sum_slow(float v) {
#pragma unroll
  for (int o = 32; o > 0; o >>= 1) v += __shfl_xor(v, o);
  return v;
}
DI float fexp2(float x) { return __builtin_amdgcn_exp2f(x); }
DI float fexp(float x) { return __builtin_amdgcn_exp2f(x * LOG2E); }
DI float frcp(float x) { return __builtin_amdgcn_rcpf(x); }
DI float sigmoidf_(float x) { return frcp(1.f + fexp(-x)); }
DI float frsqrt(float x) { return __builtin_amdgcn_rsqf(x); }
DI int key_of_row(int m) { return m < NLAT ? (m & (T_ - 1)) : T_ + ((m - NLAT) & (CTXL - 1)); }
DI int batch_of_row(int m) { return m < NLAT ? (m >> 13) : ((m - NLAT) >> 8); }
DI int mods_slot(int m) { return m < NLAT ? (m >> 13) : 2; }
template <int CTRL> DI float dpp_mov(float v) {
  return __builtin_bit_cast(float, __builtin_amdgcn_update_dpp(0, __builtin_bit_cast(int, v), CTRL, 0xf, 0xf, false));
}
DI float allreduce16(float v) {
  v += dpp_mov<0x128>(v);
  v += dpp_mov<0x124>(v);
  v += dpp_mov<0x122>(v);
  v += dpp_mov<0x121>(v);
  return v;
}
DI float wave_sum(float v) {
  v = allreduce16(v);
  { const auto sw = __builtin_amdgcn_permlane32_swap(__float_as_uint(v), __float_as_uint(v), false, false); v = __uint_as_float(sw[0]) + __uint_as_float(sw[1]); }
  v += __shfl_xor(v, 16);
  return v;
}

DI void phase_mods(const Params& p, char* smem) {
  float* s_silu = (float*)smem;
  float* s_red = s_silu + 3 * 1024;
  const int tid = otid(), lane = tid & 63, wave = tid >> 6;
  for (int i = tid; i < 3 * 1024; i += THREADS) {
    int sI = i >> 10, k = i & 1023;
    float v = (sI < 2) ? p.c[sI * 1024 + k] : p.c_ctx[k];
    s_silu[i] = v * sigmoidf_(v);
  }
  __syncthreads();
  float* mods = (float*)(p.ws + OFF_MODS);
  for (int item = obid(); item < 192; item += gridDim.x) {
    const int l = item / 96, n0 = (item % 96) * 64;
    float a0 = 0.f, a1 = 0.f, a2 = 0.f;
    const float* w = p.w_mod + (size_t)l * 1024 * 6144 + (size_t)(wave * 128) * 6144 + n0 + lane;
#pragma unroll 16
    for (int kk = 0; kk < 128; ++kk) {
      const int k = wave * 128 + kk;
      const float wv = __builtin_nontemporal_load(&w[(size_t)kk * 6144]);
      a0 += s_silu[k] * wv; a1 += s_silu[1024 + k] * wv; a2 += s_silu[2048 + k] * wv;
    }
    s_red[(wave * 3 + 0) * 64 + lane] = a0; s_red[(wave * 3 + 1) * 64 + lane] = a1; s_red[(wave * 3 + 2) * 64 + lane] = a2;
    __syncthreads();
    if (tid < 192) {
      const int sI = tid >> 6, j = tid & 63;
      float acc = p.b_mod[l * 6144 + n0 + j];
#pragma unroll
      for (int w8 = 0; w8 < 8; ++w8) acc += s_red[(w8 * 3 + sI) * 64 + j];
      mods[(size_t)(l * 3 + sI) * 6144 + n0 + j] = acc;
    }
    __syncthreads();
  }
}

struct RowMapId { DI int operator()(int n) const { return n; } };
struct RowMapWin { DI int operator()(int n) const { return n < 512 ? n : (n < 928 ? n : (n < 1984 ? n + 96 : n + 320)); } };
template <class RM>
DI void conv_T(const float* __restrict__ src, int K, int N, bf16_t* __restrict__ dst, int ldd, int Kpad, RM rm, int& rot, char* smem) {
  float* tile = (float*)smem;
  const int tid = otid(), G = gridDim.x;
  const int kt_n = Kpad >> 6, nt_n = N >> 6, total = kt_n * nt_n;
  int first = (int)((obid() + G - (rot % G)) % G);
  const int lk = tid >> 4, ln4 = (tid & 15) * 4;
  const int sn = tid >> 3, sk8 = (tid & 7) * 8;
  for (int t = first; t < total; t += G) {
    const int k0 = (t / nt_n) << 6, n0 = (t % nt_n) << 6;
    float4 v0 = make_float4(0.f, 0.f, 0.f, 0.f), v1 = make_float4(0.f, 0.f, 0.f, 0.f);
    { typedef float f4v_t __attribute__((ext_vector_type(4)));
      if (k0 + lk < K) { const f4v_t t_ = __builtin_nontemporal_load((const f4v_t*)(src + (size_t)(k0 + lk) * N + n0 + ln4)); v0 = make_float4(t_.x, t_.y, t_.z, t_.w); }
      if (k0 + lk + 32 < K) { const f4v_t t_ = __builtin_nontemporal_load((const f4v_t*)(src + (size_t)(k0 + lk + 32) * N + n0 + ln4)); v1 = make_float4(t_.x, t_.y, t_.z, t_.w); } }
    *(float4*)(tile + lk * 68 + ln4) = v0;
    *(float4*)(tile + (lk + 32) * 68 + ln4) = v1;
    __syncthreads();
    float f[8];
#pragma unroll
    for (int e = 0; e < 8; ++e) f[e] = tile[(sk8 + e) * 68 + sn];
    *(uint4*)(dst + (size_t)rm(n0 + sn) * ldd + k0 + sk8) = make_uint4(pack2(f[0], f[1]), pack2(f[2], f[3]), pack2(f[4], f[5]), pack2(f[6], f[7]));
    __syncthreads();
  }
  rot += total;
}
DI void phase_convert(const Params& p, int l, char* smem) {
  char* ws = p.ws;
  int rot = 0;
  conv_T(p.w_in + (size_t)l * 1024 * IN_COLS, 1024, IN_COLS, (bf16_t*)(ws + OFF_WIN), 1024, 1024, RowMapWin(), rot, smem);
  conv_T(p.w_out + (size_t)l * 1024 * 1024, 1024, 1024, (bf16_t*)(ws + OFF_WOUT), 1024, 1024, RowMapId(), rot, smem);
  conv_T(p.w_mlp1 + (size_t)l * 1024 * 4096, 1024, 4096, (bf16_t*)(ws + OFF_W1), 1024, 1024, RowMapId(), rot, smem);
  conv_T(p.w_mlp2 + (size_t)l * 4096 * 1024, 4096, 1024, (bf16_t*)(ws + OFF_W2), 4096, 4096, RowMapId(), rot, smem);
  conv_T(p.mla_w_uq + (size_t)l * 256 * 384, 256, 384, (bf16_t*)(ws + OFF_WUQ), 256, 256, RowMapId(), rot, smem);
  conv_T(p.mla_w_ukv + (size_t)l * 128 * 512, 128, 512, (bf16_t*)(ws + OFF_WUKV), 128, 128, RowMapId(), rot, smem);
  for (int d = 0; d < 2; ++d) {
    conv_T(p.rwkv_w2 + (size_t)(l * 2 + d) * 64 * 256, 64, 256, (bf16_t*)(ws + OFF_WW2) + d * 256 * 64, 64, 64, RowMapId(), rot, smem);
    conv_T(p.rwkv_a2 + (size_t)(l * 2 + d) * 64 * 256, 64, 256, (bf16_t*)(ws + OFF_WA2) + d * 256 * 64, 64, 64, RowMapId(), rot, smem);
  }
  conv_T(p.rwkv_g2 + (size_t)l * 160 * 256, 160, 256, (bf16_t*)(ws + OFF_WG2), 192, 192, RowMapId(), rot, smem);
}

DI void phase_rows(const Params& p, int nrows, const bf16_t* __restrict__ y, const float* xl_src, const float* xc_src,
                   float* xl_dst, float* xc_dst, const float* mods_y, int gt_off, const float* __restrict__ gpost, bool do_h,
                   const float* mods_h, int sh_off, int sc_off, const float* __restrict__ gpre, bf16_t* hdst, const float* yslab = nullptr, int nslab = 0) {
  const int tid_ = otid(); const int lane = tid_ & 63, wave = tid_ >> 6;
  float4 gpo[4], gpr[4], gtv[4], scv[4], shv[4];
#pragma unroll
  for (int i = 0; i < 4; ++i) {
    const int c = i * 256 + lane * 4;
    gpo[i] = y ? *(const float4*)(gpost + c) : make_float4(0.f, 0.f, 0.f, 0.f);
    gpr[i] = do_h ? *(const float4*)(gpre + c) : make_float4(0.f, 0.f, 0.f, 0.f);
    gtv[i] = scv[i] = shv[i] = make_float4(0.f, 0.f, 0.f, 0.f);
  }
  int cur_slot = -1;
  for (int row = obid() * 8 + wave; row < nrows; row += gridDim.x * 8) {
    const int slot = mods_slot(row);
    const float* xs = row < NLAT ? xl_src + (size_t)row * 1024 : xc_src + (size_t)(row - NLAT) * 1024;
    float4 xv[4];
#pragma unroll
    for (int i = 0; i < 4; ++i) { typedef float f4v_t __attribute__((ext_vector_type(4))); const f4v_t t_ = __builtin_nontemporal_load((const f4v_t*)(xs + i * 256 + lane * 4)); xv[i] = make_float4(t_.x, t_.y, t_.z, t_.w); }
    if (slot != cur_slot) {
      cur_slot = slot;
#pragma unroll
      for (int i = 0; i < 4; ++i) {
        const int c = i * 256 + lane * 4;
        if (y) gtv[i] = *(const float4*)(mods_y + (size_t)slot * 6144 + gt_off + c);
        if (do_h) { scv[i] = *(const float4*)(mods_h + (size_t)slot * 6144 + sc_off + c); shv[i] = *(const float4*)(mods_h + (size_t)slot * 6144 + sh_off + c); }
      }
    }
    if (y) {
      float4 yv[4];
      float ss = 0.f;
#pragma unroll
      for (int i = 0; i < 4; ++i) {
        if (nslab > 0 && row >= NLAT) {
          float4 a = make_float4(0.f, 0.f, 0.f, 0.f);
          for (int sidx = 0; sidx < nslab; ++sidx) {
            const float4 t4 = *(const float4*)(yslab + ((size_t)sidx * NCTX + (row - NLAT)) * 1024 + i * 256 + lane * 4);
            a.x += t4.x; a.y += t4.y; a.z += t4.z; a.w += t4.w;
          }
          yv[i] = a;
        } else
        { typedef unsigned u2v_t __attribute__((ext_vector_type(2))); const u2v_t n_ = __builtin_nontemporal_load((const u2v_t*)(y + (size_t)row * 1024 + i * 256 + lane * 4)); const uint2 u_ = make_uint2(n_.x, n_.y);
          yv[i] = make_float4(__uint_as_float(u_.x << 16), __uint_as_float(u_.x & 0xffff0000u), __uint_as_float(u_.y << 16), __uint_as_float(u_.y & 0xffff0000u)); }
        ss += yv[i].x * yv[i].x + yv[i].y * yv[i].y + yv[i].z * yv[i].z + yv[i].w * yv[i].w;
      }
      ss = wave_sum(ss);
      const float rs = frsqrt(ss * (1.f / 1024.f) + EPS);
      float* xd = row < NLAT ? xl_dst + (size_t)row * 1024 : xc_dst + (size_t)(row - NLAT) * 1024;
#pragma unroll
      for (int i = 0; i < 4; ++i) {
        const int c = i * 256 + lane * 4;
        const float4 g = gpo[i], t = gtv[i];
        xv[i].x += t.x * (yv[i].x * rs * g.x); xv[i].y += t.y * (yv[i].y * rs * g.y);
        xv[i].z += t.z * (yv[i].z * rs * g.z); xv[i].w += t.w * (yv[i].w * rs * g.w);
        { typedef float f4v_t __attribute__((ext_vector_type(4))); const f4v_t t_ = {xv[i].x, xv[i].y, xv[i].z, xv[i].w}; __builtin_nontemporal_store(t_, (f4v_t*)(xd + c)); }
      }
    }
    if (do_h) {
      float ss = 0.f;
#pragma unroll
      for (int i = 0; i < 4; ++i) ss += xv[i].x * xv[i].x + xv[i].y * xv[i].y + xv[i].z * xv[i].z + xv[i].w * xv[i].w;
      ss = wave_sum(ss);
      const float rs = frsqrt(ss * (1.f / 1024.f) + EPS);
#pragma unroll
      for (int i = 0; i < 4; ++i) {
        const int c = i * 256 + lane * 4;
        const float4 g = gpr[i], a = scv[i], b = shv[i];
        st4bf(hdst + (size_t)row * 1024 + c, xv[i].x * rs * g.x * (1.f + a.x) + b.x, xv[i].y * rs * g.y * (1.f + a.y) + b.y,
              xv[i].z * rs * g.z * (1.f + a.z) + b.z, xv[i].w * rs * g.w * (1.f + a.w) + b.w);
      }
    }
  }
}

namespace pg8 {
#define PG8_LAS __attribute__((address_space(3)))
typedef unsigned short bf16_t;
typedef short bf16x8 __attribute__((ext_vector_type(8)));
typedef float f32x4 __attribute__((ext_vector_type(4)));
typedef unsigned u32x4 __attribute__((ext_vector_type(4)));
constexpr int BM = 256, BK = 64, HALF = 128, HTB = HALF * BK * 2  , STAGE_BYTES = 8 * HTB, NXCD = 8, WGM = 8;

__host__ __device__ __forceinline__ int lds_byte(int r, int c) { const int st = (r >> 4) * 2 + (c >> 5), rr = r & 15, cc = c & 31, ob = rr * 64 + cc * 2; return st * 1024 + (ob ^ (((ob >> 9) & 1) << 5)); }
__host__ __device__ __forceinline__ void stage_rc(int b, int& R, int& C) { const int st = b / 1024, sb = b % 1024, swz = sb ^ (((sb >> 9) & 1) << 5); R = (st >> 1) * 16 + swz / 64; C = (st & 1) * 32 + (swz % 64) / 2; }
__host__ __device__ __forceinline__ int perm32(int rho) { const int n = rho >> 4, i = rho & 15; return 8 * (i >> 2) + 4 * n + (i & 3); }

struct Unit { int pm, pn; };
struct Gemm { const bf16_t* A; const bf16_t* Bt; int M, N, K, ld; };

struct StaticOrder {
    int nM, nN, nwg, G, c;
    __host__ __device__ void init(int M, int N, int G_, int c_) { nM = M / BM; nN = N / BM; nwg = nM * nN; G = G_; c = c_; }
    __host__ __device__ bool next(int i, Unit& u) const {
        const long L = (long)i * G + c; if (L >= nwg) return false;
        int wgid = (int)L; { const int q = nwg / NXCD, r = nwg % NXCD, xcd = wgid % NXCD, off = wgid / NXCD; wgid = (xcd < r ? xcd * (q + 1) : r * (q + 1) + (xcd - r) * q) + off; }
        const int nig = WGM * nN, gid = wgid / nig, fm = gid * WGM, gsz = (nM - fm) < WGM ? (nM - fm) : WGM;
        u.pm = fm + ((wgid % nig) % gsz); u.pn = (wgid % nig) / gsz; return true;
    }
    __device__ __forceinline__ void a_ready(const Unit&) const {}
    __device__ __forceinline__ void done(const Unit&) const {}
};

struct PEpiBf16 {
    static constexpr bool PERM = true, AFTER_DRAIN = false;
    bf16_t* O; int ldc; bool sqrelu;
    __device__ __forceinline__ void operator()(const f32x4 (&acc)[2][2][4][2], const Unit& u, int wr, int wc, int fr, int fq) const {
        const int row0 = u.pm * BM + wr * 64 + fr, col0 = u.pn * BM + wc * 32 + 8 * fq;
#pragma unroll
        for (int ai = 0; ai < 2; ++ai)
#pragma unroll
            for (int m = 0; m < 4; ++m) { bf16_t* rowp = O + (size_t)(row0 + ai * HALF + m * 16) * ldc + col0;
#pragma unroll
                for (int bj = 0; bj < 2; ++bj) { f32x4 v0 = acc[ai][bj][m][0], v1 = acc[ai][bj][m][1];
                    if (sqrelu) { v0 = __builtin_elementwise_max(v0, (f32x4){0.f, 0.f, 0.f, 0.f}); v1 = __builtin_elementwise_max(v1, (f32x4){0.f, 0.f, 0.f, 0.f}); v0 = v0 * v0; v1 = v1 * v1; }
                    u32x4 w; w.x = ::pack2(v0[0], v0[1]); w.y = ::pack2(v0[2], v0[3]); w.z = ::pack2(v1[0], v1[1]); w.w = ::pack2(v1[2], v1[3]);
                    *(u32x4*)(rowp + bj * HALF) = w; } }
    }
};
struct PieceOrder {
    int pm, pn; bool have;
    __device__ __forceinline__ bool next(int i, Unit& u) const { if (i != 0 || !have) return false; u.pm = pm; u.pn = pn; return true; }
    __device__ __forceinline__ void a_ready(const Unit&) const {}
    __device__ __forceinline__ void done(const Unit&) const {}
};
struct WinCOrder {
    int G, c;
    __device__ __forceinline__ bool next(int i, Unit& u) const {
        const long L = (long)i * G + c; if (L >= 342) return false;
        if (L < 330) { u.pm = (int)(L / 5); u.pn = 4 + (int)(L % 5); }
        else { const int j = (int)L - 330, k6 = j % 6; u.pm = 64 + j / 6; u.pn = k6 < 4 ? k6 : k6 + 5; }
        return true; }
    __device__ __forceinline__ void a_ready(const Unit&) const {}
    __device__ __forceinline__ void done(const Unit&) const {}
};
struct PEpiF32 {
    static constexpr bool PERM = true, AFTER_DRAIN = false;
    float* O; int ldc;
    __device__ __forceinline__ void operator()(const f32x4 (&acc)[2][2][4][2], const Unit& u, int wr, int wc, int fr, int fq) const {
        const int row0 = u.pm * BM + wr * 64 + fr, col0 = u.pn * BM + wc * 32 + 8 * fq;
#pragma unroll
        for (int ai = 0; ai < 2; ++ai)
#pragma unroll
            for (int m = 0; m < 4; ++m) { float* rowp = O + (size_t)(row0 + ai * HALF + m * 16) * ldc + col0;
#pragma unroll
                for (int bj = 0; bj < 2; ++bj) { *(f32x4*)(rowp + bj * HALF) = acc[ai][bj][m][0]; *(f32x4*)(rowp + bj * HALF + 4) = acc[ai][bj][m][1]; } }
    }
};
struct PEpiWin {
    static constexpr bool PERM = true, AFTER_DRAIN = false;
    bf16_t *za, *zb, *zc, *zd, *vta, *vtd;
    __device__ __forceinline__ void operator()(const f32x4 (&acc)[2][2][4][2], const Unit& u, int wr, int wc, int fr, int fq) const {
        const int row0 = u.pm * BM + wr * 64 + fr;
#pragma unroll
        for (int bj = 0; bj < 2; ++bj) {
            const int pc = u.pn * BM + bj * HALF + wc * 32 + 8 * fq;
            bf16_t* dst; int col, ld; bf16_t* vt = nullptr; bool ok = true;
            if (pc < 512) { col = pc; dst = za; ld = 512; if (col >= 384) vt = vta; }
            else if (pc < 1024) { col = pc - 512; dst = zb; ld = 512; }
            else if (pc < 2304) { col = pc - 1024; dst = zc; ld = 1152; ok = col < 1152; }
            else { col = pc - 2304; dst = zd; ld = 512; if (col >= 384) vt = vtd; }
#pragma unroll
            for (int ai = 0; ai < 2; ++ai)
#pragma unroll
                for (int m = 0; m < 4; ++m) {
                    const int r = row0 + ai * HALF + m * 16;
                    const f32x4 v0 = acc[ai][bj][m][0], v1 = acc[ai][bj][m][1];
                    if (vt) {
                        bf16_t* base = vt + ((size_t)::batch_of_row(r) * 128 + (col - 384)) * KEYS + ::key_of_row(r);
                        base[0] = ::f2bf(v0[0]); base[(size_t)KEYS] = ::f2bf(v0[1]); base[(size_t)2 * KEYS] = ::f2bf(v0[2]); base[(size_t)3 * KEYS] = ::f2bf(v0[3]);
                        base[(size_t)4 * KEYS] = ::f2bf(v1[0]); base[(size_t)5 * KEYS] = ::f2bf(v1[1]); base[(size_t)6 * KEYS] = ::f2bf(v1[2]); base[(size_t)7 * KEYS] = ::f2bf(v1[3]);
                    } else if (ok) {
                        u32x4 w; w.x = ::pack2(v0[0], v0[1]); w.y = ::pack2(v0[2], v0[3]); w.z = ::pack2(v1[0], v1[1]); w.w = ::pack2(v1[2], v1[3]);
                        *(u32x4*)(dst + (size_t)r * ld + col) = w;
                    }
                }
        }
    }
};

template <class Epi, class Sched, bool ALIGN_EPI = false, bool SP2 = false>
__device__ __forceinline__ void gemm_phase(PG8_LAS unsigned char* lds, const Gemm g, const Sched& S, const Epi& E) {
    const int tid = otid(), wid = __builtin_amdgcn_readfirstlane(tid >> 6), lane = tid & 63, wr = wid >> 2, wc = wid & 3, fr = lane & 15, fq = lane >> 4;
    const int K = g.ld, nt = g.K / BK;
    unsigned voffA[2], voffB[2];
#pragma unroll
    for (int i = 0; i < 2; ++i) { int R, C; stage_rc(tid * 16 + i * 8192, R, C); const int Rb = Epi::PERM ? ((R & ~31) + perm32(R & 31)) : R;
        voffA[i] = (unsigned)(R * K + C) * 2u; voffB[i] = (unsigned)(Rb * K + C) * 2u; }
    const size_t kstep = (size_t)(BK * 2);
    const size_t hstep = (size_t)HALF * K * 2;
    const size_t tstep = 2 * hstep;
    const unsigned ldsw = (unsigned)wid * 1024u;
    const int aoff = lds_byte(wr * 64 + fr, fq * 8), boff = lds_byte(wc * 32 + fr, fq * 8);
#define PG8_SA(b, h) (((b) * 2 + (h)) * HTB)
#define PG8_SB(b, h) ((4 + (b) * 2 + (h)) * HTB)
#define PG8_STAGE(bufoff, gbase, voff) do { _Pragma("unroll") for (int _i = 0; _i < 2; ++_i) \
        __builtin_amdgcn_global_load_lds((const unsigned*)((const char*)(gbase) + (voff)[_i]), (PG8_LAS unsigned*)(lds + (bufoff) + ldsw + _i * 8192), 16, 0, 0); } while (0)
#define PG8_LDA(dst, b, h) do { _Pragma("unroll") for (int m = 0; m < 4; ++m) _Pragma("unroll") for (int k = 0; k < 2; ++k) dst[m][k] = *(const PG8_LAS bf16x8*)(lds + PG8_SA(b, h) + aoff + m * 2048 + k * 1024); } while (0)
#define PG8_LDB(dst, b, h) do { _Pragma("unroll") for (int n = 0; n < 2; ++n) _Pragma("unroll") for (int k = 0; k < 2; ++k) dst[n][k] = *(const PG8_LAS bf16x8*)(lds + PG8_SB(b, h) + boff + n * 2048 + k * 1024); } while (0)
#define PG8_MMA(ai, bj, At, Bt) do { __builtin_amdgcn_s_setprio(1); _Pragma("unroll") for (int m = 0; m < 4; ++m) _Pragma("unroll") for (int n = 0; n < 2; ++n) _Pragma("unroll") for (int k = 0; k < 2; ++k) \
        acc[ai][bj][m][n] = __builtin_amdgcn_mfma_f32_16x16x32_bf16(Bt[n][k], At[m][k], acc[ai][bj][m][n], 0, 0, 0); __builtin_amdgcn_s_setprio(0); } while (0)
#define PG8_WAIT_V(n) asm volatile("s_waitcnt vmcnt(" #n ")" ::: "memory")
#define PG8_WAIT_L(n) asm volatile("s_waitcnt lgkmcnt(" #n ")" ::: "memory")
#define PG8_BAR __builtin_amdgcn_s_barrier()
#define PG8_SCHED __builtin_amdgcn_sched_barrier(0)
    Unit cur, nxt; int ui = 0;
    if (!S.next(0, cur)) return;
    f32x4 acc[2][2][4][2];
#pragma unroll
    for (int a = 0; a < 2; ++a)
#pragma unroll
        for (int b = 0; b < 2; ++b)
#pragma unroll
            for (int m = 0; m < 4; ++m)
#pragma unroll
                for (int n = 0; n < 2; ++n) acc[a][b][m][n] = (f32x4){0.f, 0.f, 0.f, 0.f};
    bf16x8 At[4][2], B0[2][2], B1[2][2];
    const char* cA = (const char*)g.A + (size_t)cur.pm * tstep; const char* cB = (const char*)g.Bt + (size_t)cur.pn * tstep;
    S.a_ready(cur);
    if constexpr (SP2) {
        PG8_STAGE(PG8_SB(0, 0), cB, voffB); PG8_STAGE(PG8_SB(0, 1), cB + hstep, voffB); PG8_STAGE(PG8_SA(0, 0), cA, voffA); PG8_STAGE(PG8_SA(0, 1), cA + hstep, voffA);
        if (wr == 1) PG8_BAR;
        PG8_WAIT_V(2); PG8_BAR;
        PG8_STAGE(PG8_SB(1, 0), cB + kstep, voffB); PG8_STAGE(PG8_SA(1, 0), cA + kstep, voffA); PG8_STAGE(PG8_SB(1, 1), cB + hstep + kstep, voffB);
        PG8_WAIT_V(6); PG8_BAR;
    } else {
        PG8_STAGE(PG8_SB(0, 0), cB, voffB); PG8_STAGE(PG8_SA(0, 0), cA, voffA); PG8_STAGE(PG8_SB(0, 1), cB + hstep, voffB); PG8_STAGE(PG8_SA(0, 1), cA + hstep, voffA);
        if (wr == 1) PG8_BAR;
        PG8_WAIT_V(4); PG8_BAR;
        PG8_STAGE(PG8_SB(1, 0), cB + kstep, voffB); PG8_STAGE(PG8_SA(1, 0), cA + kstep, voffA); PG8_STAGE(PG8_SB(1, 1), cB + hstep + kstep, voffB);
        PG8_WAIT_V(6); PG8_BAR;
    }
    for (;;) {
        const bool has_next = S.next(ui + 1, nxt);
        const char* nA = has_next ? (const char*)g.A + (size_t)nxt.pm * tstep : cA; const char* nB = has_next ? (const char*)g.Bt + (size_t)nxt.pn * tstep : cB;
        for (int t = 0; t < nt; t += 2) {
            const bool last = (t == nt - 2);
            const char* a1 = cA + (size_t)(t + 1) * kstep;
            const char* a2 = last ? nA : cA + (size_t)(t + 2) * kstep; const char* b2 = last ? nB : cB + (size_t)(t + 2) * kstep;
            const char* a3 = a2 + kstep; const char* b3 = b2 + kstep;
            if (last && has_next) S.a_ready(nxt);
            if constexpr (SP2) {
            PG8_LDB(B0, 0, 0); PG8_LDB(B1, 0, 1); PG8_SCHED; PG8_LDA(At, 0, 0); PG8_STAGE(PG8_SA(1, 1), a1 + hstep, voffA);
            PG8_WAIT_V(8); PG8_WAIT_L(0); PG8_BAR; PG8_MMA(0, 0, At, B0); PG8_MMA(0, 1, At, B1); PG8_BAR; PG8_SCHED;
            PG8_LDA(At, 0, 1); PG8_STAGE(PG8_SB(0, 0), b2, voffB); PG8_STAGE(PG8_SB(0, 1), b2 + hstep, voffB); PG8_STAGE(PG8_SA(0, 0), a2, voffA);
            PG8_WAIT_V(8); PG8_WAIT_L(0); PG8_BAR; PG8_MMA(1, 0, At, B0); PG8_MMA(1, 1, At, B1); PG8_BAR; PG8_SCHED;
            PG8_LDB(B0, 1, 0); PG8_LDB(B1, 1, 1); PG8_SCHED; PG8_LDA(At, 1, 0); PG8_STAGE(PG8_SA(0, 1), a2 + hstep, voffA);
            PG8_WAIT_V(8); PG8_WAIT_L(0); PG8_BAR; PG8_MMA(0, 0, At, B0); PG8_MMA(0, 1, At, B1); PG8_BAR; PG8_SCHED;
            PG8_LDA(At, 1, 1); PG8_STAGE(PG8_SB(1, 0), b3, voffB); PG8_STAGE(PG8_SB(1, 1), b3 + hstep, voffB); PG8_STAGE(PG8_SA(1, 0), a3, voffA);
            PG8_WAIT_V(8); PG8_WAIT_L(0); PG8_BAR; PG8_MMA(1, 0, At, B0); PG8_MMA(1, 1, At, B1); PG8_BAR; PG8_SCHED;
            } else {
            PG8_LDB(B0, 0, 0); PG8_SCHED; PG8_LDA(At, 0, 0); PG8_STAGE(PG8_SA(1, 1), a1 + hstep, voffA);
            PG8_WAIT_L(8); PG8_BAR; PG8_WAIT_L(0); PG8_MMA(0, 0, At, B0); PG8_BAR; PG8_SCHED;
            PG8_LDB(B1, 0, 1); PG8_STAGE(PG8_SB(0, 0), b2, voffB);
            PG8_BAR; PG8_WAIT_L(0); PG8_MMA(0, 1, At, B1); PG8_BAR;
            PG8_LDA(At, 0, 1); PG8_STAGE(PG8_SA(0, 0), a2, voffA);
            PG8_BAR; PG8_WAIT_L(0); PG8_MMA(1, 0, At, B0); PG8_BAR; PG8_SCHED;
            PG8_STAGE(PG8_SB(0, 1), b2 + hstep, voffB);
            PG8_WAIT_V(6); PG8_BAR; PG8_MMA(1, 1, At, B1); PG8_BAR;
            PG8_LDB(B0, 1, 0); PG8_SCHED; PG8_LDA(At, 1, 0); PG8_STAGE(PG8_SA(0, 1), a2 + hstep, voffA);
            PG8_WAIT_L(8); PG8_BAR; PG8_WAIT_L(0); PG8_MMA(0, 0, At, B0); PG8_BAR; PG8_SCHED;
            PG8_LDB(B1, 1, 1); PG8_STAGE(PG8_SB(1, 0), b3, voffB);
            PG8_BAR; PG8_WAIT_L(0); PG8_MMA(0, 1, At, B1); PG8_BAR;
            PG8_LDA(At, 1, 1); PG8_STAGE(PG8_SA(1, 0), a3, voffA);
            PG8_BAR; PG8_WAIT_L(0); PG8_MMA(1, 0, At, B0); PG8_BAR; PG8_SCHED;
            PG8_STAGE(PG8_SB(1, 1), b3 + hstep, voffB);
            PG8_WAIT_V(6); PG8_BAR; PG8_MMA(1, 1, At, B1); PG8_BAR;
            }
        }
        if constexpr (ALIGN_EPI) { if (wr == 0) PG8_BAR; }
        if constexpr (!Epi::AFTER_DRAIN) { E(acc, cur, wr, wc, fr, fq); S.done(cur); }
        if (!has_next) break;
#pragma unroll
        for (int a = 0; a < 2; ++a)
#pragma unroll
            for (int b = 0; b < 2; ++b)
#pragma unroll
                for (int m = 0; m < 4; ++m)
#pragma unroll
                    for (int n = 0; n < 2; ++n) acc[a][b][m][n] = (f32x4){0.f, 0.f, 0.f, 0.f};
        cur = nxt; cA = nA; cB = nB; ++ui;
        if constexpr (ALIGN_EPI) { if (wr == 1) PG8_BAR; }
    }
    PG8_WAIT_V(0);
    if constexpr (!ALIGN_EPI) { if (wr == 0) PG8_BAR; }
    PG8_BAR;
    if constexpr (Epi::AFTER_DRAIN) { E.fused(acc, cur, wr, wc, fr, fq, lds, wid, lane); S.done(cur); }
#undef PG8_SA
#undef PG8_SB
#undef PG8_STAGE
#undef PG8_LDA
#undef PG8_LDB
#undef PG8_MMA
#undef PG8_WAIT_V
#undef PG8_WAIT_L
#undef PG8_BAR
#undef PG8_SCHED
}
}
template <class Epi>
DI void gemm_small_tile(const bf16_t* __restrict__ A, int lda, const bf16_t* __restrict__ W, int ldw, int mt, int nt, int K, char* smem, Epi epi) {
  bf16_t* As = (bf16_t*)smem;
  bf16_t* Bs = As + 2 * 256 * 72;
  const int tid = otid(), lane = tid & 63, wave = tid >> 6;
  const int wm = wave >> 1, wn = wave & 1, l = lane & 31, h = lane >> 5;
  const int nk = K >> 6;
  {
    const int m0 = mt * 256, n0 = nt * 128;
    f32x16 acc[2][2];
#pragma unroll
    for (int i = 0; i < 2; ++i)
#pragma unroll
      for (int j = 0; j < 2; ++j)
#pragma unroll
        for (int q = 0; q < 16; ++q) acc[i][j][q] = 0.f;
    uint4 sA0, sA1, sA2, sA3, sA4, sA5, sB0, sB1, sB2, sB3, sB4, sB5;
    const bf16_t* ap[4];
    const bf16_t* bp[2];
    int aoff[4], boff[2];
#pragma unroll
    for (int i = 0; i < 4; ++i) {
      int c = tid + THREADS * i, row = c >> 3, kc = c & 7;
      ap[i] = A + (size_t)(m0 + row) * lda + kc * 8;
      aoff[i] = row * 72 + kc * 8;
    }
#pragma unroll
    for (int i = 0; i < 2; ++i) {
      int c = tid + THREADS * i, row = c >> 3, kc = c & 7;
      bp[i] = W + (size_t)(n0 + row) * ldw + kc * 8;
      boff[i] = row * 72 + kc * 8;
    }
    const bf16_t* Ab = As + (wm * 64 + l) * 72 + 8 * h;
    const bf16_t* Bb = Bs + (wn * 64 + l) * 72 + 8 * h;
#define G_LOAD(P, KT) { const int k1_ = (KT) << 6; P##0 = *(const uint4*)(ap[0] + k1_); P##1 = *(const uint4*)(ap[1] + k1_); P##2 = *(const uint4*)(ap[2] + k1_); \
                        P##3 = *(const uint4*)(ap[3] + k1_); P##4 = *(const uint4*)(bp[0] + k1_); P##5 = *(const uint4*)(bp[1] + k1_); }
#define G_STORE(P, BUF) { *(uint4*)(As + (BUF) * 256 * 72 + aoff[0]) = P##0; *(uint4*)(As + (BUF) * 256 * 72 + aoff[1]) = P##1; *(uint4*)(As + (BUF) * 256 * 72 + aoff[2]) = P##2; \
                          *(uint4*)(As + (BUF) * 256 * 72 + aoff[3]) = P##3; *(uint4*)(Bs + (BUF) * 128 * 72 + boff[0]) = P##4; *(uint4*)(Bs + (BUF) * 128 * 72 + boff[1]) = P##5; }
#define G_COMPUTE(BUF) { _Pragma("unroll") for (int ks = 0; ks < 4; ++ks) { bf16x8 af[2], bfr[2]; \
        af[0] = *(const bf16x8*)(Ab + (BUF) * 256 * 72 + ks * 16); af[1] = *(const bf16x8*)(Ab + (BUF) * 256 * 72 + 32 * 72 + ks * 16); \
        bfr[0] = *(const bf16x8*)(Bb + (BUF) * 128 * 72 + ks * 16); bfr[1] = *(const bf16x8*)(Bb + (BUF) * 128 * 72 + 32 * 72 + ks * 16); \
        _Pragma("unroll") for (int i = 0; i < 2; ++i) _Pragma("unroll") for (int j = 0; j < 2; ++j) acc[i][j] = MFMA32(bfr[j], af[i], acc[i][j]); } }
    G_LOAD(sA, 0);
    sB0 = sA0; sB1 = sA1; sB2 = sA2; sB3 = sA3; sB4 = sA4; sB5 = sA5;
    if (nk > 1) G_LOAD(sB, 1);
    for (int kt = 0; kt < nk; kt += 2) {
      G_STORE(sA, 0);
      __syncthreads();
      if (kt + 2 < nk) G_LOAD(sA, kt + 2);
      G_COMPUTE(0);
      if (kt + 1 < nk) {
        G_STORE(sB, 1);
        __syncthreads();
        if (kt + 3 < nk) G_LOAD(sB, kt + 3);
        G_COMPUTE(1);
      }
    }
    __syncthreads();
#pragma unroll
    for (int i = 0; i < 2; ++i)
#pragma unroll
      for (int j = 0; j < 2; ++j) epi(m0 + wm * 64 + 32 * i + l, n0 + wn * 64 + 32 * j, h, acc[i][j]);
  }
#undef G_LOAD
#undef G_STORE
#undef G_COMPUTE
}
template <class Epi>
DI void gemm_small(const bf16_t* __restrict__ A, int lda, const bf16_t* __restrict__ W, int ldw, int mtiles, int ntiles, int K,
                   int& rot, char* smem, Epi epi) {
  const int G = gridDim.x, total = mtiles * ntiles;
  const int vcu = (G % 8 == 0) ? (obid() % 8) * (G / 8) + obid() / 8 : obid();
  int first = (int)((vcu + G - (rot % G)) % G);
#pragma unroll 1
  for (int tile = first; tile < total; tile += G) {
    const int mt = tile / ntiles, nt = tile - mt * ntiles;
    gemm_small_tile(A, lda, W, ldw, mt, nt, K, smem, epi);
  }
  rot += total;
}

struct EpiUq {
  bf16_t* bq;
  DI void operator()(int m, int nbase, int h, const f32x16& a) const {
    const float qs = 0.10206207261596577f * LOG2E;
    const bool rope = ((nbase % 96) == 64) && (m < NLAT);
    float o[16];
    if (rope) {
      const int t = m & (T_ - 1);
#pragma unroll
      for (int g = 0; g < 4; ++g) {
        const float pos = (g >> 1) ? (float)(t & 63) : (float)(t >> 6);
#pragma unroll
        for (int c = 0; c < 4; ++c) {
          const int fi = 4 * h + c;
          const float inv = fexp2(-(float)fi * (13.287712379549449f / 8.f));
          const float rev = pos * inv * 0.15915494309189535f;
          const float sn = __builtin_amdgcn_sinf(rev), cs = __builtin_amdgcn_cosf(rev);
          const float own = a[4 * g + c], par = a[4 * (g ^ 1) + c];
          o[4 * g + c] = (g & 1) ? (par * sn + own * cs) : (own * cs - par * sn);
        }
      }
    } else {
#pragma unroll
      for (int q = 0; q < 16; ++q) o[q] = a[q];
    }
    bf16_t* dst = bq + (size_t)m * 384 + nbase + 4 * h;
#pragma unroll
    for (int g = 0; g < 4; ++g) st4bf(dst + 8 * g, o[4 * g] * qs, o[4 * g + 1] * qs, o[4 * g + 2] * qs, o[4 * g + 3] * qs);
  }
};
struct EpiUkv {
  bf16_t *bk, *vtb;
  DI void operator()(int m, int nbase, int h, const f32x16& a) const {
    const int head = nbase >> 7, dd = nbase & 127;
    if (dd < 64) {
      bf16_t* dst = bk + (size_t)m * 384 + head * 96 + dd + 4 * h;
#pragma unroll
      for (int g = 0; g < 4; ++g) st4bf(dst + 8 * g, a[4 * g], a[4 * g + 1], a[4 * g + 2], a[4 * g + 3]);
    } else {
      const int b = batch_of_row(m), key = key_of_row(m);
      bf16_t* base = vtb + ((size_t)b * 256 + head * 64 + (dd - 64)) * KEYS + key;
#pragma unroll
      for (int g = 0; g < 4; ++g)
#pragma unroll
        for (int c = 0; c < 4; ++c) base[(size_t)(8 * g + 4 * h + c) * KEYS] = f2bf(a[4 * g + c]);
    }
  }
};
struct EpiUqkv {
  int type; bf16_t *bq, *bk, *vtb;
  DI void operator()(int m, int nbase, int h, const f32x16& a) const {
    if (type == 0) EpiUq{bq}(m, nbase, h, a); else EpiUkv{bk, vtb}(m, nbase, h, a);
  }
};
struct EpiWlora {
  bf16_t* dst; const float* w0;
  DI void operator()(int m, int nbase, int h, const f32x16& a) const {
    float o[16];
#pragma unroll
    for (int g = 0; g < 4; ++g)
#pragma unroll
      for (int c = 0; c < 4; ++c) {
        const float u = w0[nbase + 8 * g + 4 * h + c] + a[4 * g + c];
        const float ew = 0.6065306597126334f * sigmoidf_(u);
        o[4 * g + c] = 1.f - fexp(-ew);
      }
    bf16_t* d = dst + (size_t)m * 1792 + nbase + 4 * h;
#pragma unroll
    for (int g = 0; g < 4; ++g) st4bf(d + 8 * g, o[4 * g], o[4 * g + 1], o[4 * g + 2], o[4 * g + 3]);
  }
};
struct EpiAlora {
  bf16_t* dst; const float* a0;
  DI void operator()(int m, int nbase, int h, const f32x16& a) const {
    float o[16];
#pragma unroll
    for (int g = 0; g < 4; ++g)
#pragma unroll
      for (int c = 0; c < 4; ++c) o[4 * g + c] = sigmoidf_(a0[nbase + 8 * g + 4 * h + c] + a[4 * g + c]);
    bf16_t* d = dst + (size_t)m * 1792 + nbase + 4 * h;
#pragma unroll
    for (int g = 0; g < 4; ++g) st4bf(d + 8 * g, o[4 * g], o[4 * g + 1], o[4 * g + 2], o[4 * g + 3]);
  }
};
struct EpiBf16 {
  bf16_t* dst; int ld; bool sqrelu;
  DI void operator()(int m, int nbase, int h, const f32x16& a) const {
    bf16_t* d = dst + (size_t)m * ld + nbase + 4 * h;
#pragma unroll
    for (int g = 0; g < 4; ++g) {
      float v0 = a[4 * g], v1 = a[4 * g + 1], v2 = a[4 * g + 2], v3 = a[4 * g + 3];
      if (sqrelu) { v0 = fmaxf(v0, 0.f); v1 = fmaxf(v1, 0.f); v2 = fmaxf(v2, 0.f); v3 = fmaxf(v3, 0.f); v0 *= v0; v1 *= v1; v2 *= v2; v3 *= v3; }
      st4bf(d + 8 * g, v0, v1, v2, v3);
    }
  }
};

DI void unpack8(const uint4 u, float* f) {
  f[0] = __uint_as_float(u.x << 16); f[1] = __uint_as_float(u.x & 0xffff0000u); f[2] = __uint_as_float(u.y << 16); f[3] = __uint_as_float(u.y & 0xffff0000u);
  f[4] = __uint_as_float(u.z << 16); f[5] = __uint_as_float(u.z & 0xffff0000u); f[6] = __uint_as_float(u.w << 16); f[7] = __uint_as_float(u.w & 0xffff0000u);
}
DI uint4 pack8(const float* f) { return make_uint4(pack2(f[0], f[1]), pack2(f[2], f[3]), pack2(f[4], f[5]), pack2(f[6], f[7])); }
DI float allreduce8(float v) {
  v += dpp_mov<0xB1>(v);
  v += dpp_mov<0x4E>(v);
  v += dpp_mov<0x141>(v);
  return v;
}
DI uint4 dpp_u4_xor2(uint4 u) {
  uint4 r;
  r.x = (unsigned)__builtin_amdgcn_update_dpp(0, (int)u.x, 0x4E, 0xf, 0xf, false); r.y = (unsigned)__builtin_amdgcn_update_dpp(0, (int)u.y, 0x4E, 0xf, 0xf, false);
  r.z = (unsigned)__builtin_amdgcn_update_dpp(0, (int)u.z, 0x4E, 0xf, 0xf, false); r.w = (unsigned)__builtin_amdgcn_update_dpp(0, (int)u.w, 0x4E, 0xf, 0xf, false);
  return r;
}
DI uint4 dpp_u4_xor1(uint4 u) {
  uint4 r;
  r.x = (unsigned)__builtin_amdgcn_update_dpp(0, (int)u.x, 0xB1, 0xf, 0xf, false); r.y = (unsigned)__builtin_amdgcn_update_dpp(0, (int)u.y, 0xB1, 0xf, 0xf, false);
  r.z = (unsigned)__builtin_amdgcn_update_dpp(0, (int)u.z, 0xB1, 0xf, 0xf, false); r.w = (unsigned)__builtin_amdgcn_update_dpp(0, (int)u.w, 0xB1, 0xf, 0xf, false);
  return r;
}
template <bool DO_ABD, bool DO_C>
DI void prep_rows(const Params& p, int l, int first, int end, int step) {
  char* ws = p.ws;
  const int tid_ = otid(); const int lane = tid_ & 63, wave = tid_ >> 6;
  bf16_t* ZA = (bf16_t*)(ws + OFF_ZA); bf16_t* ZD = (bf16_t*)(ws + OFF_ZD); bf16_t* ZB = (bf16_t*)(ws + OFF_ZB);
  const bf16_t* ZC = (const bf16_t*)(ws + OFF_ZC);
  bf16_t* BK = (bf16_t*)(ws + OFF_BK); bf16_t* SC = (bf16_t*)(ws + OFF_SCANIN);
  bf16_t* TW = (bf16_t*)(ws + OFF_TMPW); bf16_t* TA = (bf16_t*)(ws + OFF_TMPA); bf16_t* TG = (bf16_t*)(ws + OFF_TMPG);
  float* INVN = (float*)(ws + OFF_INVN);
  const float* mu = p.rwkv_mu + l * C_COLS;
  const float* kk0 = p.rwkv_k_k + (l * 2 + 0) * 256; const float* kk1 = p.rwkv_k_k + (l * 2 + 1) * 256;
  const int j = lane & 7;
  float gA[8], gAp[8];
  {
    const float* gsrc = (lane < 32 ? p.gqa_q_norm : p.gqa_k_norm) + l * 64;
#pragma unroll
    for (int e = 0; e < 8; ++e) { gA[e] = gsrc[8 * j + e]; gAp[e] = gsrc[(8 * j + e) ^ 16]; }
  }
  float inv64[8], inv32[8];
#pragma unroll
  for (int e = 0; e < 8; ++e) {
    inv64[e] = fexp2(-(float)(8 * (j & 1) + e) * (13.287712379549449f / 16.f)) * 0.15915494309189535f;
    inv32[e] = fexp2(-(float)e * (13.287712379549449f / 8.f)) * 0.15915494309189535f;
  }
  float gB[8];
#pragma unroll
  for (int e = 0; e < 8; ++e) gB[e] = lane < 32 ? p.mla_q_norm[l * 256 + 8 * lane + e] : (lane < 48 ? p.mla_kv_norm[l * 128 + 8 * (lane - 32) + e] : 0.f);
  float muc[3][8], kkc0[8], kkc1[8];
#pragma unroll
  for (int i = 0; i < 3; ++i)
#pragma unroll
    for (int e = 0; e < 8; ++e) { const int c = lane + 64 * i; muc[i][e] = (c < 132) ? mu[8 * c + e] : 0.f; }
#pragma unroll
  for (int e = 0; e < 8; ++e) { const int kc = (8 * lane - 256) & 255; kkc0[e] = kk0[kc + e]; kkc1[e] = kk1[kc + e]; }
  const bool x2_64 = (j >> 1) & 1, col64 = (j >> 2) & 1;
  const int jj = lane & 3; const bool x2_32 = jj & 1, col32 = (jj >> 1) & 1;
  for (int row = first + wave; row < end; row += step) {
    const bool lat = row < NLAT;
    const int t = row & (T_ - 1);
    const float prow = (float)(t >> 6), pcol = (float)(t & 63);
    uint4 ua = make_uint4(0, 0, 0, 0), ud = ua, ub = ua;
    if constexpr (DO_ABD) {
      ua = *(const uint4*)(ZA + (size_t)row * 512 + 8 * lane);
      ud = *(const uint4*)(ZD + (size_t)row * 512 + 8 * lane);
      ub = *(const uint4*)(ZB + (size_t)row * 512 + 8 * lane);
    }
    const int pos = lat ? t : ((row - NLAT) & (CTXL - 1));
    const int lastp = lat ? (T_ - 1) : (CTXL - 1);
    const bool hp = pos > 0, hn = pos < lastp;
    const bf16_t* zc = ZC + (size_t)row * 1152 + 8 * lane;
    uint4 c0[3], cp[3], cn[3];
#pragma unroll
    for (int i = 0; i < 3; ++i) {
      const bool ok = DO_C && ((i < 2) || (lane < 4));
      c0[i] = ok ? *(const uint4*)(zc + 512 * i) : make_uint4(0, 0, 0, 0);
      cp[i] = (ok && hp) ? *(const uint4*)(zc + 512 * i - 1152) : make_uint4(0, 0, 0, 0);
      cn[i] = (ok && hn) ? *(const uint4*)(zc + 512 * i + 1152) : make_uint4(0, 0, 0, 0);
    }
    if constexpr (DO_ABD) {
    float sn64[8], cs64[8], sn32[8], cs32[8];
    {
      const float p64 = col64 ? pcol : prow, p32 = col32 ? pcol : prow;
#pragma unroll
      for (int e = 0; e < 8; ++e) {
        const float r64 = lat ? p64 * inv64[e] : 0.f, r32 = lat ? p32 * inv32[e] : 0.f;
        sn64[e] = __builtin_amdgcn_sinf(r64); cs64[e] = __builtin_amdgcn_cosf(r64);
        sn32[e] = __builtin_amdgcn_sinf(r32); cs32[e] = __builtin_amdgcn_cosf(r32);
      }
    }
    {
      float x[8], xp[8];
      unpack8(ua, x); unpack8(dpp_u4_xor2(ua), xp);
      float ss = 0.f;
#pragma unroll
      for (int e = 0; e < 8; ++e) ss += x[e] * x[e];
      ss = allreduce8(ss);
      const float rs = frsqrt(ss * (1.f / 64.f) + EPS);
      const float sc = lane < 32 ? 0.125f * LOG2E : 1.f;
      float o[8];
#pragma unroll
      for (int e = 0; e < 8; ++e) {
        const float own = x[e] * rs * gA[e], par = xp[e] * rs * gAp[e];
        o[e] = (x2_64 ? (par * sn64[e] + own * cs64[e]) : (own * cs64[e] - par * sn64[e])) * sc;
      }
      if (lane < 48) *(uint4*)(ZA + (size_t)row * 512 + 8 * lane) = pack8(o);
    }
    {
      float x[8], xp[8];
      unpack8(ud, x); unpack8(dpp_u4_xor2(ud), xp);
      const float sc = lane < 32 ? 0.125f * LOG2E : 1.f;
      float o[8];
#pragma unroll
      for (int e = 0; e < 8; ++e) o[e] = (x2_64 ? (xp[e] * sn64[e] + x[e] * cs64[e]) : (x[e] * cs64[e] - xp[e] * sn64[e])) * sc;
      if (lane < 48) *(uint4*)(ZD + (size_t)row * 512 + 8 * lane) = pack8(o);
    }
    {
      float x[8], xp[8];
      unpack8(ub, x); unpack8(dpp_u4_xor1(ub), xp);
      float ss = 0.f;
#pragma unroll
      for (int e = 0; e < 8; ++e) ss += x[e] * x[e];
      const float s16 = allreduce16(ss);
      const float s32 = s16 + __shfl_xor(s16, 16);
      const float rs = lane < 32 ? frsqrt(s32 * (1.f / 256.f) + EPS) : frsqrt(s16 * (1.f / 128.f) + EPS);
      float o[8];
#pragma unroll
      for (int e = 0; e < 8; ++e) o[e] = x[e] * rs * gB[e];
      if (lane < 48) *(uint4*)(ZB + (size_t)row * 512 + 8 * lane) = pack8(o);
      float kr[8];
#pragma unroll
      for (int e = 0; e < 8; ++e) kr[e] = x2_32 ? (xp[e] * sn32[e] + x[e] * cs32[e]) : (x[e] * cs32[e] - xp[e] * sn32[e]);
      if (lane >= 48 && lane < 52) {
        const uint4 kb = pack8(kr);
        bf16_t* bk = BK + (size_t)row * 384 + 64 + 8 * jj;
        *(uint4*)(bk) = kb; *(uint4*)(bk + 96) = kb; *(uint4*)(bk + 192) = kb; *(uint4*)(bk + 288) = kb;
      }
    }
    }
    if constexpr (DO_C) {
#pragma unroll
    for (int i = 0; i < 3; ++i) {
      const int c = lane + 64 * i;
      if (c < 132) {
        float z[8], zp[8], zn[8], zs[8];
        unpack8(c0[i], z); unpack8(cp[i], zp); unpack8(cn[i], zn);
#pragma unroll
        for (int e = 0; e < 8; ++e) zs[e] = z[e] + muc[i][e] * (0.5f * (zp[e] + zn[e]) - z[e]);
        if (c < 96) {
          const uint4 pk = pack8(zs);
          *(uint4*)(SC + (size_t)row * 1792 + 8 * c) = pk;
          if (i == 0) {
            float kq[8]; unpack8(pk, kq);
            float s0 = 0.f, s1 = 0.f;
#pragma unroll
            for (int e = 0; e < 8; ++e) { const float a0 = kq[e] * kkc0[e], a1 = kq[e] * kkc1[e]; s0 += a0 * a0; s1 += a1 * a1; }
            s0 = allreduce8(s0); s1 = allreduce8(s1);
            if (lane >= 32 && j == 0) {
              const int hd = (lane - 32) >> 3;
              INVN[(size_t)row * 8 + hd] = fminf(frsqrt(s0), 1e12f);
              INVN[(size_t)row * 8 + 4 + hd] = fminf(frsqrt(s1), 1e12f);
            }
          }
        } else if (c < 104) {
          float o[8];
#pragma unroll
          for (int e = 0; e < 8; ++e) { const float ex = fexp(2.f * zs[e]); o[e] = 1.f - 2.f * frcp(ex + 1.f); }
          *(uint4*)(TW + (size_t)row * 64 + 8 * (c - 96)) = pack8(o);
        } else if (c < 112) {
          *(uint4*)(TA + (size_t)row * 64 + 8 * (c - 104)) = pack8(zs);
        } else {
          float o[8];
#pragma unroll
          for (int e = 0; e < 8; ++e) o[e] = sigmoidf_(zs[e]);
          *(uint4*)(TG + (size_t)row * 192 + 8 * (c - 112)) = pack8(o);
        }
      } else if (c < 136) {
        *(uint4*)(TG + (size_t)row * 192 + 8 * (c - 112)) = make_uint4(0, 0, 0, 0);
      }
    }
    }
  }
}

template <int DK>
DI void attn_item(const bf16_t* __restrict__ Q, int ldq, const bf16_t* __restrict__ Kg, int ldk, const bf16_t* __restrict__ Vt,
                  int qrow0, int b, int lat_t0, int lat_t1, bool window, int qpos0, bool use_sink, float sink_l2,
                  bf16_t* out, int ldo, char* smem) {
  constexpr int KS = DK + 8, NKS = DK / 16, CPR = DK / 8;
  bf16_t* Ks = (bf16_t*)smem;
  bf16_t* Vs = Ks + 2 * 64 * KS;
  const int tid = otid(), lane = tid & 63, wave = tid >> 6, l = lane & 31, h = lane >> 5;
  const int pl = (l & ~12) | ((l & 4) << 1) | ((l & 8) >> 1);
  const int nlat = lat_t1 - lat_t0, ntile = nlat + 4;
  bf16x8 qf[NKS];
  {
    const bf16_t* qp = Q + (size_t)(qrow0 + wave * 32 + l) * ldq + 8 * h;
#pragma unroll
    for (int ks = 0; ks < NKS; ++ks) qf[ks] = *(const bf16x8*)(qp + ks * 16);
  }
  f32x16 o0, o1;
#pragma unroll
  for (int q = 0; q < 16; ++q) { o0[q] = 0.f; o1[q] = 0.f; }
  if (wave >= 4) __builtin_amdgcn_s_setprio(1);
  float m_run = use_sink ? sink_l2 : -64.f;
  f32x16 o2;
#pragma unroll
  for (int q = 0; q < 16; ++q) o2[q] = 0.f;
  o2[0] = (use_sink && h == 0) ? 1.f : 0.f;
  bf16x8 vones;
#pragma unroll
  for (int e = 0; e < 8; ++e) vones[e] = (l == 0) ? (short)0x3F80 : (short)0;
  const int qp_ = qpos0 + wave * 32 + l;

  uint4 rk0, rk1 = make_uint4(0, 0, 0, 0), rv;
  const int krow_a = tid / CPR, kc_a = tid % CPR;
  const int krow_b = (tid + 512) / CPR, kc_b = (tid + 512) % CPR;
  const int vrow = tid >> 3, vkc = tid & 7;
  auto tile_src = [&](int i, int& krow_base, int& vcol) {
    if (i < nlat) { const int kt = lat_t0 + i; krow_base = b * T_ + kt * 64; vcol = kt * 64; }
    else { const int c = i - nlat; krow_base = NLAT + b * CTXL + c * 64; vcol = T_ + c * 64; }
  };
  {
    int kb, vc; tile_src(0, kb, vc);
    rk0 = *(const uint4*)(Kg + (size_t)(kb + krow_a) * ldk + kc_a * 8);
    if (DK == 96 && tid < 256) rk1 = *(const uint4*)(Kg + (size_t)(kb + krow_b) * ldk + kc_b * 8);
    rv = *(const uint4*)(Vt + (size_t)vrow * KEYS + vc + vkc * 8);
    *(uint4*)(Ks + krow_a * KS + kc_a * 8) = rk0;
    if (DK == 96 && tid < 256) *(uint4*)(Ks + krow_b * KS + kc_b * 8) = rk1;
    *(uint4*)(Vs + vrow * 72 + vkc * 8) = rv;
  }
  __syncthreads();
  for (int it = 0; it < ntile; ++it) {
    const int buf = it & 1;
    if (it + 1 < ntile) {
      int kb, vc; tile_src(it + 1, kb, vc);
      rk0 = *(const uint4*)(Kg + (size_t)(kb + krow_a) * ldk + kc_a * 8);
      if (DK == 96 && tid < 256) rk1 = *(const uint4*)(Kg + (size_t)(kb + krow_b) * ldk + kc_b * 8);
      rv = *(const uint4*)(Vt + (size_t)vrow * KEYS + vc + vkc * 8);
    }
    const bf16_t* Kb = Ks + buf * 64 * KS + pl * KS + 8 * h;
    const bf16_t* Vb = Vs + buf * 64 * 72 + l * 72 + 8 * h;
    f32x16 s0, s1;
    {
      const float nm = -m_run;
#pragma unroll
      for (int q = 0; q < 16; ++q) { s0[q] = nm; s1[q] = nm; }
    }
#pragma unroll
    for (int ks = 0; ks < NKS; ++ks) {
      const bf16x8 k0 = *(const bf16x8*)(Kb + ks * 16);
      const bf16x8 k1 = *(const bf16x8*)(Kb + 32 * KS + ks * 16);
      s0 = MFMA32(k0, qf[ks], s0);
      s1 = MFMA32(k1, qf[ks], s1);
    }
    if (window && it < nlat) {
      const int kbase = (lat_t0 + it) * 64 + 8 * h - qp_;
#pragma unroll
      for (int q = 0; q < 16; ++q) {
        const int d0 = kbase + 16 * (q >> 3) + (q & 7);
        const int d1 = d0 + 32;
        if (d0 > 128 || d0 < -128) s0[q] = -1e30f;
        if (d1 > 128 || d1 < -128) s1[q] = -1e30f;
      }
    }
    int di = 0;
#pragma unroll
    for (int q = 0; q < 16; q += 2) {
      const int a0 = __float_as_int(s0[q]), a1 = __float_as_int(s1[q]), a2 = __float_as_int(s0[q + 1]), a3 = __float_as_int(s1[q + 1]);
      di = max(max(di, a0), max(a1, max(a2, a3)));
    }
    float d = __int_as_float(di);
    { const auto sw = __builtin_amdgcn_permlane32_swap(__float_as_uint(d), __float_as_uint(d), false, false); d = fmaxf(__uint_as_float(sw[0]), __uint_as_float(sw[1])); }
    if (__any(d > 8.f)) {
      const float alpha = fexp2(-d);
      m_run += d;
      o2[0] *= alpha;
#pragma unroll
      for (int q = 0; q < 16; ++q) { s0[q] -= d; s1[q] -= d; o0[q] *= alpha; o1[q] *= alpha; }
    }
#pragma unroll
    for (int q = 0; q < 16; ++q) { s0[q] = fexp2(s0[q]); s1[q] = fexp2(s1[q]); }
    bf16x8 pf[4];
#pragma unroll
    for (int s4 = 0; s4 < 4; ++s4) {
      unsigned u[4];
#pragma unroll
      for (int j = 0; j < 4; ++j) {
        const float e0 = (s4 < 2) ? s0[8 * (s4 & 1) + 2 * j] : s1[8 * (s4 & 1) + 2 * j];
        const float e1 = (s4 < 2) ? s0[8 * (s4 & 1) + 2 * j + 1] : s1[8 * (s4 & 1) + 2 * j + 1];
        u[j] = pack2(e0, e1);
      }
      pf[s4] = __builtin_bit_cast(bf16x8, make_uint4(u[0], u[1], u[2], u[3]));
    }
#pragma unroll
    for (int s4 = 0; s4 < 4; ++s4) {
      const bf16x8 v0 = *(const bf16x8*)(Vb + s4 * 16);
      const bf16x8 v1 = *(const bf16x8*)(Vb + 32 * 72 + s4 * 16);
      o0 = MFMA32(v0, pf[s4], o0);
      o1 = MFMA32(v1, pf[s4], o1);
      o2 = MFMA32(vones, pf[s4], o2);
    }
    if (it + 1 < ntile) {
      const int nb = buf ^ 1;
      *(uint4*)(Ks + nb * 64 * KS + krow_a * KS + kc_a * 8) = rk0;
      if (DK == 96 && tid < 256) *(uint4*)(Ks + nb * 64 * KS + krow_b * KS + kc_b * 8) = rk1;
      *(uint4*)(Vs + nb * 64 * 72 + vrow * 72 + vkc * 8) = rv;
    }
    __syncthreads();
  }
  __builtin_amdgcn_s_setprio(0);
  float lt;
  { const float l_run = o2[0]; const auto sw = __builtin_amdgcn_permlane32_swap(__float_as_uint(l_run), __float_as_uint(l_run), false, false); lt = __uint_as_float(sw[0]) + __uint_as_float(sw[1]); }
  const float inv = frcp(lt);
  bf16_t* op = out + (size_t)(qrow0 + wave * 32 + l) * ldo + 4 * h;
#pragma unroll
  for (int g = 0; g < 4; ++g) {
    st4bf(op + 8 * g, o0[4 * g] * inv, o0[4 * g + 1] * inv, o0[4 * g + 2] * inv, o0[4 * g + 3] * inv);
    st4bf(op + 32 + 8 * g, o1[4 * g] * inv, o1[4 * g + 1] * inv, o1[4 * g + 2] * inv, o1[4 * g + 3] * inv);
  }
}

DI void run_attn_item(const Params& p, int l, int kind, int b, int hq, int qt, bool isctx, char* smem) {
  char* ws = p.ws;
  const bf16_t* ZA = (const bf16_t*)(ws + OFF_ZA); const bf16_t* ZD = (const bf16_t*)(ws + OFF_ZD);
  const bf16_t* BQ = (const bf16_t*)(ws + OFF_BQ); const bf16_t* BK = (const bf16_t*)(ws + OFF_BK);
  const bf16_t* VTA = (const bf16_t*)(ws + OFF_VTA); const bf16_t* VTB = (const bf16_t*)(ws + OFF_VTB); const bf16_t* VTD = (const bf16_t*)(ws + OFF_VTD);
  bf16_t* OUTS = (bf16_t*)(ws + OFF_OUTS);
  const int qrow0 = isctx ? NLAT + b * CTXL : b * T_ + qt * 256;
  int t0 = 0, t1 = isctx ? 0 : 128;
  if (kind == 0) {
    attn_item<96>(BQ + hq * 96, 384, BK + hq * 96, 384, VTB + ((size_t)b * 256 + hq * 64) * KEYS, qrow0, b, t0, t1, false, 0, false, 0.f,
                  OUTS + 256 + hq * 64, 1024, smem);
  } else if (kind == 1) {
    attn_item<64>(ZA + hq * 64, 512, ZA + 256 + (hq >> 1) * 64, 512, VTA + ((size_t)b * 128 + (hq >> 1) * 64) * KEYS, qrow0, b, t0, t1, false, 0,
                  false, 0.f, OUTS + hq * 64, 1024, smem);
  } else {
    if (!isctx) { t0 = 4 * qt - 2; if (t0 < 0) t0 = 0; t1 = 4 * qt + 6; if (t1 > 128) t1 = 128; }
    attn_item<64>(ZD + hq * 64, 512, ZD + 256 + (hq >> 1) * 64, 512, VTD + ((size_t)b * 128 + (hq >> 1) * 64) * KEYS, qrow0, b, t0, t1, !isctx,
                  qt * 256, true, p.swa_sink[l * 4 + hq] * LOG2E, OUTS + 768 + hq * 64, 1024, smem);
  }
}

constexpr int SCH = 32;
constexpr int SST = 336;
DI int scan_row(int b, int dir, int s) {
  if (s < CTXL) return NLAT + b * CTXL + (dir ? CTXL - 1 - s : s);
  const int s2 = s - CTXL;
  return b * T_ + (dir ? T_ - 1 - s2 : s2);
}
DI void scan_block(const Params& p, int l, int sb, char* smem) {
  float* opbuf = (float*)smem;
  float* ybuf = opbuf + 2 * SCH * SST;
  const int tid = otid(), lane = tid & 63, wave = tid >> 6;
  const int chain = sb >> 2, rg = sb & 3, b = chain >> 3, hh = (chain >> 1) & 3, dir = chain & 1;
  const bf16_t* SC = (const bf16_t*)(p.ws + OFF_SCANIN);
  float* Y = (float*)(p.ws + OFF_Y) + (size_t)dir * NT * 256;
  const int nchunk = (CTXL + T_) / SCH;
  const float* INVN = (const float*)(p.ws + OFF_INVN);
  const int ht = tid - 256, fg = ht & 15;
  float kkc[4], kac[4];
#pragma unroll
  for (int e = 0; e < 4; ++e) {
    kkc[e] = p.rwkv_k_k[(l * 2 + dir) * 256 + hh * 64 + ((4 * fg + e) & 63)];
    kac[e] = p.rwkv_k_a[(l * 2 + dir) * 256 + hh * 64 + ((4 * fg + e) & 63)];
  }
  struct HStage { uint2 r0, k0, v0, w0, a0, r1, k1, v1, w1, a1; float n0, n1; };
  auto issue = [&](HStage& h, int ci) {
    {
      const int row = scan_row(b, dir, ci * SCH + (ht >> 4));
      const bf16_t* src = SC + (size_t)row * 1792 + hh * 64 + 4 * fg;
      h.r0 = *(const uint2*)(src); h.k0 = *(const uint2*)(src + 256); h.v0 = *(const uint2*)(src + 512);
      h.w0 = *(const uint2*)(src + (3 + dir) * 256); h.a0 = *(const uint2*)(src + (5 + dir) * 256);
      h.n0 = INVN[(size_t)row * 8 + dir * 4 + hh];
    }
    {
      const int row = scan_row(b, dir, ci * SCH + (ht >> 4) + 16);
      const bf16_t* src = SC + (size_t)row * 1792 + hh * 64 + 4 * fg;
      h.r1 = *(const uint2*)(src); h.k1 = *(const uint2*)(src + 256); h.v1 = *(const uint2*)(src + 512);
      h.w1 = *(const uint2*)(src + (3 + dir) * 256); h.a1 = *(const uint2*)(src + (5 + dir) * 256);
      h.n1 = INVN[(size_t)row * 8 + dir * 4 + hh];
    }
  };
  auto commit1 = [&](uint2 lr, uint2 lk, uint2 lv, uint2 lw, uint2 la, float inn, int ls, int bi) {
    float* st = opbuf + ((size_t)bi * SCH + ls) * SST + 4 * fg;
    float r4[4], k4[4], v4[4], w4[4], a4[4];
    r4[0] = __uint_as_float(lr.x << 16); r4[1] = __uint_as_float(lr.x & 0xffff0000u); r4[2] = __uint_as_float(lr.y << 16); r4[3] = __uint_as_float(lr.y & 0xffff0000u);
    k4[0] = __uint_as_float(lk.x << 16); k4[1] = __uint_as_float(lk.x & 0xffff0000u); k4[2] = __uint_as_float(lk.y << 16); k4[3] = __uint_as_float(lk.y & 0xffff0000u);
    v4[0] = __uint_as_float(lv.x << 16); v4[1] = __uint_as_float(lv.x & 0xffff0000u); v4[2] = __uint_as_float(lv.y << 16); v4[3] = __uint_as_float(lv.y & 0xffff0000u);
    w4[0] = __uint_as_float(lw.x << 16); w4[1] = __uint_as_float(lw.x & 0xffff0000u); w4[2] = __uint_as_float(lw.y << 16); w4[3] = __uint_as_float(lw.y & 0xffff0000u);
    a4[0] = __uint_as_float(la.x << 16); a4[1] = __uint_as_float(la.x & 0xffff0000u); a4[2] = __uint_as_float(la.y << 16); a4[3] = __uint_as_float(la.y & 0xffff0000u);
    float kk[4];
#pragma unroll
    for (int e = 0; e < 4; ++e) kk[e] = k4[e] * kkc[e] * inn;
    *(float4*)(st) = make_float4(1.f - w4[0], 1.f - w4[1], 1.f - w4[2], 1.f - w4[3]);
    *(float4*)(st + 64) = make_float4(-kk[0], -kk[1], -kk[2], -kk[3]);
    *(float4*)(st + 128) = make_float4(kk[0] * a4[0], kk[1] * a4[1], kk[2] * a4[2], kk[3] * a4[3]);
    *(float4*)(st + 192) = make_float4(k4[0] * (1.f + (a4[0] - 1.f) * kac[0]), k4[1] * (1.f + (a4[1] - 1.f) * kac[1]),
                                       k4[2] * (1.f + (a4[2] - 1.f) * kac[2]), k4[3] * (1.f + (a4[3] - 1.f) * kac[3]));
    *(float4*)(st + 256) = make_float4(r4[0], r4[1], r4[2], r4[3]);
    if ((fg >> 2) == rg) *(float4*)(opbuf + ((size_t)bi * SCH + ls) * SST + 320 + 4 * (fg & 3)) = make_float4(v4[0], v4[1], v4[2], v4[3]);
  };
  auto commit = [&](const HStage& h, int bi) {
    commit1(h.r0, h.k0, h.v0, h.w0, h.a0, h.n0, (ht >> 4), bi);
    commit1(h.r1, h.k1, h.v1, h.w1, h.a1, h.n1, (ht >> 4) + 16, bi);
  };
  auto flush = [&](int ci) {
    const float* yb = ybuf + (size_t)(ci & 1) * SCH * 256;
#pragma unroll
    for (int i = 0; i < 2; ++i) {
      const int o = ht + 256 * i, ls = o >> 4, r16 = o & 15;
      const float* src = yb + ls * 256 + r16 * 16;
      const float4 a = *(const float4*)(src), b4 = *(const float4*)(src + 4), c = *(const float4*)(src + 8), d = *(const float4*)(src + 12);
      const float y = ((a.x + a.y) + (a.z + a.w)) + ((b4.x + b4.y) + (b4.z + b4.w)) + ((c.x + c.y) + (c.z + c.w)) + ((d.x + d.y) + (d.z + d.w));
      __builtin_nontemporal_store(y, &Y[(size_t)scan_row(b, dir, ci * SCH + ls) * 256 + hh * 64 + rg * 16 + r16]);
    }
  };
  typedef float f2_t __attribute__((ext_vector_type(2)));
  f2_t Sa = {0.f, 0.f}, Sb = {0.f, 0.f};
  const int rowl = wave * 4 + (lane >> 4), c4 = lane & 15;
  auto process = [&](int bi) {
    const float* cb = opbuf + (size_t)bi * SCH * SST + 4 * c4;
    const float* vb = opbuf + (size_t)bi * SCH * SST + 320 + rowl;
    float* yb = ybuf + (size_t)bi * SCH * 256 + wave * 64 + lane;
    f2_t W0[3], W1[3], A0[3], A1[3], B0[3], B1[3], K0[3], K1[3], R0[3], R1[3]; float V_[3];
#define SC_LD2(DST0, DST1, PTR) { const float4 t_ = *(const float4*)(PTR); DST0 = (f2_t){t_.x, t_.y}; DST1 = (f2_t){t_.z, t_.w}; }
#define SC_LOAD(ST, SL) { const float* q_ = cb + (ST) * SST; SC_LD2(W0[SL], W1[SL], q_); SC_LD2(A0[SL], A1[SL], q_ + 64); SC_LD2(B0[SL], B1[SL], q_ + 128); \
                          SC_LD2(K0[SL], K1[SL], q_ + 192); SC_LD2(R0[SL], R1[SL], q_ + 256); V_[SL] = vb[(ST) * SST]; }
    SC_LOAD(0, 0);
    SC_LOAD(1, 1);
#pragma unroll
    for (int ls = 0; ls < SCH; ++ls) {
      if (ls + 2 < SCH) SC_LOAD(ls + 2, (ls + 2) % 3);
      const int sl = ls % 3;
      const f2_t vv = {V_[sl], V_[sl]};
      f2_t pp = __builtin_elementwise_fma(Sb, A1[sl], Sa * A0[sl]);
      float pa = pp.x + pp.y;
      const f2_t ta = __builtin_elementwise_fma(Sa, W0[sl], vv * K0[sl]);
      const f2_t tb = __builtin_elementwise_fma(Sb, W1[sl], vv * K1[sl]);
      pa = allreduce16(pa);
      const f2_t pv = {pa, pa};
      Sa = __builtin_elementwise_fma(pv, B0[sl], ta);
      Sb = __builtin_elementwise_fma(pv, B1[sl], tb);
      const f2_t yy = __builtin_elementwise_fma(Sb, R1[sl], Sa * R0[sl]);
      yb[ls * 256] = yy.x + yy.y;
    }
#undef SC_LOAD
#undef SC_LD2
  };
  HStage h0, h1;
  const bool helper = wave >= 4;
  if (helper) { issue(h0, 0); commit(h0, 0); issue(h1, 1); issue(h0, 2); }
  __syncthreads();
#pragma unroll 1
  for (int ci = 0; ci <= nchunk; ci += 2) {
    if (helper) {
      if (ci + 1 < nchunk) { commit(h1, 1); if (ci + 3 < nchunk) issue(h1, ci + 3); }
      if (ci >= 1) flush(ci - 1);
    } else if (ci < nchunk) process(0);
    __syncthreads();
    if (helper) {
      if (ci + 2 < nchunk) { commit(h0, 0); if (ci + 4 < nchunk) issue(h0, ci + 4); }
      if (ci < nchunk) flush(ci);
    } else if (ci + 1 < nchunk) process(1);
    __syncthreads();
  }
}

DI void phase_rwkv_out(const Params& p, int l, int nrows) {
  char* ws = p.ws;
  const int tid_ = otid(); const int lane = tid_ & 63, wave = tid_ >> 6;
  const float* Y0 = (const float*)(ws + OFF_Y); const float* Y1 = Y0 + (size_t)NT * 256;
  const bf16_t* SC = (const bf16_t*)(ws + OFF_SCANIN); const bf16_t* Gb = (const bf16_t*)(ws + OFF_G);
  bf16_t* OUTS = (bf16_t*)(ws + OFF_OUTS);
  const int c0 = 4 * lane;
  const float4 lw = *(const float4*)(p.rwkv_ln_w + l * 256 + c0), lb = *(const float4*)(p.rwkv_ln_b + l * 256 + c0);
  const float4 ka0 = *(const float4*)(p.rwkv_k_a + (l * 2 + 0) * 256 + c0), ka1 = *(const float4*)(p.rwkv_k_a + (l * 2 + 1) * 256 + c0);
  const float4 rk = *(const float4*)(p.rwkv_r_k + l * 256 + c0);
  const float lwv[4] = {lw.x, lw.y, lw.z, lw.w}, lbv[4] = {lb.x, lb.y, lb.z, lb.w};
  const float k0v[4] = {ka0.x, ka0.y, ka0.z, ka0.w}, k1v[4] = {ka1.x, ka1.y, ka1.z, ka1.w}, rkv[4] = {rk.x, rk.y, rk.z, rk.w};
  for (int row = obid() * 8 + wave; row < nrows; row += gridDim.x * 8) {
    typedef float f4v_t __attribute__((ext_vector_type(4)));
    const f4v_t ya = __builtin_nontemporal_load((const f4v_t*)(Y0 + (size_t)row * 256 + c0)), yb = __builtin_nontemporal_load((const f4v_t*)(Y1 + (size_t)row * 256 + c0));
    const bf16_t* sc = SC + (size_t)row * 1792 + c0;
    const uint2 ur = *(const uint2*)(sc), uk = *(const uint2*)(sc + 256), uv = *(const uint2*)(sc + 512), ua0 = *(const uint2*)(sc + 5 * 256), ua1 = *(const uint2*)(sc + 6 * 256);
    const uint2 ug = *(const uint2*)(Gb + (size_t)row * 256 + c0);
    const float y[4] = {ya.x + yb.x, ya.y + yb.y, ya.z + yb.z, ya.w + yb.w};
    const float mean = allreduce16((y[0] + y[1]) + (y[2] + y[3])) * (1.f / 64.f);
    float d[4], var = 0.f;
#pragma unroll
    for (int e = 0; e < 4; ++e) { d[e] = y[e] - mean; var += d[e] * d[e]; }
    var = allreduce16(var) * (1.f / 64.f);
    const float rstd = frsqrt(var + 64e-5f);
#define U2F(U, E) (((E) & 1) ? __uint_as_float((((E) >> 1) ? (U).y : (U).x) & 0xffff0000u) : __uint_as_float((((E) >> 1) ? (U).y : (U).x) << 16))
    float bs = 0.f, r4[4], k4[4], v4[4], g4[4];
#pragma unroll
    for (int e = 0; e < 4; ++e) {
      r4[e] = U2F(ur, e); k4[e] = U2F(uk, e); v4[e] = U2F(uv, e); g4[e] = U2F(ug, e);
      const float a0 = U2F(ua0, e), a1 = U2F(ua1, e);
      const float kd0 = k4[e] * (1.f + (a0 - 1.f) * k0v[e]), kd1 = k4[e] * (1.f + (a1 - 1.f) * k1v[e]);
      bs += r4[e] * (kd0 + kd1) * rkv[e];
    }
#undef U2F
    bs = allreduce16(bs);
    float o[4];
#pragma unroll
    for (int e = 0; e < 4; ++e) o[e] = ((d[e] * rstd * lwv[e] + lbv[e]) + bs * v4[e]) * g4[e];
    st4bf(OUTS + (size_t)row * 1024 + 512 + c0, o[0], o[1], o[2], o[3]);
  }
}

#define XB_TMO      128
#define XB_XCNT(j)  (256  + 64 * (j))
#define XB_XSUB(j)  (1280 + 64 * (j))
#define XB_XGEN(j)  (2304 + 64 * (j))
#define XB_TOP      3328
#define XB_TOPGEN   3392
#define XCD_BAR_WORDS 3456
#define XB_SPIN_CAP (1u << 22)
#define LAS __attribute__((address_space(3)))
DI unsigned xb_ld(unsigned* p) { return __hip_atomic_load(p, __ATOMIC_RELAXED, __HIP_MEMORY_SCOPE_AGENT); }
DI unsigned xb_add(unsigned* p, unsigned v) { return __hip_atomic_fetch_add(p, v, __ATOMIC_RELAXED, __HIP_MEMORY_SCOPE_AGENT); }
DI unsigned xb_xcc_id() { return (unsigned)__builtin_amdgcn_s_getreg((3 << 11) | 20) & 0xFu; }
#define XB_SPIN(cond, bar) do { unsigned _sp = 0; while (cond) { __builtin_amdgcn_s_sleep(1); \
    if ((++_sp & 255u) == 0u) { if (xb_ld(&(bar)[XB_TMO])) break; if (_sp > XB_SPIN_CAP) { atomicAdd(&(bar)[XB_TMO], 1u); break; } } } } while (0)
struct XcdBarrier { unsigned* bar; unsigned x; volatile LAS unsigned* st; };
DI XcdBarrier xcd_barrier_post(unsigned* bar, volatile LAS unsigned* st) {
  XcdBarrier b; b.bar = bar; b.x = xb_xcc_id(); b.st = st;
  if (threadIdx.x == 0) (void)xb_add(&bar[XB_XCNT(b.x)], 1u);
  return b;
}
DI void xcd_barrier_complete(unsigned* bar, unsigned x, unsigned& nloc, unsigned& nx) {
  const unsigned G = gridDim.x * gridDim.y * gridDim.z;
  unsigned sum, cnt, mine, sp = 0u;
  for (;;) {
    sum = 0u; cnt = 0u; mine = 0u;
#pragma unroll
    for (unsigned j = 0; j < 16; ++j) { const unsigned c = xb_ld(&bar[XB_XCNT(j)]); sum += c; cnt += (c > 0u) ? 1u : 0u; mine = (j == x) ? c : mine; }
    if (sum == G) break;
    __builtin_amdgcn_s_sleep(1);
    if ((++sp & 255u) == 0u) { if (xb_ld(&bar[XB_TMO])) break; if (sp > XB_SPIN_CAP) { atomicAdd(&bar[XB_TMO], 1u); break; } }
  }
  nloc = mine > 0u ? mine : 1u; nx = cnt > 0u ? cnt : 1u;
}
DI void xcd_barrier(const XcdBarrier& b) {
  asm volatile("s_waitcnt vmcnt(0)" ::: "memory");
  __syncthreads();
  if (otid() == 0) {
    unsigned* bar = b.bar;
    __builtin_amdgcn_s_waitcnt(0);
    unsigned nloc = b.st[0], nx = b.st[1];
    if (nloc == 0u) { xcd_barrier_complete(bar, b.x, nloc, nx); b.st[0] = nloc; b.st[1] = nx; }
    const unsigned old = xb_add(&bar[XB_XSUB(b.x)], 1u);
    const unsigned gen = old / nloc;
    if (old + 1u == (gen + 1u) * nloc) {
      __builtin_amdgcn_fence(__ATOMIC_RELEASE, "agent");
      asm volatile("s_waitcnt vmcnt(0)" ::: "memory");
      const unsigned og = xb_add(&bar[XB_TOP], 1u);
      const unsigned tg = og / nx;
      if (og + 1u == (tg + 1u) * nx) xb_add(&bar[XB_TOPGEN], 1u);
      else XB_SPIN(xb_ld(&bar[XB_TOPGEN]) == tg, bar);
      __builtin_amdgcn_fence(__ATOMIC_ACQUIRE, "agent");
      xb_add(&bar[XB_XGEN(b.x)], 1u);
      asm volatile("s_waitcnt vmcnt(0)" ::: "memory");
    } else {
      XB_SPIN(xb_ld(&bar[XB_XGEN(b.x)]) == gen, bar);
      __builtin_amdgcn_fence(__ATOMIC_ACQUIRE, "agent");
      asm volatile("s_waitcnt vmcnt(0)" ::: "memory");
    }
  }
  __syncthreads();
}

typedef const uint64_t __attribute__((address_space(4))) cu64_t;
DI Params load_params(cu64_t*& ka) {
  asm volatile("" : "+s"(ka));
  Params p;
  const float** d = (const float**)&p;
#pragma unroll
  for (int i = 0; i < 32; ++i) d[i] = (const float*)(const float __attribute__((address_space(1)))*)ka[i];
  p.out = (float*)(float __attribute__((address_space(1)))*)ka[32];
  p.ws = (char*)(char __attribute__((address_space(1)))*)ka[33];
  return p;
}
#define LP() const Params p = load_params(ka)
__global__ void __launch_bounds__(THREADS) fwd_megakernel(Params p_unused) {
  extern __shared__ __attribute__((aligned(16))) char smem[];
  cg::grid_group grid = cg::this_grid();
  cu64_t* ka = (cu64_t*)__builtin_amdgcn_kernarg_segment_ptr();
  int* s_item = (int*)(smem + LDS_MAIN);
  if (threadIdx.x < 16) ((volatile LAS unsigned*)(smem + LDS_MAIN))[threadIdx.x] = 0u;
  __syncthreads();
  XcdBarrier xbar;
  { LP(); xbar = xcd_barrier_post((unsigned*)(p.ws + OFF_CTL), (volatile LAS unsigned*)(smem + LDS_MAIN + 16)); }
#define PH_BEGIN { LP(); char* ws = p.ws; (void)ws; float* mods = (float*)(ws + OFF_MODS); (void)mods; float* XC = (float*)(ws + OFF_XC); (void)XC; bf16_t* H = (bf16_t*)(ws + OFF_H); (void)H; int rot = 0; (void)rot;
#define XBAR() { LP(); xbar.bar = (unsigned*)(p.ws + OFF_CTL); xbar.x = xb_xcc_id(); xcd_barrier(xbar); }
#define PH_END } XBAR();
#define PH_END_CG } if (gridDim.x == 0x7fffffffu) grid.sync(); XBAR();

  PH_BEGIN
    phase_mods(p, smem);
    phase_convert(p, 0, smem);
  PH_END_CG
  PH_BEGIN
    phase_rows(p, NT, nullptr, p.x, p.ctx, nullptr, nullptr, nullptr, 0, nullptr, true, mods, 0, 1024, p.g_pre_mix, H);
  PH_END

  volatile int* s_layer = (volatile int*)(smem + LDS_MAIN + 48);
#pragma unroll 1
  for (;;) {
    const int l = __builtin_amdgcn_readfirstlane(*s_layer);
    if (l >= 2) break;
    const bool last = (l == 1);
    const int nrows = last ? NLAT : NT;
    PH_BEGIN
      pg8::PEpiWin e{(bf16_t*)(ws + OFF_ZA), (bf16_t*)(ws + OFF_ZB), (bf16_t*)(ws + OFF_ZC), (bf16_t*)(ws + OFF_ZD), (bf16_t*)(ws + OFF_VTA), (bf16_t*)(ws + OFF_VTD)};
      const int vcu = (gridDim.x % 8 == 0) ? (obid() % 8) * ((int)gridDim.x / 8) + obid() / 8 : obid();
      pg8::Gemm g{H, (const bf16_t*)(ws + OFF_WIN), NT, NWIN, 1024, 1024}; pg8::WinCOrder S{(int)gridDim.x, vcu};
      pg8::gemm_phase<pg8::PEpiWin, pg8::WinCOrder, true, true>((PG8_LAS unsigned char*)smem, g, S, e);
    PH_END
    PH_BEGIN
      prep_rows<false, true>(p, l, obid() * 8, NT, (int)gridDim.x * 8);
    PH_END
    PH_BEGIN
      gemm_small((const bf16_t*)(ws + OFF_TMPW), 64, (const bf16_t*)(ws + OFF_WW2), 64, NT / 256, 4, 64, rot, smem,
                 EpiWlora{(bf16_t*)(ws + OFF_SCANIN) + 3 * 256, p.rwkv_w0 + l * 512});
      gemm_small((const bf16_t*)(ws + OFF_TMPA), 64, (const bf16_t*)(ws + OFF_WA2), 64, NT / 256, 4, 64, rot, smem,
                 EpiAlora{(bf16_t*)(ws + OFF_SCANIN) + 5 * 256, p.rwkv_a0 + l * 512});
      gemm_small((const bf16_t*)(ws + OFF_TMPG), 192, (const bf16_t*)(ws + OFF_WG2), 192, NT / 256, 2, 192, rot, smem, EpiBf16{(bf16_t*)(ws + OFF_G), 256, false});
    PH_END
    PH_BEGIN
      for (int sb = obid(); sb < 64; sb += gridDim.x) scan_block(p, l, sb, smem);
      const int NWQ = 384, NPREP = 264, NPROJ = 462, NJOB = NWQ + NPREP + NPROJ;
      const int nitems = NJOB + (last ? 768 : 792);
      unsigned* counters = (unsigned*)(ws + OFF_CTL + 32768);
      bool win_ok = false;
      bool prep_ok = false;
      bool proj_ok = false;
#pragma unroll 1
      for (;;) {
        if (otid() == 0) {
          const int it = (int)atomicAdd(&counters[l * 64], 1u);
          if (it >= NWQ && it < nitems && !win_ok) {
            unsigned sp = 0;
            while (xb_ld(&counters[l * 64 + 48]) < (unsigned)NWQ) { __builtin_amdgcn_s_sleep(2); if (++sp > (1u << 24)) break; }
            __builtin_amdgcn_fence(__ATOMIC_ACQUIRE, "agent");
            asm volatile("s_waitcnt vmcnt(0)" ::: "memory");
            win_ok = true;
          }
          if (it >= NWQ + NPREP && it < nitems && !prep_ok) {
            unsigned sp = 0;
            while (xb_ld(&counters[l * 64 + 32]) < (unsigned)NPREP) { __builtin_amdgcn_s_sleep(2); if (++sp > (1u << 24)) break; }
            __builtin_amdgcn_fence(__ATOMIC_ACQUIRE, "agent");
            asm volatile("s_waitcnt vmcnt(0)" ::: "memory");
            prep_ok = true;
          }
          const int q0 = it - NJOB;
          const bool is_mla = (q0 >= 256 && q0 < 512) || (q0 >= 768 && q0 < 776);
          if (is_mla && it < nitems && !proj_ok) {
            unsigned sp = 0;
            while (xb_ld(&counters[l * 64 + 16]) < (unsigned)NPROJ) { __builtin_amdgcn_s_sleep(2); if (++sp > (1u << 24)) break; }
            __builtin_amdgcn_fence(__ATOMIC_ACQUIRE, "agent");
            asm volatile("s_waitcnt vmcnt(0)" ::: "memory");
            proj_ok = true;
          }
          *s_item = it;
        }
        __syncthreads();
        const int item = *s_item;
        __syncthreads();
        if (item >= nitems) break;
        if (item < NWQ) {
          const int mt = item / 6, k6 = item - 6 * mt;
          pg8::PEpiWin e{(bf16_t*)(ws + OFF_ZA), (bf16_t*)(ws + OFF_ZB), (bf16_t*)(ws + OFF_ZC), (bf16_t*)(ws + OFF_ZD), (bf16_t*)(ws + OFF_VTA), (bf16_t*)(ws + OFF_VTD)};
          pg8::Gemm g{H, (const bf16_t*)(ws + OFF_WIN), NT, NWIN, 1024, 1024};
          pg8::PieceOrder S{mt, k6 < 4 ? k6 : k6 + 5, true};
          pg8::gemm_phase<pg8::PEpiWin, pg8::PieceOrder, false, true>((PG8_LAS unsigned char*)smem, g, S, e);
          asm volatile("s_waitcnt vmcnt(0)" ::: "memory");
          __syncthreads();
          if (otid() == 0) {
            __builtin_amdgcn_fence(__ATOMIC_RELEASE, "agent");
            asm volatile("s_waitcnt vmcnt(0)" ::: "memory");
            (void)xb_add(&counters[l * 64 + 48], 1u);
          }
        } else if (item < NWQ + NPREP) {
          const int pjb = item - NWQ;
          prep_rows<true, false>(p, l, pjb * 64, pjb * 64 + 64, 8);
          asm volatile("s_waitcnt vmcnt(0)" ::: "memory");
          __syncthreads();
          if (otid() == 0) {
            __builtin_amdgcn_fence(__ATOMIC_RELEASE, "agent");
            asm volatile("s_waitcnt vmcnt(0)" ::: "memory");
            (void)xb_add(&counters[l * 64 + 32], 1u);
          }
        } else if (item < NJOB) {
          const bf16_t* ZB = (const bf16_t*)(ws + OFF_ZB);
          const int pj = item - NWQ - NPREP;
          const bool isq = pj < 198;
          const int j = isq ? pj : pj - 198;
          const int mt = isq ? j / 3 : j >> 2, nt = isq ? j - 3 * mt : j & 3;
          gemm_small_tile(isq ? ZB : ZB + 256, 512, (const bf16_t*)(ws + (isq ? OFF_WUQ : OFF_WUKV)), isq ? 256 : 128, mt, nt, isq ? 256 : 128, smem,
                          EpiUqkv{isq ? 0 : 1, (bf16_t*)(ws + OFF_BQ), (bf16_t*)(ws + OFF_BK), (bf16_t*)(ws + OFF_VTB)});
          asm volatile("s_waitcnt vmcnt(0)" ::: "memory");
          __syncthreads();
          if (otid() == 0) {
            __builtin_amdgcn_fence(__ATOMIC_RELEASE, "agent");
            asm volatile("s_waitcnt vmcnt(0)" ::: "memory");
            (void)xb_add(&counters[l * 64 + 16], 1u);
          }
        } else {
          const int q = item - NJOB;
          int kind, b, hq, qt; bool isctx = false;
          if (q < 768) { const int k3 = q >> 8; kind = (k3 == 0) ? 1 : (k3 == 1 ? 0 : 2); const int j = q & 255; b = j >> 7; hq = (j >> 5) & 3; qt = j & 31; }
          else { const int j = q - 768; kind = j >> 3; b = (j >> 2) & 1; hq = j & 3; qt = 0; isctx = true; }
          run_attn_item(p, l, kind, b, hq, qt, isctx, smem);
        }
      }
    PH_END
    PH_BEGIN
      phase_rwkv_out(p, l, nrows);
    PH_END
    PH_BEGIN
      {
        pg8::PEpiBf16 e{(bf16_t*)(ws + OFF_YMIX), 1024, false};
        pg8::Gemm g{(const bf16_t*)(ws + OFF_OUTS), (const bf16_t*)(ws + OFF_WOUT), NLAT, 1024, 1024, 1024}; pg8::StaticOrder S; S.init(NLAT, 1024, (int)gridDim.x, obid());
        pg8::gemm_phase<pg8::PEpiBf16, pg8::StaticOrder, true, true>((PG8_LAS unsigned char*)smem, g, S, e);
      }
      if (!last) {
        const int idx = obid(), u = idx >> 2, ks = idx & 3;
        pg8::PieceOrder S{64 + (u >> 2), u & 3, idx < 32};
        pg8::PEpiF32 e{(float*)(ws + OFF_SLAB1) + (size_t)ks * NCTX * 1024 - (size_t)NLAT * 1024, 1024};
        pg8::Gemm g{(const bf16_t*)(ws + OFF_OUTS) + ks * 256, (const bf16_t*)(ws + OFF_WOUT) + ks * 256, NT, 1024, 256, 1024};
        pg8::gemm_phase<pg8::PEpiF32, pg8::PieceOrder, false, true>((PG8_LAS unsigned char*)smem, g, S, e);
      }
    PH_END
    PH_BEGIN
      const float* modl = mods + (size_t)l * 3 * 6144;
      phase_rows(p, nrows, (const bf16_t*)(ws + OFF_YMIX), l == 0 ? p.x : p.out, l == 0 ? p.ctx : XC, p.out, XC, modl, 2048, p.g_post_mix + l * 1024, true,
                 modl, 3072, 4096, p.g_pre_mlp + l * 1024, (bf16_t*)(ws + OFF_H2), (const float*)(ws + OFF_SLAB1), last ? 0 : 4);
    PH_END
    PH_BEGIN
      pg8::PEpiBf16 e{(bf16_t*)(ws + OFF_U), 4096, true};
      pg8::Gemm g{(const bf16_t*)(ws + OFF_H2), (const bf16_t*)(ws + OFF_W1), nrows, 4096, 1024, 1024}; pg8::StaticOrder S; S.init(nrows, 4096, (int)gridDim.x, obid());
      pg8::gemm_phase<pg8::PEpiBf16, pg8::StaticOrder, true, true>((PG8_LAS unsigned char*)smem, g, S, e);
    PH_END
    PH_BEGIN
      {
        pg8::PEpiBf16 e{(bf16_t*)(ws + OFF_Y2), 1024, false};
        pg8::Gemm g{(const bf16_t*)(ws + OFF_U), (const bf16_t*)(ws + OFF_W2), NLAT, 1024, 4096, 4096}; pg8::StaticOrder S; S.init(NLAT, 1024, (int)gridDim.x, obid());
        pg8::gemm_phase<pg8::PEpiBf16, pg8::StaticOrder, true, true>((PG8_LAS unsigned char*)smem, g, S, e);
      }
      if (!last) {
        const int idx = obid(), u = idx >> 3, ks = idx & 7;
        pg8::PieceOrder S{64 + (u >> 2), u & 3, idx < 64};
        pg8::PEpiF32 e{(float*)(ws + OFF_SLAB2) + (size_t)ks * NCTX * 1024 - (size_t)NLAT * 1024, 1024};
        pg8::Gemm g{(const bf16_t*)(ws + OFF_U) + ks * 512, (const bf16_t*)(ws + OFF_W2) + ks * 512, NT, 1024, 512, 4096};
        pg8::gemm_phase<pg8::PEpiF32, pg8::PieceOrder, false, true>((PG8_LAS unsigned char*)smem, g, S, e);
      }
    PH_END
    PH_BEGIN
      if (!last) phase_convert(p, l + 1, smem);
      const float* modl = mods + (size_t)l * 3 * 6144;
      phase_rows(p, nrows, (const bf16_t*)(ws + OFF_Y2), p.out, XC, p.out, XC, modl, 5120, p.g_post_mlp + l * 1024, !last,
                 mods + (size_t)(l + 1) * 3 * 6144, 0, 1024, p.g_pre_mix + (last ? 0 : (l + 1) * 1024), H, (const float*)(ws + OFF_SLAB2), last ? 0 : 8);
    }
    if (last) break;
    XBAR();
    if (otid() == 0) *s_layer = l + 1;
    __syncthreads();
  }
}

extern "C" void kernel_launch(void* const* d_in, const int* in_sizes, int n_in, void* d_out, int out_size, void* d_ws, size_t ws_size,
                              hipStream_t stream) {
  static int grid_blocks = 0;
  if (grid_blocks == 0) {
    if (n_in != 32 || ws_size < WS_NEED) { fprintf(stderr, "kernel_launch: unexpected n_in %d / ws_size %zu\n", n_in, ws_size); grid_blocks = -1; return; }
    int dev = 0, cus = 0, per_cu = 0;
    hipGetDevice(&dev);
    hipDeviceGetAttribute(&cus, hipDeviceAttributeMultiprocessorCount, dev);
    hipFuncSetAttribute((const void*)fwd_megakernel, hipFuncAttributeMaxDynamicSharedMemorySize, LDS_BYTES);
    hipOccupancyMaxActiveBlocksPerMultiprocessor(&per_cu, (const void*)fwd_megakernel, THREADS, LDS_BYTES);
    if (per_cu < 1) { fprintf(stderr, "kernel_launch: occupancy query says %d blocks per CU\n", per_cu); grid_blocks = -1; return; }
    grid_blocks = cus;
  }
  if (grid_blocks < 0) return;
  hipMemsetAsync((char*)d_ws + OFF_CTL, 0, 65536, stream);
  Params p{};
  const float** pp = (const float**)&p;
  for (int i = 0; i < 32; ++i) pp[i] = (const float*)d_in[i];
  p.out = (float*)d_out;
  p.ws = (char*)d_ws;
  void* args[] = {&p};
  hipError_t e = hipLaunchCooperativeKernel((const void*)fwd_megakernel, dim3(grid_blocks), dim3(THREADS), args, LDS_BYTES, stream);
  if (e != hipSuccess) fprintf(stderr, "cooperative launch failed: %s (grid %d)\n", hipGetErrorString(e), grid_blocks);
}
```
